# Optimizing an MI355X kernel written in HIP

```python
import math
import jax
import jax.numpy as jnp
from jax import lax
import numpy as np

D_MODEL = 1024
BATCH = 8
SEQ = 4096
DEPTH = 4

GRID_W = 64
PLE_DIM = 256
EPS = 1e-6
N_EVEN = (DEPTH + 1) // 2
N_ODD = DEPTH // 2

HY_W = D_MODEL
HY_GROUPS = 8
HY_BANDS = 16
HY_EMB = 1 + 2 * HY_BANDS
HY_HIDDEN = 64
HY_SHORT = 3
HY_FAST_DECAY = 0.3
HY_SLOW_DECAY = 1.5
HY_TARGET = 1e-2

GM_W = D_MODEL
GM_GROUPS = 8
GM_GROUP_CH = GM_W // GM_GROUPS
CHUNK = 128

EVEN_IN = 4 * HY_W + 3 * GM_W
EVEN_MIX = HY_W + GM_W

POOL_WINDOWS = (2, 4, 8, 16)
POOL_GROUPS = len(POOL_WINDOWS)
POOL_W = D_MODEL
POOL_GROUP_CH = POOL_W // POOL_GROUPS

NA_HEADS = 16
NA_HEAD_DIM = 64
NA_W = NA_HEADS * NA_HEAD_DIM
NA_KH_MAX = 8
NA_KW = 16

ODD_IN = 2 * POOL_W + 4 * NA_W
ODD_MIX = POOL_W + NA_W

kernel_name = "hybrid_hyena_gmlp_pool_natten_encoder"


def rmsnorm(x, g):
    xf = x.astype(jnp.float32)
    y = xf * lax.rsqrt(jnp.mean(xf * xf, axis=-1, keepdims=True) + EPS)
    return (y * g.astype(jnp.float32)).astype(x.dtype)


def centred_short_conv(x, w, b):
    xp = jnp.pad(x, ((0, 0), (1, 1), (0, 0)))
    return xp[:, :-2] * w[0] + xp[:, 1:-1] * w[1] + xp[:, 2:] * w[2] + b


def hyena_two_sided_filter(L, w0, b0, w1, b1, w2, b2, w_out, freq):
    f32 = jnp.float32
    t = jnp.linspace(0.0, 1.0, L, dtype=f32)[:, None]
    ang = 2.0 * math.pi * jnp.arange(L, dtype=f32)[:, None] / L
    bands = jnp.linspace(1e-4, HY_BANDS - 1, HY_BANDS, dtype=f32)[None, :]
    feats = jnp.concatenate([t, jnp.cos(bands * ang), -jnp.sin(bands * ang)], axis=-1)
    fr = freq.astype(f32)
    h = jnp.sin(fr * (feats @ w0.astype(f32) + b0.astype(f32)))
    h = jnp.sin(fr * (h @ w1.astype(f32) + b1.astype(f32)))
    h = jnp.sin(fr * (h @ w2.astype(f32) + b2.astype(f32)))
    k = (h @ w_out.astype(f32)).reshape(L, 2, HY_W)
    max_decay = math.log(HY_TARGET) / HY_FAST_DECAY
    min_decay = math.log(HY_TARGET) / HY_SLOW_DECAY
    deltas = jnp.linspace(min_decay, max_decay, HY_W, dtype=f32)
    k = k * jnp.exp(-t * jnp.abs(deltas))[:, None, :]
    k_fwd = k[:, 0]
    k_bwd = k[1:, 1][::-1]
    kc = jnp.concatenate([k_fwd, jnp.zeros((1, HY_W), f32), k_bwd], axis=0)
    return kc * lax.rsqrt(jnp.sum(kc * kc, axis=0, keepdims=True) + EPS)


def fft_long_conv(z, kc, d):
    L = z.shape[1]
    n = 2 * L
    zf = z.astype(jnp.float32)
    spec = jnp.fft.rfft(zf, n=n, axis=1) * jnp.fft.rfft(kc, n=n, axis=0)[None]
    y = jnp.fft.irfft(spec, n=n, axis=1)[:, :L]
    return (y + zf * d.astype(jnp.float32)).astype(z.dtype)


def even_mixer(hn, w_in, conv_w, conv_b, hy_w0, hy_b0, hy_w1, hy_b1, hy_w2, hy_b2,
               hy_wout, hy_freq, hy_d, gm_norm_g, gm_ws, gm_bs, w_out):
    B, L, _ = hn.shape
    proj = hn @ w_in
    hy_in, g_a, u_b, v_b, g_b = jnp.split(
        proj, [3 * HY_W, 4 * HY_W, 4 * HY_W + GM_W, 4 * HY_W + 2 * GM_W], axis=-1)
    hy_in = centred_short_conv(hy_in, conv_w, conv_b)
    x0, x1, v = jnp.split(hy_in, 3, axis=-1)
    kc = hyena_two_sided_filter(L, hy_w0, hy_b0, hy_w1, hy_b1, hy_w2, hy_b2, hy_wout, hy_freq)
    y_a = x0 * fft_long_conv(v * x1, kc, hy_d) * jax.nn.silu(g_a)
    v_c = rmsnorm(v_b, gm_norm_g).reshape(B, L // CHUNK, CHUNK, GM_GROUPS, GM_GROUP_CH)
    s = jnp.einsum('gpq,bnqgc->bnpgc', gm_ws, v_c) + gm_bs.T[None, None, :, :, None]
    y_b = u_b * s.reshape(B, L, GM_W) * jax.nn.silu(g_b)
    return jnp.concatenate([y_a, y_b], axis=-1) @ w_out


def multiscale_pool(xc):
    B, L, C = xc.shape
    xf = xc.astype(jnp.float32)
    cs = jnp.concatenate([jnp.zeros((B, 1, C), jnp.float32), jnp.cumsum(xf, axis=1)], axis=1)
    t = np.arange(L)
    outs = []
    for g, w in enumerate(POOL_WINDOWS):
        lo = np.clip(t - w // 2, 0, L)
        hi = np.clip(t + w // 2, 0, L)
        seg = cs[:, :, g * POOL_GROUP_CH:(g + 1) * POOL_GROUP_CH]
        cnt = jnp.asarray((hi - lo).astype(np.float32))[None, :, None]
        outs.append((jnp.take(seg, hi, axis=1) - jnp.take(seg, lo, axis=1)) / cnt)
    pooled = jnp.concatenate(outs, axis=-1)
    return (pooled - xf).astype(xc.dtype)


def neighbourhood_attention(q, k, v, rpb):
    B, L, H, Dh = q.shape
    rows = L // GRID_W
    kh = min(NA_KH_MAX, rows)
    kw = NA_KW
    qg = q.reshape(B, rows, GRID_W, H, Dh)
    kg = k.reshape(B, rows, GRID_W, H, Dh)
    vg = v.reshape(B, rows, GRID_W, H, Dh)
    cols = np.arange(GRID_W)
    col_start = np.clip(cols - kw // 2, 0, GRID_W - kw)
    col_idx = col_start[:, None] + np.arange(kw)[None, :]
    dc = col_idx - cols[:, None] + (NA_KW - 1)
    rpb_c = rpb[:, :, dc]
    scale = Dh ** -0.5

    def row_block(r):
        rs = jnp.clip(r - kh // 2, 0, rows - kh)
        kb = lax.dynamic_slice_in_dim(kg, rs, kh, axis=1)
        vb = lax.dynamic_slice_in_dim(vg, rs, kh, axis=1)
        k_win = kb[:, :, col_idx]
        v_win = vb[:, :, col_idx]
        q_row = lax.dynamic_index_in_dim(qg, r, axis=1, keepdims=False)
        s = jnp.einsum('bqhd,bjqkhd->bhqjk', q_row, k_win).astype(jnp.float32) * scale
        dr = rs + jnp.arange(kh) - r + (NA_KH_MAX - 1)
        bias = jnp.take(rpb_c, dr, axis=1).astype(jnp.float32)
        s = s + jnp.transpose(bias, (0, 2, 1, 3))[None]
        a = jax.nn.softmax(s.reshape(B, H, GRID_W, kh * kw), axis=-1).reshape(B, H, GRID_W, kh, kw)
        return jnp.einsum('bhqjk,bjqkhd->bqhd', a.astype(v.dtype), v_win)

    out = lax.map(row_block, jnp.arange(rows))
    return jnp.transpose(out, (1, 0, 2, 3, 4)).reshape(B, L, H * Dh)


def odd_mixer(hn, w_in, pool_w, pool_b, pool_scale, rpb, w_out):
    B, L, _ = hn.shape
    proj = hn @ w_in
    xc, g_c, q, k, v, g_d = jnp.split(
        proj, [POOL_W, 2 * POOL_W, 2 * POOL_W + NA_W, 2 * POOL_W + 2 * NA_W, 2 * POOL_W + 3 * NA_W], axis=-1)
    d = multiscale_pool(xc).reshape(B, L, POOL_GROUPS, POOL_GROUP_CH)
    y_c = jnp.einsum('bsgc,gcd->bsgd', d, pool_w).reshape(B, L, POOL_W) + pool_b
    y_c = y_c * pool_scale * jax.nn.silu(g_c)
    shp = (B, L, NA_HEADS, NA_HEAD_DIM)
    y_d = neighbourhood_attention(q.reshape(shp), k.reshape(shp), v.reshape(shp), rpb) * jax.nn.silu(g_d)
    return jnp.concatenate([y_c, y_d], axis=-1) @ w_out


def setup_inputs(seed: int = 0) -> dict:
    key = jax.random.key(seed)
    ks = jax.random.split(key, 32)
    f32 = jnp.float32

    def nrm(k, shape, scale):
        return jax.random.normal(k, shape, f32) * scale

    return {
        "x": nrm(ks[0], (BATCH, SEQ, D_MODEL), 1.0),
        "p": nrm(ks[1], (DEPTH, BATCH, SEQ, PLE_DIM), 1.0),
        "norm_g": 1.0 + nrm(ks[2], (DEPTH, D_MODEL), 0.1),
        "final_g": 1.0 + nrm(ks[3], (D_MODEL,), 0.1),
        "ev_w_in": nrm(ks[4], (N_EVEN, D_MODEL, EVEN_IN), D_MODEL ** -0.5),
        "ev_conv_w": nrm(ks[5], (N_EVEN, HY_SHORT, 3 * HY_W), HY_SHORT ** -0.5),
        "ev_conv_b": nrm(ks[6], (N_EVEN, 3 * HY_W), 0.01),
        "hy_w0": nrm(ks[7], (N_EVEN, HY_EMB, HY_HIDDEN), HY_EMB ** -0.5),
        "hy_b0": nrm(ks[8], (N_EVEN, HY_HIDDEN), 0.1),
        "hy_w1": nrm(ks[9], (N_EVEN, HY_HIDDEN, HY_HIDDEN), HY_HIDDEN ** -0.5),
        "hy_b1": nrm(ks[10], (N_EVEN, HY_HIDDEN), 0.1),
        "hy_w2": nrm(ks[11], (N_EVEN, HY_HIDDEN, HY_HIDDEN), HY_HIDDEN ** -0.5),
        "hy_b2": nrm(ks[12], (N_EVEN, HY_HIDDEN), 0.1),
        "hy_wout": nrm(ks[13], (N_EVEN, HY_HIDDEN, 2 * HY_W), HY_HIDDEN ** -0.5),
        "hy_freq": 1.0 + nrm(ks[14], (N_EVEN, HY_HIDDEN), 0.1),
        "hy_d": nrm(ks[15], (N_EVEN, HY_W), 1.0),
        "gm_norm_g": 1.0 + nrm(ks[16], (N_EVEN, GM_W), 0.1),
        "gm_ws": nrm(ks[17], (N_EVEN, GM_GROUPS, CHUNK, CHUNK), CHUNK ** -0.5),
        "gm_bs": 1.0 + nrm(ks[18], (N_EVEN, GM_GROUPS, CHUNK), 0.1),
        "ev_w_out": nrm(ks[19], (N_EVEN, EVEN_MIX, D_MODEL), EVEN_MIX ** -0.5),
        "od_w_in": nrm(ks[20], (N_ODD, D_MODEL, ODD_IN), D_MODEL ** -0.5),
        "pool_w": nrm(ks[21], (N_ODD, POOL_GROUPS, POOL_GROUP_CH, POOL_GROUP_CH), POOL_GROUP_CH ** -0.5),
        "pool_b": nrm(ks[22], (N_ODD, POOL_W), 0.01),
        "pool_scale": 1.0 + nrm(ks[23], (N_ODD, POOL_W), 0.1),
        "na_rpb": nrm(ks[24], (N_ODD, NA_HEADS, 2 * NA_KH_MAX - 1, 2 * NA_KW - 1), 0.1),
        "od_w_out": nrm(ks[25], (N_ODD, ODD_MIX, D_MODEL), ODD_MIX ** -0.5),
        "ple_up": nrm(ks[26], (DEPTH, PLE_DIM, D_MODEL), PLE_DIM ** -0.5),
        "ple_gate_w": nrm(ks[27], (DEPTH, D_MODEL, D_MODEL), D_MODEL ** -0.5),
        "ple_g": 1.0 + nrm(ks[28], (DEPTH, D_MODEL), 0.1),
    }


def reference(x, p, norm_g, final_g, ev_w_in, ev_conv_w, ev_conv_b, hy_w0, hy_b0, hy_w1, hy_b1,
              hy_w2, hy_b2, hy_wout, hy_freq, hy_d, gm_norm_g, gm_ws, gm_bs, ev_w_out,
              od_w_in, pool_w, pool_b, pool_scale, na_rpb, od_w_out, ple_up, ple_gate_w, ple_g):
    h = x
    for i in range(DEPTH):
        j = i // 2
        hn = rmsnorm(h, norm_g[i])
        if i % 2 == 0:
            mix = even_mixer(hn, ev_w_in[j], ev_conv_w[j], ev_conv_b[j], hy_w0[j], hy_b0[j],
                             hy_w1[j], hy_b1[j], hy_w2[j], hy_b2[j], hy_wout[j], hy_freq[j],
                             hy_d[j], gm_norm_g[j], gm_ws[j], gm_bs[j], ev_w_out[j])
        else:
            mix = odd_mixer(hn, od_w_in[j], pool_w[j], pool_b[j], pool_scale[j], na_rpb[j], od_w_out[j])
        h = h + mix
        gate = jax.nn.sigmoid(rmsnorm(h, ple_g[i]) @ ple_gate_w[i])
        h = h + (p[i] @ ple_up[i]) * gate
    return rmsnorm(h, final_g)
```

```cpp
#include <hip/hip_runtime.h>
#include <hip/hip_cooperative_groups.h>
#include <cstdio>
namespace cg = cooperative_groups;

typedef unsigned short bf16_t;
typedef short bf16x8 __attribute__((ext_vector_type(8)));
typedef short bf16x4 __attribute__((ext_vector_type(4)));
typedef float f32x4 __attribute__((ext_vector_type(4)));

#define NT 256
constexpr int LDS_BYTES = 0;
constexpr size_t MiB = 1u << 20;
constexpr size_t WB_OFF = 0, HBA_OFF = 80 * MiB, SPEC_OFF = 144 * MiB, H3_OFF = 177 * MiB, TW_OFF = 179 * MiB, R_OFF = 180 * MiB, WS_END = 500 * MiB;
constexpr int TOK = 32768, SEQ = 4096, DM = 1024;
constexpr size_t W_EIN = 0, W_OIN = 14680064, W_EOUT = 27262976, W_OOUT = 31457280, W_PGATE = 35651584, W_PUP = 39845888, W_POOL = 40894464, W_GMWS = 41418752;
constexpr int SPEC_STRIDE = 4104;

struct Params { const float* in[29]; float* out; unsigned char* ws; };
enum { I_X = 0, I_P, I_NORMG, I_FINALG, I_EWIN, I_CONVW, I_CONVB, I_HW0, I_HB0, I_HW1, I_HB1, I_HW2, I_HB2, I_HWOUT, I_HFREQ, I_HD, I_GMG, I_GMWS, I_GMBS, I_EWOUT, I_OWIN, I_POOLW, I_POOLB, I_POOLS, I_RPB, I_OWOUT, I_PUP, I_PGATE, I_PLEG };

__device__ __forceinline__ unsigned short f2bf(float f) { unsigned u = __float_as_uint(f); u += 0x7fffu + ((u >> 16) & 1u); return (unsigned short)(u >> 16); }
__device__ __forceinline__ float bf2f(unsigned short h) { return __uint_as_float(((unsigned)h) << 16); }
__device__ __forceinline__ unsigned pack2(float lo, float hi) { return (unsigned)f2bf(lo) | ((unsigned)f2bf(hi) << 16); }
__device__ __forceinline__ float lo_f(unsigned u) { return __uint_as_float(u << 16); }
__device__ __forceinline__ float hi_f(unsigned u) { return __uint_as_float(u & 0xffff0000u); }
__device__ __forceinline__ float silu_f(float v) { return v / (1.f + __expf(-v)); }
__device__ __forceinline__ float sigmoid_f(float v) { return 1.f / (1.f + __expf(-v)); }
__device__ __forceinline__ void unpack8(const uint4& u, float* f) { f[0] = lo_f(u.x); f[1] = hi_f(u.x); f[2] = lo_f(u.y); f[3] = hi_f(u.y); f[4] = lo_f(u.z); f[5] = hi_f(u.z); f[6] = lo_f(u.w); f[7] = hi_f(u.w); }

typedef const Params __attribute__((address_space(4)))* KP;
__device__ __forceinline__ KP params_fresh() { KP p = (KP)__builtin_amdgcn_kernarg_segment_ptr(); asm volatile("" : "+s"(p)); return p; }
__device__ __forceinline__ int tid_fresh() { int t = threadIdx.x; asm volatile("" : "+v"(t)); return t; }

__device__ __forceinline__ int swz(int row, int kc) { return row * 128 + ((kc ^ ((row >> 1) & 7)) << 4); }

template <int AM, bool SS>
__device__ __forceinline__ void load_a1(int tid, uint4& out, float& ssq, const void* A0, const void* A1, int lda, int row, int k0, int aux) {
  const int kc = tid & 7;
  if (AM == 0) {
    out = *(const uint4*)((const bf16_t*)A0 + (size_t)row * lda + k0 + kc * 8);
  } else if (AM == 2) {
    const bf16_t* src = (k0 < 1024) ? (const bf16_t*)A0 : (const bf16_t*)A1;
    out = *(const uint4*)(src + (size_t)row * lda + (k0 & 1023) + kc * 8);
  } else if (AM == 1) {
    const float* src = (const float*)A0 + (size_t)row * lda + k0 + kc * 8;
    const float4 a = *(const float4*)src, b = *(const float4*)(src + 4);
    out = make_uint4(pack2(a.x, a.y), pack2(a.z, a.w), pack2(b.x, b.y), pack2(b.z, b.w));
  } else {
    const bf16_t* src = (const bf16_t*)A0 + k0 + kc * 8;
    const int half = 1 << aux;
    const int tb = row & (SEQ - 1), base = row - tb;
    const int lo = max(tb - half, 0), hi = min(tb + half, SEQ);
    float s0 = 0.f, s1 = 0.f, s2 = 0.f, s3 = 0.f, s4 = 0.f, s5 = 0.f, s6 = 0.f, s7 = 0.f;
#pragma unroll 1
    for (int t = lo; t < hi; ++t) {
      const uint4 u = *(const uint4*)(src + (size_t)(base + t) * lda);
      s0 += lo_f(u.x); s1 += hi_f(u.x); s2 += lo_f(u.y); s3 += hi_f(u.y); s4 += lo_f(u.z); s5 += hi_f(u.z); s6 += lo_f(u.w); s7 += hi_f(u.w);
    }
    const uint4 u = *(const uint4*)(src + (size_t)row * lda);
    const float inv = 1.f / (float)(hi - lo);
    out = make_uint4(pack2(s0 * inv - lo_f(u.x), s1 * inv - hi_f(u.x)), pack2(s2 * inv - lo_f(u.y), s3 * inv - hi_f(u.y)),
                     pack2(s4 * inv - lo_f(u.z), s5 * inv - hi_f(u.z)), pack2(s6 * inv - lo_f(u.w), s7 * inv - hi_f(u.w)));
  }
  if (SS) {
    const float f0 = lo_f(out.x), f1 = hi_f(out.x), f2 = lo_f(out.y), f3 = hi_f(out.y), f4 = lo_f(out.z), f5 = hi_f(out.z), f6 = lo_f(out.w), f7 = hi_f(out.w);
    ssq += f0 * f0 + f1 * f1 + f2 * f2 + f3 * f3 + f4 * f4 + f5 * f5 + f6 * f6 + f7 * f7;
  }
}
template <int AM, bool SS>
__device__ __forceinline__ void load_a(int tid, uint4& a0, uint4& a1, uint4& a2, uint4& a3, const void* A0, const void* A1, int lda, int m0, int k0, int aux, float (&ss)[4]) {
  const int row = m0 + (tid >> 3);
  load_a1<AM, SS>(tid, a0, ss[0], A0, A1, lda, row, k0, aux);
  load_a1<AM, SS>(tid, a1, ss[1], A0, A1, lda, row + 32, k0, aux);
  load_a1<AM, SS>(tid, a2, ss[2], A0, A1, lda, row + 64, k0, aux);
  load_a1<AM, SS>(tid, a3, ss[3], A0, A1, lda, row + 96, k0, aux);
}
__device__ __forceinline__ void load_b(int tid, uint4& b0, uint4& b1, uint4& b2, uint4& b3, const bf16_t* Bt, int ldb, int n0, int k0) {
  const bf16_t* p = Bt + (size_t)(n0 + (tid >> 3)) * ldb + k0 + (tid & 7) * 8;
  b0 = *(const uint4*)p; b1 = *(const uint4*)(p + (size_t)32 * ldb); b2 = *(const uint4*)(p + (size_t)64 * ldb); b3 = *(const uint4*)(p + (size_t)96 * ldb);
}
__device__ __forceinline__ void store_tile(int tid, unsigned char* dst, const uint4& r0v, const uint4& r1v, const uint4& r2v, const uint4& r3v) {
  const int r0 = tid >> 3, kc = tid & 7;
  *(uint4*)(dst + swz(r0, kc)) = r0v; *(uint4*)(dst + swz(r0 + 32, kc)) = r1v; *(uint4*)(dst + swz(r0 + 64, kc)) = r2v; *(uint4*)(dst + swz(r0 + 96, kc)) = r3v;
}

template <int AM, bool SS, bool SWAP>
__device__ __forceinline__ void gemm_mainloop(f32x4 (&acc)[4][4], const void* A0, const void* A1, int lda, const bf16_t* Bt, int ldb,
                                              int m0, int n0, int K, int aux, unsigned char* smem, float (&ss)[4]) {
  const int tid = tid_fresh(), wid = tid >> 6, lane = tid & 63, wr = wid >> 1, wc = wid & 1, fr = lane & 15, fq = lane >> 4;
  uint4 a0, a1, a2, a3, b0, b1, b2, b3;
  const int nk = K >> 6;
  __syncthreads();
  load_a<AM, SS>(tid, a0, a1, a2, a3, A0, A1, lda, m0, 0, aux, ss);
  load_b(tid, b0, b1, b2, b3, Bt, ldb, n0, 0);
  store_tile(tid, smem, a0, a1, a2, a3); store_tile(tid, smem + 16384, b0, b1, b2, b3);
  __syncthreads();
  for (int kt = 0; kt < nk; ++kt) {
    unsigned char* cur = smem + (kt & 1) * 32768;
    unsigned char* nxt = smem + ((kt + 1) & 1) * 32768;
    const bool more = (kt + 1 < nk);
    if (more) { load_a<AM, SS>(tid, a0, a1, a2, a3, A0, A1, lda, m0, (kt + 1) << 6, aux, ss); load_b(tid, b0, b1, b2, b3, Bt, ldb, n0, (kt + 1) << 6); }
#pragma unroll
    for (int s = 0; s < 2; ++s) {
      bf16x8 af[4], bfr[4];
#pragma unroll
      for (int m = 0; m < 4; ++m) af[m] = *(const bf16x8*)(cur + swz(wr * 64 + m * 16 + fr, s * 4 + fq));
#pragma unroll
      for (int n = 0; n < 4; ++n) bfr[n] = *(const bf16x8*)(cur + 16384 + swz(wc * 64 + n * 16 + fr, s * 4 + fq));
#pragma unroll
      for (int m = 0; m < 4; ++m)
#pragma unroll
        for (int n = 0; n < 4; ++n)
          acc[m][n] = SWAP ? __builtin_amdgcn_mfma_f32_16x16x32_bf16(bfr[n], af[m], acc[m][n], 0, 0, 0)
                           : __builtin_amdgcn_mfma_f32_16x16x32_bf16(af[m], bfr[n], acc[m][n], 0, 0, 0);
    }
    if (more) { store_tile(tid, nxt, a0, a1, a2, a3); store_tile(tid, nxt + 16384, b0, b1, b2, b3); }
    __syncthreads();
  }
}
__device__ __forceinline__ void finish_rstd(float (&ss)[4], unsigned char* smem) {
  const int tid = tid_fresh(), r0 = tid >> 3, kc = tid & 7;
  float* rs = (float*)smem;
#pragma unroll
  for (int i = 0; i < 4; ++i) {
    float v = ss[i];
    v += __shfl_xor(v, 1); v += __shfl_xor(v, 2); v += __shfl_xor(v, 4);
    if (kc == 0) rs[r0 + 32 * i] = rsqrtf(v * (1.f / 1024.f) + 1e-6f);
  }
  __syncthreads();
}
__device__ __forceinline__ void zero_acc(f32x4 (&acc)[4][4]) {
#pragma unroll
  for (int m = 0; m < 4; ++m)
#pragma unroll
    for (int n = 0; n < 4; ++n) acc[m][n] = (f32x4){0.f, 0.f, 0.f, 0.f};
}

__device__ __forceinline__ void inproj_phase(const bf16_t* hb, const bf16_t* W, int ng, int wr0, int wr1, int wr2, int wr3,
                             bf16_t* d0, bf16_t* d1, bf16_t* d2, bf16_t* d3, int md0, int md1, int md2, int md3, unsigned char* smem) {
  const int tid = tid_fresh(), wid = tid >> 6, lane = tid & 63, wr = wid >> 1, wc = wid & 1, fr = lane & 15, fq = lane >> 4;
  const int per_m = ng * 8, ntiles = 256 * per_m;
  for (int t = blockIdx.x; t < ntiles; t += gridDim.x) {
    const int mt = t / per_m, rem = t - mt * per_m, grp = rem >> 3, nt = rem & 7;
    const int wrow = grp == 0 ? wr0 : grp == 1 ? wr1 : grp == 2 ? wr2 : wr3;
    bf16_t* dst = grp == 0 ? d0 : grp == 1 ? d1 : grp == 2 ? d2 : d3;
    const int mode = grp == 0 ? md0 : grp == 1 ? md1 : grp == 2 ? md2 : md3;
    const int m0 = mt * 128, n0 = nt * 128;
    f32x4 acc[4][4]; zero_acc(acc);
    float ss[4] = {0.f, 0.f, 0.f, 0.f};
    if (mode == 1) {
      gemm_mainloop<0, true, false>(acc, hb, nullptr, 1024, W + (size_t)wrow * 1024, 1024, m0, n0, 1024, 0, smem, ss);
      finish_rstd(ss, smem);
      const float* rs = (const float*)smem;
#pragma unroll
      for (int m = 0; m < 4; ++m) {
        const int rl = wr * 64 + m * 16 + fq * 4;
        const float r0 = rs[rl], r1 = rs[rl + 1], r2 = rs[rl + 2], r3 = rs[rl + 3];
#pragma unroll
        for (int n = 0; n < 4; ++n) {
          const int col = n0 + wc * 64 + n * 16 + fr;
          uint2 o; o.x = pack2(acc[m][n][0] * r0, acc[m][n][1] * r1); o.y = pack2(acc[m][n][2] * r2, acc[m][n][3] * r3);
          *(uint2*)(dst + (size_t)col * TOK + m0 + rl) = o;
        }
      }
    } else {
      gemm_mainloop<0, true, true>(acc, hb, nullptr, 1024, W + (size_t)wrow * 1024, 1024, m0, n0, 1024, 0, smem, ss);
      finish_rstd(ss, smem);
      const float* rs = (const float*)smem;
#pragma unroll
      for (int m = 0; m < 4; ++m) {
        const int rl = wr * 64 + m * 16 + fr;
        const float r = rs[rl];
#pragma unroll
        for (int n = 0; n < 4; ++n) {
          const int col = n0 + wc * 64 + n * 16 + fq * 4;
          bf16_t* pd = dst + (size_t)(m0 + rl) * 1024 + col;
          float v0 = acc[m][n][0] * r, v1 = acc[m][n][1] * r, v2 = acc[m][n][2] * r, v3 = acc[m][n][3] * r;
          if (mode == 2) {
            const uint2 old = *(const uint2*)pd;
            v0 = lo_f(old.x) * silu_f(v0); v1 = hi_f(old.x) * silu_f(v1); v2 = lo_f(old.y) * silu_f(v2); v3 = hi_f(old.y) * silu_f(v3);
          }
          uint2 o; o.x = pack2(v0, v1); o.y = pack2(v2, v3);
          *(uint2*)pd = o;
        }
      }
    }
  }
}

__device__ __forceinline__ void outproj_phase(const bf16_t* MA, const bf16_t* MB, const bf16_t* Wt  , const float* hsrc, float* hres, bf16_t* hbB, unsigned char* smem) {
  const int tid = tid_fresh(), wid = tid >> 6, lane = tid & 63, wr = wid >> 1, wc = wid & 1, fr = lane & 15, fq = lane >> 4;
  for (int t = blockIdx.x; t < 2048; t += gridDim.x) {
    const int mt = t >> 3, nt = t & 7, m0 = mt * 128, n0 = nt * 128;
    f32x4 acc[4][4]; zero_acc(acc);
    float ss[4] = {0.f, 0.f, 0.f, 0.f};
    gemm_mainloop<2, false, true>(acc, MA, MB, 1024, Wt, 2048, m0, n0, 2048, 0, smem, ss);
#pragma unroll
    for (int m = 0; m < 4; ++m) {
      const int row = m0 + wr * 64 + m * 16 + fr;
#pragma unroll
      for (int n = 0; n < 4; ++n) {
        const int col = n0 + wc * 64 + n * 16 + fq * 4;
        const size_t idx = (size_t)row * 1024 + col;
        const float4 h = *(const float4*)(hsrc + idx);
        const float4 o = make_float4(h.x + acc[m][n][0], h.y + acc[m][n][1], h.z + acc[m][n][2], h.w + acc[m][n][3]);
        *(float4*)(hres + idx) = o;
        uint2 ob; ob.x = pack2(o.x, o.y); ob.y = pack2(o.z, o.w);
        *(uint2*)(hbB + idx) = ob;
      }
    }
  }
}

__device__ __forceinline__ void ple_phase(const bf16_t* hbB, const float* pin  , const bf16_t* Wg  , const bf16_t* Wup  ,
                          float* hres, bf16_t* hbA, unsigned char* smem) {
  const int tid = tid_fresh(), wid = tid >> 6, lane = tid & 63, wr = wid >> 1, wc = wid & 1, fr = lane & 15, fq = lane >> 4;
  for (int t = blockIdx.x; t < 2048; t += gridDim.x) {
    const int mt = t >> 3, nt = t & 7, m0 = mt * 128, n0 = nt * 128;
    f32x4 ag[4][4]; zero_acc(ag);
    float ss[4] = {0.f, 0.f, 0.f, 0.f};
    gemm_mainloop<0, true, true>(ag, hbB, nullptr, 1024, Wg, 1024, m0, n0, 1024, 0, smem, ss);
    finish_rstd(ss, smem);
    unsigned gp[4][4][2];
    {
      const float* rs = (const float*)smem;
#pragma unroll
      for (int m = 0; m < 4; ++m) {
        const float r = rs[wr * 64 + m * 16 + fr];
#pragma unroll
        for (int n = 0; n < 4; ++n) {
          gp[m][n][0] = pack2(sigmoid_f(r * ag[m][n][0]), sigmoid_f(r * ag[m][n][1]));
          gp[m][n][1] = pack2(sigmoid_f(r * ag[m][n][2]), sigmoid_f(r * ag[m][n][3]));
        }
      }
    }
    zero_acc(ag);
    float ss2[4] = {0.f, 0.f, 0.f, 0.f};
    gemm_mainloop<1, false, true>(ag, pin, nullptr, 256, Wup, 256, m0, n0, 256, 0, smem, ss2);
#pragma unroll
    for (int m = 0; m < 4; ++m) {
      const int rl = wr * 64 + m * 16 + fr;
#pragma unroll
      for (int n = 0; n < 4; ++n) {
        const int col = n0 + wc * 64 + n * 16 + fq * 4;
        const size_t idx = (size_t)(m0 + rl) * 1024 + col;
        const float4 h = *(const float4*)(hres + idx);
        float4 o;
        o.x = h.x + ag[m][n][0] * lo_f(gp[m][n][0]);
        o.y = h.y + ag[m][n][1] * hi_f(gp[m][n][0]);
        o.z = h.z + ag[m][n][2] * lo_f(gp[m][n][1]);
        o.w = h.w + ag[m][n][3] * hi_f(gp[m][n][1]);
        *(float4*)(hres + idx) = o;
        uint2 ob; ob.x = pack2(o.x, o.y); ob.y = pack2(o.z, o.w);
        *(uint2*)(hbA + idx) = ob;
      }
    }
  }
}

__device__ __forceinline__ void pool_phase(const bf16_t* XC, const bf16_t* Wp  , const float* pb, const float* ps, bf16_t* MC, unsigned char* smem) {
  const int tid = tid_fresh(), wid = tid >> 6, lane = tid & 63, wr = wid >> 1, wc = wid & 1, fr = lane & 15, fq = lane >> 4;
  for (int t = blockIdx.x; t < 2048; t += gridDim.x) {
    const int mt = t >> 3, g = (t >> 1) & 3, nt = t & 1, m0 = mt * 128, n0 = nt * 128;
    f32x4 acc[4][4]; zero_acc(acc);
    float ss[4] = {0.f, 0.f, 0.f, 0.f};
    gemm_mainloop<3, false, true>(acc, XC + g * 256, nullptr, 1024, Wp + (size_t)g * 65536, 256, m0, n0, 256, g, smem, ss);
#pragma unroll
    for (int m = 0; m < 4; ++m) {
      const int row = m0 + wr * 64 + m * 16 + fr;
#pragma unroll
      for (int n = 0; n < 4; ++n) {
        const int col = g * 256 + n0 + wc * 64 + n * 16 + fq * 4;
        const float4 b = *(const float4*)(pb + col), s = *(const float4*)(ps + col);
        uint2 o; o.x = pack2((acc[m][n][0] + b.x) * s.x, (acc[m][n][1] + b.y) * s.y); o.y = pack2((acc[m][n][2] + b.z) * s.z, (acc[m][n][3] + b.w) * s.w);
        *(uint2*)(MC + (size_t)row * 1024 + col) = o;
      }
    }
  }
}

__device__ __forceinline__ void gmlp_phase(bf16_t* UB, const bf16_t* VB, const bf16_t* Ws  , const float* gmg, const float* gbs  , unsigned char* smem) {
  const int tid = tid_fresh(), wid = tid >> 6, lane = tid & 63, wr = wid >> 1, wc = wid & 1, fr = lane & 15, fq = lane >> 4;
  unsigned char* sW = smem;
  unsigned char* sX = smem + 32768;
  float* rstd = (float*)(smem + 32768);
  for (int it = blockIdx.x; it < 2048; it += gridDim.x) {
    const int g = it & 7, tok0 = (it >> 3) * 128;
    __syncthreads();
    for (int r = wid; r < 128; r += 4) {
      const bf16_t* src = VB + (size_t)(tok0 + r) * 1024 + lane * 8;
      float f[8], s = 0.f;
      unpack8(*(const uint4*)src, f);
#pragma unroll
      for (int e = 0; e < 8; ++e) s += f[e] * f[e];
      unpack8(*(const uint4*)(src + 512), f);
#pragma unroll
      for (int e = 0; e < 8; ++e) s += f[e] * f[e];
#pragma unroll
      for (int o = 32; o > 0; o >>= 1) s += __shfl_xor(s, o);
      if (lane == 0) rstd[r] = rsqrtf(s * (1.f / 1024.f) + 1e-6f);
    }
#pragma unroll 2
    for (int i = 0; i < 8; ++i) {
      const int id = tid + 256 * i, row = id >> 4, kc = id & 15;
      *(uint4*)(sW + row * 256 + ((kc ^ (row & 15)) << 4)) = *(const uint4*)(Ws + (size_t)g * 16384 + row * 128 + kc * 8);
    }
    __syncthreads();
    const float rq = rstd[tid & 127];
    __syncthreads();
#pragma unroll 2
    for (int i = 0; i < 8; ++i) {
      const int id = tid + 256 * i, q = id & 127, cc = id >> 7;
      float f[8]; unpack8(*(const uint4*)(VB + (size_t)(tok0 + q) * 1024 + g * 128 + cc * 8), f);
#pragma unroll
      for (int e = 0; e < 8; ++e) {
        const int c = cc * 8 + e;
        const float v = f[e] * rq * gmg[g * 128 + c];
        *(bf16_t*)(sX + c * 256 + (((q >> 3) ^ (c & 15)) << 4) + (q & 7) * 2) = f2bf(v);
      }
    }
    __syncthreads();
    f32x4 acc[4][4]; zero_acc(acc);
#pragma unroll
    for (int s = 0; s < 4; ++s) {
      bf16x8 af[4], bfr[4];
#pragma unroll
      for (int m = 0; m < 4; ++m) { const int row = wr * 64 + m * 16 + fr; af[m] = *(const bf16x8*)(sW + row * 256 + (((s * 4 + fq) ^ (row & 15)) << 4)); }
#pragma unroll
      for (int n = 0; n < 4; ++n) { const int row = wc * 64 + n * 16 + fr; bfr[n] = *(const bf16x8*)(sX + row * 256 + (((s * 4 + fq) ^ (row & 15)) << 4)); }
#pragma unroll
      for (int m = 0; m < 4; ++m)
#pragma unroll
        for (int n = 0; n < 4; ++n) acc[m][n] = __builtin_amdgcn_mfma_f32_16x16x32_bf16(bfr[n], af[m], acc[m][n], 0, 0, 0);
    }
#pragma unroll
    for (int m = 0; m < 4; ++m) {
      const int p = wr * 64 + m * 16 + fr;
      const float bias = gbs[g * 128 + p];
#pragma unroll
      for (int n = 0; n < 4; ++n) {
        const int c = wc * 64 + n * 16 + fq * 4;
        bf16_t* pd = UB + (size_t)(tok0 + p) * 1024 + g * 128 + c;
        const uint2 u = *(const uint2*)pd;
        uint2 o; o.x = pack2(lo_f(u.x) * (acc[m][n][0] + bias), hi_f(u.x) * (acc[m][n][1] + bias));
        o.y = pack2(lo_f(u.y) * (acc[m][n][2] + bias), hi_f(u.y) * (acc[m][n][3] + bias));
        *(uint2*)pd = o;
      }
    }
  }
}

__device__ __forceinline__ void na_phase(bf16_t* Q, const bf16_t* Kb, const bf16_t* Vt, const float* rpb) {
  const int tid = tid_fresh(), wave = tid >> 6, lane = tid & 63, fr = lane & 15, fq = lane >> 4;
  const int nw = gridDim.x * 4;
  for (int it = blockIdx.x * 4 + wave; it < 8 * 64 * 16 * 4; it += nw) {
    const int wq = it & 3, h = (it >> 2) & 15, r = (it >> 6) & 63, b = it >> 12;
    const int rs = min(max(r - 4, 0), 56);
    const int w0 = (wq == 0) ? 0 : (wq == 1) ? 8 : (wq == 2) ? 24 : 32;
    const int qc = wq * 16 + fr;
    const int tokq = b * 4096 + r * 64 + qc;
    const bf16x8 qf0 = *(const bf16x8*)(Q + (size_t)tokq * 1024 + h * 64 + fq * 8);
    const bf16x8 qf1 = *(const bf16x8*)(Q + (size_t)tokq * 1024 + h * 64 + 32 + fq * 8);
    const int cs = min(max(qc - 8, 0), 48);
    const float* rp = rpb + h * (15 * 31);
    f32x4 sc[8][2];
    float mx = -1e30f;
#pragma unroll
    for (int jr = 0; jr < 8; ++jr) {
#pragma unroll
      for (int hc = 0; hc < 2; ++hc) {
        const int tokk = b * 4096 + (rs + jr) * 64 + w0 + hc * 16 + fr;
        const bf16x8 kf0 = *(const bf16x8*)(Kb + (size_t)tokk * 1024 + h * 64 + fq * 8);
        const bf16x8 kf1 = *(const bf16x8*)(Kb + (size_t)tokk * 1024 + h * 64 + 32 + fq * 8);
        f32x4 a = (f32x4){0.f, 0.f, 0.f, 0.f};
        a = __builtin_amdgcn_mfma_f32_16x16x32_bf16(kf0, qf0, a, 0, 0, 0);
        a = __builtin_amdgcn_mfma_f32_16x16x32_bf16(kf1, qf1, a, 0, 0, 0);
        const int dr = rs + jr - r + 7;
#pragma unroll
        for (int e = 0; e < 4; ++e) {
          const int kcol = w0 + hc * 16 + fq * 4 + e;
          const bool valid = (kcol >= cs) && (kcol < cs + 16);
          const int dc = min(max(kcol - qc + 15, 0), 30);
          const float v = valid ? (a[e] * 0.125f + rp[dr * 31 + dc]) : -1e30f;
          a[e] = v; mx = fmaxf(mx, v);
        }
        sc[jr][hc] = a;
      }
    }
    mx = fmaxf(mx, __shfl_xor(mx, 16)); mx = fmaxf(mx, __shfl_xor(mx, 32));
    float sum = 0.f;
#pragma unroll
    for (int jr = 0; jr < 8; ++jr)
#pragma unroll
      for (int hc = 0; hc < 2; ++hc)
#pragma unroll
        for (int e = 0; e < 4; ++e) { const float pv = (sc[jr][hc][e] > -1e29f) ? __expf(sc[jr][hc][e] - mx) : 0.f; sc[jr][hc][e] = pv; sum += pv; }
    sum += __shfl_xor(sum, 16); sum += __shfl_xor(sum, 32);
    const float inv = 1.f / sum;
    f32x4 o[4];
#pragma unroll
    for (int dt = 0; dt < 4; ++dt) o[dt] = (f32x4){0.f, 0.f, 0.f, 0.f};
#pragma unroll
    for (int jr = 0; jr < 8; ++jr) {
      union { bf16x8 v; unsigned u[4]; } pf;
      pf.u[0] = pack2(sc[jr][0][0] * inv, sc[jr][0][1] * inv); pf.u[1] = pack2(sc[jr][0][2] * inv, sc[jr][0][3] * inv);
      pf.u[2] = pack2(sc[jr][1][0] * inv, sc[jr][1][1] * inv); pf.u[3] = pack2(sc[jr][1][2] * inv, sc[jr][1][3] * inv);
      const size_t tk = (size_t)b * 4096 + (rs + jr) * 64 + w0 + fq * 4;
#pragma unroll
      for (int dt = 0; dt < 4; ++dt) {
        const bf16_t* vp = Vt + (size_t)(h * 64 + dt * 16 + fr) * TOK + tk;
        union { bf16x8 v; uint2 u[2]; } vf;
        vf.u[0] = *(const uint2*)vp; vf.u[1] = *(const uint2*)(vp + 16);
        o[dt] = __builtin_amdgcn_mfma_f32_16x16x32_bf16(vf.v, pf.v, o[dt], 0, 0, 0);
      }
    }
#pragma unroll
    for (int dt = 0; dt < 4; ++dt) {
      uint2 ob; ob.x = pack2(o[dt][0], o[dt][1]); ob.y = pack2(o[dt][2], o[dt][3]);
      *(uint2*)(Q + (size_t)tokq * 1024 + h * 64 + dt * 16 + fq * 4) = ob;
    }
  }
}

__device__ __forceinline__ float2 cmul(float2 a, float2 b) { return make_float2(a.x * b.x - a.y * b.y, a.x * b.y + a.y * b.x); }
__device__ __forceinline__ float2 cadd(float2 a, float2 b) { return make_float2(a.x + b.x, a.y + b.y); }
__device__ __forceinline__ float2 csub(float2 a, float2 b) { return make_float2(a.x - b.x, a.y - b.y); }

template <bool DIF>
__device__ __forceinline__ void bfly(float2& a, float2& b, float2 w) {
  if (DIF) { const float2 s = cadd(a, b), d = csub(a, b); a = s; b = cmul(d, w); }
  else { const float2 t = cmul(b, w); const float2 s = cadd(a, t), d = csub(a, t); a = s; b = d; }
}
template <bool DIF>
__device__ __forceinline__ void fft_r8(float2* buf, const float2* __restrict__ T, int lq) {
  const int q = 1 << lq, sA = 1024 >> lq;
  for (int g = tid_fresh(); g < 1024; g += NT) {
    const int j0 = g & (q - 1), i0 = ((g >> lq) << (lq + 3)) + j0;
    float2 x[8];
#pragma unroll
    for (int p = 0; p < 8; ++p) x[p] = buf[i0 + p * q];
    if (DIF) {
#pragma unroll
      for (int p = 0; p < 4; ++p) bfly<true>(x[p], x[p + 4], T[j0 * sA + p * 1024]);
#pragma unroll
      for (int p = 0; p < 2; ++p) { const float2 w = T[j0 * 2 * sA + p * 2048]; bfly<true>(x[p], x[p + 2], w); bfly<true>(x[4 + p], x[6 + p], w); }
      { const float2 w = T[j0 * 4 * sA]; bfly<true>(x[0], x[1], w); bfly<true>(x[2], x[3], w); bfly<true>(x[4], x[5], w); bfly<true>(x[6], x[7], w); }
    } else {
      { const float2 w = T[j0 * 4 * sA]; bfly<false>(x[0], x[1], w); bfly<false>(x[2], x[3], w); bfly<false>(x[4], x[5], w); bfly<false>(x[6], x[7], w); }
#pragma unroll
      for (int p = 0; p < 2; ++p) { const float2 w = T[j0 * 2 * sA + p * 2048]; bfly<false>(x[p], x[p + 2], w); bfly<false>(x[4 + p], x[6 + p], w); }
#pragma unroll
      for (int p = 0; p < 4; ++p) bfly<false>(x[p], x[p + 4], T[j0 * sA + p * 1024]);
    }
#pragma unroll
    for (int p = 0; p < 8; ++p) buf[i0 + p * q] = x[p];
  }
  __syncthreads();
}
__device__ __forceinline__ void fft_r2(float2* buf) {
  for (int g = tid_fresh(); g < 4096; g += NT) {
    const float4 v = ((const float4*)buf)[g];
    ((float4*)buf)[g] = make_float4(v.x + v.z, v.y + v.w, v.x - v.z, v.y - v.w);
  }
  __syncthreads();
}
__device__ __forceinline__ void fft_dif(float2* buf, const float2* T) { fft_r8<true>(buf, T, 10); fft_r8<true>(buf, T, 7); fft_r8<true>(buf, T, 4); fft_r8<true>(buf, T, 1); fft_r2(buf); }
__device__ __forceinline__ void fft_dit(float2* buf, const float2* T) { fft_r2(buf); fft_r8<false>(buf, T, 1); fft_r8<false>(buf, T, 4); fft_r8<false>(buf, T, 7); fft_r8<false>(buf, T, 10); }
__device__ __forceinline__ int brev13(int k) { return (int)(__brev((unsigned)k) >> 19); }

__device__ __forceinline__ void hyena_feats(float* h3, unsigned char* smem) {
  KP PP = params_fresh();
  float* hin = (float*)smem;
  const int tid = tid_fresh(), r = tid >> 6, u = tid & 63;
  for (int it = blockIdx.x; it < 2048; it += gridDim.x) {
    const int j = it >> 10, l = (it & 1023) * 4 + r;
    const float* w0 = PP->in[I_HW0] + j * 33 * 64; const float* b0 = PP->in[I_HB0] + j * 64;
    const float* w1 = PP->in[I_HW1] + j * 4096; const float* b1 = PP->in[I_HB1] + j * 64;
    const float* w2 = PP->in[I_HW2] + j * 4096; const float* b2 = PP->in[I_HB2] + j * 64;
    const float fr = PP->in[I_HFREQ][j * 64 + u];
    __syncthreads();
    {
      const float tt = (float)l / 4095.f;
      const float ang = 6.283185307179586f * (float)l / 4096.f;
      float f = 0.f;
      if (u == 0) f = tt;
      else if (u <= 16) { const float band = 1e-4f + (float)(u - 1) * ((15.f - 1e-4f) / 15.f); f = cosf(band * ang); }
      else if (u <= 32) { const float band = 1e-4f + (float)(u - 17) * ((15.f - 1e-4f) / 15.f); f = -sinf(band * ang); }
      hin[r * 64 + u] = f;
    }
    __syncthreads();
    float a = b0[u];
    for (int k = 0; k < 33; ++k) a += hin[r * 64 + k] * w0[k * 64 + u];
    float v = sinf(fr * a);
    __syncthreads(); hin[r * 64 + u] = v; __syncthreads();
    a = b1[u];
    for (int k = 0; k < 64; ++k) a += hin[r * 64 + k] * w1[k * 64 + u];
    v = sinf(fr * a);
    __syncthreads(); hin[r * 64 + u] = v; __syncthreads();
    a = b2[u];
    for (int k = 0; k < 64; ++k) a += hin[r * 64 + k] * w2[k * 64 + u];
    v = sinf(fr * a);
    h3[((size_t)j * 4096 + l) * 64 + u] = v;
  }
}

__device__ __forceinline__ void spectrum_phase(const float* hwout, int j, const float* h3, const float2* T, float4* spec, unsigned char* smem) {
  float2* buf = (float2*)smem;
  float* red = (float*)smem;
  const int tid = tid_fresh(), lane = tid & 63, wid = tid >> 6;
  const float* wout = hwout + (size_t)j * 64 * 2048;
  const float mind = logf(0.01f) / 1.5f, maxd = logf(0.01f) / 0.3f;
  for (int pi = blockIdx.x; pi < 512; pi += gridDim.x) {
    const int c1 = 2 * pi, c2 = c1 + 1;
    const float dl1 = fabsf(mind + (float)c1 * ((maxd - mind) / 1023.f)), dl2 = fabsf(mind + (float)c2 * ((maxd - mind) / 1023.f));
    __syncthreads();
    float s1 = 0.f, s2 = 0.f;
#pragma unroll 1
    for (int pass = 0; pass < 2; ++pass) {
#pragma unroll 1
      for (int i = 0; i < 16; ++i) {
        const int l = tid + 256 * i;
        const float* hr = h3 + ((size_t)j * 4096 + l) * 64;
        float a00 = 0.f, a01 = 0.f, a10 = 0.f, a11 = 0.f;
#pragma unroll 4
        for (int u = 0; u < 64; ++u) {
          const float hv = hr[u];
          const float* wr_ = wout + u * 2048;
          a00 += hv * wr_[c1]; a01 += hv * wr_[c2]; a10 += hv * wr_[1024 + c1]; a11 += hv * wr_[1024 + c2];
        }
        const float tt = (float)l / 4095.f;
        const float e1 = expf(-tt * dl1), e2 = expf(-tt * dl2);
        a00 *= e1; a10 *= e1; a01 *= e2; a11 *= e2;
        if (pass == 0) {
          s1 += a00 * a00; s2 += a01 * a01;
          if (l != 0) { s1 += a10 * a10; s2 += a11 * a11; }
        } else {
          buf[l] = make_float2(a00, a01);
          if (l == 0) buf[4096] = make_float2(0.f, 0.f);
          else buf[8192 - l] = make_float2(a10, a11);
        }
      }
      if (pass == 0) {
#pragma unroll
        for (int o = 32; o > 0; o >>= 1) { s1 += __shfl_xor(s1, o); s2 += __shfl_xor(s2, o); }
        if (lane == 0) { red[wid * 2] = s1; red[wid * 2 + 1] = s2; }
        __syncthreads();
        s1 = red[0] + red[2] + red[4] + red[6]; s2 = red[1] + red[3] + red[5] + red[7];
        __syncthreads();
      }
    }
    __syncthreads();
    const float sc1 = rsqrtf(s1 + 1e-6f) * (1.f / 8192.f);
    const float sc2 = rsqrtf(s2 + 1e-6f) * (1.f / 8192.f);
    fft_dif(buf, T);
    for (int k = tid; k <= 4096; k += NT) {
      const float2 Pk = buf[brev13(k)], Fn = buf[brev13((8192 - k) & 8191)];
      const float2 Qc = make_float2(Fn.x, -Fn.y);
      const float2 H1 = make_float2(0.5f * (Pk.x + Qc.x) * sc1, 0.5f * (Pk.y + Qc.y) * sc1);
      const float2 H2 = make_float2(0.5f * (Pk.y - Qc.y) * sc2, -0.5f * (Pk.x - Qc.x) * sc2);
      spec[(size_t)pi * SPEC_STRIDE + k] = make_float4(0.5f * (H1.x + H2.x), 0.5f * (H1.y + H2.y), 0.5f * (H1.x - H2.x), 0.5f * (H1.y - H2.y));
    }
  }
}

__device__ __forceinline__ void z_phase(const bf16_t* X1, const bf16_t* V, const float* cw  , const float* cb  , float* zT, unsigned char* smem) {
  float* zs = (float*)smem;
  const int tid = tid_fresh(), c8 = tid & 7, tr = tid >> 3;
  for (int it = blockIdx.x; it < 8192; it += gridDim.x) {
    const int ct = it & 15, tt = it >> 4, c0 = ct * 64, t0 = tt * 64;
    __syncthreads();
    const int c = c0 + c8 * 8;
    float w1[3][8], w2[3][8], bb1[8], bb2[8];
#pragma unroll
    for (int e = 0; e < 8; ++e) {
#pragma unroll
      for (int k = 0; k < 3; ++k) { w1[k][e] = cw[k * 3072 + 1024 + c + e]; w2[k][e] = cw[k * 3072 + 2048 + c + e]; }
      bb1[e] = cb[1024 + c + e]; bb2[e] = cb[2048 + c + e];
    }
#pragma unroll
    for (int i = 0; i < 2; ++i) {
      const int tl = tr + 32 * i, t = t0 + tl, tb = t & (SEQ - 1);
      float a1[8], a2[8];
#pragma unroll
      for (int e = 0; e < 8; ++e) { a1[e] = bb1[e]; a2[e] = bb2[e]; }
#pragma unroll
      for (int k = 0; k < 3; ++k) {
        const int tbk = tb + k - 1;
        if (tbk >= 0 && tbk < SEQ) {
          float f[8], g[8];
          unpack8(*(const uint4*)(X1 + (size_t)(t + k - 1) * 1024 + c), f);
          unpack8(*(const uint4*)(V + (size_t)(t + k - 1) * 1024 + c), g);
#pragma unroll
          for (int e = 0; e < 8; ++e) { a1[e] += w1[k][e] * f[e]; a2[e] += w2[k][e] * g[e]; }
        }
      }
#pragma unroll
      for (int e = 0; e < 8; ++e) zs[(c8 * 8 + e) * 65 + tl] = a1[e] * a2[e];
    }
    __syncthreads();
    {
      const int cl = tid >> 2, tq = tid & 3;
      const int bidx = t0 >> 12, tbase = t0 & (SEQ - 1);
      float* dst = zT + ((size_t)(bidx * 1024 + c0 + cl)) * SEQ + tbase + tq * 16;
#pragma unroll
      for (int v4 = 0; v4 < 4; ++v4) {
        const float* s = zs + cl * 65 + tq * 16 + v4 * 4;
        *(float4*)(dst + v4 * 4) = make_float4(s[0], s[1], s[2], s[3]);
      }
    }
  }
}

__device__ __forceinline__ void fftconv_phase(float* zT, const float4* spec, const float2* T, const float* hd, unsigned char* smem) {
  float2* buf = (float2*)smem;
  const int tid = tid_fresh();
  for (int it = blockIdx.x; it < 4096; it += gridDim.x) {
    const int b = it & 7, pi = it >> 3, c1 = 2 * pi;
    float* z1 = zT + ((size_t)(b * 1024 + c1)) * SEQ;
    float* z2 = z1 + SEQ;
    __syncthreads();
    for (int t = tid; t < 4096; t += NT) { buf[t] = make_float2(z1[t], z2[t]); buf[4096 + t] = make_float2(0.f, 0.f); }
    __syncthreads();
    fft_dif(buf, T);
    const float4* sp = spec + (size_t)pi * SPEC_STRIDE;
    for (int k = tid; k <= 4096; k += NT) {
      const int pk = brev13(k), pn = brev13((8192 - k) & 8191);
      const float2 Xk = buf[pk], Xn = buf[pn];
      const float4 sd = sp[k];
      const float2 S = make_float2(sd.x, sd.y), D = make_float2(sd.z, sd.w);
      const float2 Wk = cadd(cmul(Xk, S), cmul(make_float2(Xn.x, -Xn.y), D));
      const float2 Wn = cadd(cmul(Xn, make_float2(S.x, -S.y)), cmul(make_float2(Xk.x, -Xk.y), make_float2(D.x, -D.y)));
      buf[pk] = make_float2(Wk.x, -Wk.y);
      buf[pn] = make_float2(Wn.x, -Wn.y);
    }
    __syncthreads();
    fft_dit(buf, T);
    const float d1 = hd[c1], d2 = hd[c1 + 1];
    for (int t = tid; t < 4096; t += NT) {
      const float2 y = buf[t];
      z1[t] = y.x + d1 * z1[t];
      z2[t] = -y.y + d2 * z2[t];
    }
  }
}

__device__ __forceinline__ void ya_phase(const bf16_t* X0, const float* yT, const float* cw, const float* cb, bf16_t* MA, unsigned char* smem) {
  float* ys = (float*)smem;
  const int tid = tid_fresh(), c8 = tid & 7, tr = tid >> 3;
  for (int it = blockIdx.x; it < 8192; it += gridDim.x) {
    const int ct = it & 15, tt = it >> 4, c0 = ct * 64, t0 = tt * 64;
    __syncthreads();
    {
      const int cl = tid >> 2, tq = tid & 3;
      const int bidx = t0 >> 12, tbase = t0 & (SEQ - 1);
      const float* src = yT + ((size_t)(bidx * 1024 + c0 + cl)) * SEQ + tbase + tq * 16;
#pragma unroll
      for (int v4 = 0; v4 < 4; ++v4) {
        const float4 v = *(const float4*)(src + v4 * 4);
        float* s = ys + cl * 65 + tq * 16 + v4 * 4;
        s[0] = v.x; s[1] = v.y; s[2] = v.z; s[3] = v.w;
      }
    }
    __syncthreads();
    const int c = c0 + c8 * 8;
    float w0[3][8], bb[8];
#pragma unroll
    for (int e = 0; e < 8; ++e) {
#pragma unroll
      for (int k = 0; k < 3; ++k) w0[k][e] = cw[k * 3072 + c + e];
      bb[e] = cb[c + e];
    }
#pragma unroll
    for (int i = 0; i < 2; ++i) {
      const int tl = tr + 32 * i, t = t0 + tl, tb = t & (SEQ - 1);
      float a[8];
#pragma unroll
      for (int e = 0; e < 8; ++e) a[e] = bb[e];
#pragma unroll
      for (int k = 0; k < 3; ++k) {
        const int tbk = tb + k - 1;
        if (tbk >= 0 && tbk < SEQ) {
          float f[8];
          unpack8(*(const uint4*)(X0 + (size_t)(t + k - 1) * 1024 + c), f);
#pragma unroll
          for (int e = 0; e < 8; ++e) a[e] += w0[k][e] * f[e];
        }
      }
#pragma unroll
      for (int e = 0; e < 8; ++e) a[e] *= ys[(c8 * 8 + e) * 65 + tl];
      *(uint4*)(MA + (size_t)t * 1024 + c) = make_uint4(pack2(a[0], a[1]), pack2(a[2], a[3]), pack2(a[4], a[5]), pack2(a[6], a[7]));
    }
  }
}

__device__ __forceinline__ void convT_job(const float* src, int K, int N, bf16_t* dst, const float* scale, unsigned char* smem) {
  float* ts = (float*)smem;
  const int tid = tid_fresh();
  const int tn = N >> 6, ntile = (K >> 6) * tn;
  for (int it = blockIdx.x; it < ntile; it += gridDim.x) {
    const int k0 = (it / tn) * 64, n0 = (it % tn) * 64;
    __syncthreads();
#pragma unroll
    for (int i = 0; i < 4; ++i) {
      const int r = (tid >> 4) + 16 * i, c4 = tid & 15;
      float4 v = *(const float4*)(src + (size_t)(k0 + r) * N + n0 + c4 * 4);
      const float s = scale ? scale[k0 + r] : 1.f;
      float* d = ts + r * 65 + c4 * 4;
      d[0] = v.x * s; d[1] = v.y * s; d[2] = v.z * s; d[3] = v.w * s;
    }
    __syncthreads();
#pragma unroll
    for (int i = 0; i < 2; ++i) {
      const int id = tid + 256 * i, nn = id >> 3, kc = id & 7;
      float f[8];
#pragma unroll
      for (int e = 0; e < 8; ++e) f[e] = ts[(kc * 8 + e) * 65 + nn];
      *(uint4*)(dst + (size_t)(n0 + nn) * K + k0 + kc * 8) = make_uint4(pack2(f[0], f[1]), pack2(f[2], f[3]), pack2(f[4], f[5]), pack2(f[6], f[7]));
    }
  }
}
__device__ __forceinline__ void conv_plain(const float* src, bf16_t* dst, size_t n) {
  const size_t stride = (size_t)gridDim.x * NT * 8;
  for (size_t i = ((size_t)blockIdx.x * NT + tid_fresh()) * 8; i < n; i += stride) {
    const float4 a = *(const float4*)(src + i), b = *(const float4*)(src + i + 4);
    *(uint4*)(dst + i) = make_uint4(pack2(a.x, a.y), pack2(a.z, a.w), pack2(b.x, b.y), pack2(b.z, b.w));
  }
}

__device__ __forceinline__ void final_norm(float* h, const float* g) {
  const int tid = tid_fresh(), wave = tid >> 6, lane = tid & 63;
  for (int row = blockIdx.x * 4 + wave; row < TOK; row += gridDim.x * 4) {
    float* p = h + (size_t)row * 1024;
    float4 v[4]; float s = 0.f;
#pragma unroll
    for (int i = 0; i < 4; ++i) { v[i] = *(const float4*)(p + i * 256 + lane * 4); s += v[i].x * v[i].x + v[i].y * v[i].y + v[i].z * v[i].z + v[i].w * v[i].w; }
#pragma unroll
    for (int o = 32; o > 0; o >>= 1) s += __shfl_xor(s, o);
    const float r = rsqrtf(s * (1.f / 1024.f) + 1e-6f);
#pragma unroll
    for (int i = 0; i < 4; ++i) {
      const float4 gg = *(const float4*)(g + i * 256 + lane * 4);
      *(float4*)(p + i * 256 + lane * 4) = make_float4(v[i].x * r * gg.x, v[i].y * r * gg.y, v[i].z * r * gg.z, v[i].w * r * gg.w);
    }
  }
}

#define GSYNC() do { asm volatile("s_waitcnt vmcnt(0) lgkmcnt(0)" ::: "memory"); __builtin_amdgcn_fence(__ATOMIC_RELEASE, "agent"); asm volatile("s_waitcnt vmcnt(0)" ::: "memory"); grid.sync(); __builtin_amdgcn_fence(__ATOMIC_ACQUIRE, "agent"); } while (0)
#define WSP(off) (params_fresh()->ws + (off))
#define INP(i) (params_fresh()->in[i])
#define WBP ((bf16_t*)WSP(WB_OFF))
#define HBA ((bf16_t*)WSP(HBA_OFF))
#define SPECP ((float4*)WSP(SPEC_OFF))
#define H3P ((float*)WSP(H3_OFF))
#define TWP ((float2*)WSP(TW_OFF))
#define SLOT(i) ((bf16_t*)WSP(R_OFF + (size_t)(i) * 64 * MiB))
#define HRES (params_fresh()->out)

__global__ void __launch_bounds__(NT, 2) mega(Params Pdummy) {
  __shared__ __attribute__((aligned(16))) unsigned char smem[65536];
  cg::grid_group grid = cg::this_grid();

  for (int j = 0; j < 2; ++j) {
    convT_job(INP(I_EWIN) + (size_t)j * 1024 * 7168, 1024, 7168, WBP + W_EIN + (size_t)j * 7340032, INP(I_NORMG) + (2 * j) * 1024, smem);
    convT_job(INP(I_OWIN) + (size_t)j * 1024 * 6144, 1024, 6144, WBP + W_OIN + (size_t)j * 6291456, INP(I_NORMG) + (2 * j + 1) * 1024, smem);
    convT_job(INP(I_EWOUT) + (size_t)j * 2048 * 1024, 2048, 1024, WBP + W_EOUT + (size_t)j * 2097152, nullptr, smem);
    convT_job(INP(I_OWOUT) + (size_t)j * 2048 * 1024, 2048, 1024, WBP + W_OOUT + (size_t)j * 2097152, nullptr, smem);
    for (int g = 0; g < 4; ++g)
      convT_job(INP(I_POOLW) + (size_t)(j * 4 + g) * 65536, 256, 256, WBP + W_POOL + (size_t)(j * 4 + g) * 65536, nullptr, smem);
  }
  for (int i = 0; i < 4; ++i) {
    convT_job(INP(I_PGATE) + (size_t)i * 1048576, 1024, 1024, WBP + W_PGATE + (size_t)i * 1048576, INP(I_PLEG) + i * 1024, smem);
    convT_job(INP(I_PUP) + (size_t)i * 262144, 256, 1024, WBP + W_PUP + (size_t)i * 262144, nullptr, smem);
  }
  conv_plain(INP(I_GMWS), WBP + W_GMWS, 262144);
  conv_plain(INP(I_X), HBA, (size_t)TOK * 1024);
  hyena_feats(H3P, smem);
  {
    float2* T = TWP;
    for (int k = blockIdx.x * NT + tid_fresh(); k < 4096; k += gridDim.x * NT) {
      float s, c; sincospif((float)k / 4096.f, &s, &c);
      T[k] = make_float2(c, -s);
    }
  }
  GSYNC();

#pragma unroll 1
  for (int layer = 0; layer < 4; ++layer) {
    const int j = layer >> 1;
    if ((layer & 1) == 0) {
      spectrum_phase(INP(I_HWOUT), j, H3P, TWP, SPECP, smem);
      inproj_phase(HBA, WBP + W_EIN + (size_t)j * 7340032, 3, 0, 1024, 2048, 0, SLOT(0), SLOT(1), SLOT(2), nullptr, 0, 0, 0, 0, smem);
      GSYNC();
      z_phase(SLOT(1), SLOT(2), INP(I_CONVW) + (size_t)j * 9216, INP(I_CONVB) + (size_t)j * 3072, (float*)SLOT(3), smem);
      GSYNC();
      fftconv_phase((float*)SLOT(3), SPECP, TWP, INP(I_HD) + j * 1024, smem);
      GSYNC();
      ya_phase(SLOT(0), (const float*)SLOT(3), INP(I_CONVW) + (size_t)j * 9216, INP(I_CONVB) + (size_t)j * 3072, SLOT(1), smem);
      GSYNC();
      inproj_phase(HBA, WBP + W_EIN + (size_t)j * 7340032, 2, 4096, 5120, 0, 0, SLOT(0), SLOT(2), nullptr, nullptr, 0, 0, 0, 0, smem);
      GSYNC();
      gmlp_phase(SLOT(0), SLOT(2), WBP + W_GMWS + (size_t)j * 131072, INP(I_GMG) + j * 1024, INP(I_GMBS) + j * 1024, smem);
      GSYNC();
      inproj_phase(HBA, WBP + W_EIN + (size_t)j * 7340032, 2, 3072, 6144, 0, 0, SLOT(1), SLOT(0), nullptr, nullptr, 2, 2, 0, 0, smem);
      GSYNC();
      outproj_phase(SLOT(1), SLOT(0), WBP + W_EOUT + (size_t)j * 2097152, (layer == 0) ? INP(I_X) : (const float*)HRES, HRES, SLOT(3), smem);
      GSYNC();
      ple_phase(SLOT(3), INP(I_P) + (size_t)layer * TOK * 256, WBP + W_PGATE + (size_t)layer * 1048576, WBP + W_PUP + (size_t)layer * 262144, HRES, HBA, smem);
      GSYNC();
    } else {
      inproj_phase(HBA, WBP + W_OIN + (size_t)j * 6291456, 4, 0, 2048, 3072, 4096, SLOT(0), SLOT(1), SLOT(2), SLOT(3), 0, 0, 0, 1, smem);
      GSYNC();
      pool_phase(SLOT(0), WBP + W_POOL + (size_t)j * 262144, INP(I_POOLB) + j * 1024, INP(I_POOLS) + j * 1024, SLOT(4), smem);
      na_phase(SLOT(1), SLOT(2), SLOT(3), INP(I_RPB) + (size_t)j * 16 * 15 * 31);
      GSYNC();
      inproj_phase(HBA, WBP + W_OIN + (size_t)j * 6291456, 2, 1024, 5120, 0, 0, SLOT(4), SLOT(1), nullptr, nullptr, 2, 2, 0, 0, smem);
      GSYNC();
      outproj_phase(SLOT(4), SLOT(1), WBP + W_OOUT + (size_t)j * 2097152, HRES, HRES, SLOT(2), smem);
      GSYNC();
      ple_phase(SLOT(2), INP(I_P) + (size_t)layer * TOK * 256, WBP + W_PGATE + (size_t)layer * 1048576, WBP + W_PUP + (size_t)layer * 262144, HRES, HBA, smem);
      GSYNC();
    }
  }
  final_norm(HRES, INP(I_FINALG));
}

extern "C" void kernel_launch(void* const* d_in, const int* in_sizes, int n_in, void* d_out, int out_size, void* d_ws, size_t ws_size, hipStream_t stream) {
  static int grid_blocks = 0;
  if (grid_blocks == 0) {
    if (n_in != 29 || out_size != TOK * 1024 || ws_size < WS_END) { fprintf(stderr, "kernel_launch: unexpected shapes (n_in %d out %d ws %zu)\n", n_in, out_size, ws_size); grid_blocks = -1; return; }
    int dev = 0, cus = 0, per_cu = 0;
    if (hipGetDevice(&dev) != hipSuccess || hipDeviceGetAttribute(&cus, hipDeviceAttributeMultiprocessorCount, dev) != hipSuccess) { grid_blocks = -1; return; }
    if (hipOccupancyMaxActiveBlocksPerMultiprocessor(&per_cu, (const void*)mega, NT, LDS_BYTES) != hipSuccess || per_cu < 1) { fprintf(stderr, "occupancy query failed\n"); per_cu = 1; }
    if (per_cu > 2) per_cu = 2;
    grid_blocks = cus * per_cu;
  }
  if (grid_blocks < 0) return;
  Params p{};
  for (int i = 0; i < 29; ++i) p.in[i] = (const float*)d_in[i];
  p.out = (float*)d_out; p.ws = (unsigned char*)d_ws;
  void* args[] = {&p};
  hipError_t e = hipLaunchCooperativeKernel((const void*)mega, dim3(grid_blocks), dim3(NT), args, LDS_BYTES, stream);
  if (e != hipSuccess) fprintf(stderr, "cooperative launch failed: %s (grid %d)\n", hipGetErrorString(e), grid_blocks);
}
```

```cpp
#include <hip/hip_runtime.h>
#include <hip/hip_cooperative_groups.h>
#include <cstdio>
namespace cg = cooperative_groups;

typedef unsigned short bf16_t;
typedef short bf16x8 __attribute__((ext_vector_type(8)));
typedef short bf16x4 __attribute__((ext_vector_type(4)));
typedef float f32x4 __attribute__((ext_vector_type(4)));

#define NT 256
constexpr int LDS_BYTES = 0;
constexpr size_t MiB = 1u << 20;
constexpr size_t WB_OFF = 0, HBA_OFF = 80 * MiB, SPEC_OFF = 144 * MiB, H3_OFF = 177 * MiB, TW_OFF = 179 * MiB, R_OFF = 180 * MiB, WS_END = 500 * MiB;
constexpr int TOK = 32768, SEQ = 4096, DM = 1024;
constexpr size_t W_EIN = 0, W_OIN = 14680064, W_EOUT = 27262976, W_OOUT = 31457280, W_PGATE = 35651584, W_PUP = 39845888, W_POOL = 40894464, W_GMWS = 41418752;
constexpr int SPEC_STRIDE = 4104;

struct Params { const float* in[29]; float* out; unsigned char* ws; };
enum { I_X = 0, I_P, I_NORMG, I_FINALG, I_EWIN, I_CONVW, I_CONVB, I_HW0, I_HB0, I_HW1, I_HB1, I_HW2, I_HB2, I_HWOUT, I_HFREQ, I_HD, I_GMG, I_GMWS, I_GMBS, I_EWOUT, I_OWIN, I_POOLW, I_POOLB, I_POOLS, I_RPB, I_OWOUT, I_PUP, I_PGATE, I_PLEG };

__device__ __forceinline__ unsigned short f2bf(float f) { unsigned u = __float_as_uint(f); u += 0x7fffu + ((u >> 16) & 1u); return (unsigned short)(u >> 16); }
__device__ __forceinline__ float bf2f(unsigned short h) { return __uint_as_float(((unsigned)h) << 16); }
__device__ __forceinline__ unsigned pack2(float lo, float hi) { return (unsigned)f2bf(lo) | ((unsigned)f2bf(hi) << 16); }
__device__ __forceinline__ float lo_f(unsigned u) { return __uint_as_float(u << 16); }
__device__ __forceinline__ float hi_f(unsigned u) { return __uint_as_float(u & 0xffff0000u); }
__device__ __forceinline__ float silu_f(float v) { return v / (1.f + __expf(-v)); }
__device__ __forceinline__ float sigmoid_f(float v) { return 1.f / (1.f + __expf(-v)); }
__device__ __forceinline__ void unpack8(const uint4& u, float* f) { f[0] = lo_f(u.x); f[1] = hi_f(u.x); f[2] = lo_f(u.y); f[3] = hi_f(u.y); f[4] = lo_f(u.z); f[5] = hi_f(u.z); f[6] = lo_f(u.w); f[7] = hi_f(u.w); }

typedef const Params __attribute__((address_space(4)))* KP;
__device__ __forceinline__ KP params_fresh() { KP p = (KP)__builtin_amdgcn_kernarg_segment_ptr(); asm volatile("" : "+s"(p)); return p; }
__device__ __forceinline__ int tid_fresh() { int t = threadIdx.x; asm volatile("" : "+v"(t)); return t; }

__device__ __forceinline__ int swz(int row, int kc) { return row * 128 + ((kc ^ ((row >> 1) & 7)) << 4); }

template <int AM, bool SS>
__device__ __forceinline__ void load_a1(int tid, uint4& out, float& ssq, const void* A0, const void* A1, int lda, int row, int k0, int aux) {
  const int kc = tid & 7;
  if (AM == 0) {
    out = *(const uint4*)((const bf16_t*)A0 + (size_t)row * lda + k0 + kc * 8);
  } else if (AM == 2) {
    const bf16_t* src = (k0 < 1024) ? (const bf16_t*)A0 : (const bf16_t*)A1;
    out = *(const uint4*)(src + (size_t)row * lda + (k0 & 1023) + kc * 8);
  } else if (AM == 1) {
    const float* src = (const float*)A0 + (size_t)row * lda + k0 + kc * 8;
    const float4 a = *(const float4*)src, b = *(const float4*)(src + 4);
    out = make_uint4(pack2(a.x, a.y), pack2(a.z, a.w), pack2(b.x, b.y), pack2(b.z, b.w));
  } else {
    const bf16_t* src = (const bf16_t*)A0 + k0 + kc * 8;
    const int half = 1 << aux;
    const int tb = row & (SEQ - 1), base = row - tb;
    const int lo = max(tb - half, 0), hi = min(tb + half, SEQ);
    float s0 = 0.f, s1 = 0.f, s2 = 0.f, s3 = 0.f, s4 = 0.f, s5 = 0.f, s6 = 0.f, s7 = 0.f;
    const int cnt = hi - lo;
    const bf16_t* wp = src + (size_t)(base + lo) * lda;
#pragma unroll 1
    for (int d0 = 0; d0 < cnt; d0 += 8) {
      uint4 wv[8];
#pragma unroll
      for (int d = 0; d < 8; ++d) wv[d] = (d0 + d < cnt) ? *(const uint4*)(wp + (size_t)(d0 + d) * lda) : make_uint4(0u, 0u, 0u, 0u);
#pragma unroll
      for (int d = 0; d < 8; ++d) {
        s0 += lo_f(wv[d].x); s1 += hi_f(wv[d].x); s2 += lo_f(wv[d].y); s3 += hi_f(wv[d].y); s4 += lo_f(wv[d].z); s5 += hi_f(wv[d].z); s6 += lo_f(wv[d].w); s7 += hi_f(wv[d].w);
      }
    }
    const uint4 u = *(const uint4*)(src + (size_t)row * lda);
    const float inv = 1.f / (float)(hi - lo);
    out = make_uint4(pack2(s0 * inv - lo_f(u.x), s1 * inv - hi_f(u.x)), pack2(s2 * inv - lo_f(u.y), s3 * inv - hi_f(u.y)),
                     pack2(s4 * inv - lo_f(u.z), s5 * inv - hi_f(u.z)), pack2(s6 * inv - lo_f(u.w), s7 * inv - hi_f(u.w)));
  }
}
template <int AM, bool SS>
__device__ __forceinline__ void load_a(int tid, uint4& a0, uint4& a1, uint4& a2, uint4& a3, const void* A0, const void* A1, int lda, int m0, int k0, int aux, float (&ss)[4]) {
  const int row = m0 + (tid >> 3);
  load_a1<AM, SS>(tid, a0, ss[0], A0, A1, lda, row, k0, aux);
  load_a1<AM, SS>(tid, a1, ss[1], A0, A1, lda, row + 32, k0, aux);
  load_a1<AM, SS>(tid, a2, ss[2], A0, A1, lda, row + 64, k0, aux);
  load_a1<AM, SS>(tid, a3, ss[3], A0, A1, lda, row + 96, k0, aux);
}
__device__ __forceinline__ void load_b(int tid, uint4& b0, uint4& b1, uint4& b2, uint4& b3, const bf16_t* Bt, int ldb, int n0, int k0) {
  const bf16_t* p = Bt + (size_t)(n0 + (tid >> 3)) * ldb + k0 + (tid & 7) * 8;
  b0 = *(const uint4*)p; b1 = *(const uint4*)(p + (size_t)32 * ldb); b2 = *(const uint4*)(p + (size_t)64 * ldb); b3 = *(const uint4*)(p + (size_t)96 * ldb);
}
__device__ __forceinline__ void store_tile(int tid, unsigned char* dst, const uint4& r0v, const uint4& r1v, const uint4& r2v, const uint4& r3v) {
  const int r0 = tid >> 3, kc = tid & 7;
  *(uint4*)(dst + swz(r0, kc)) = r0v; *(uint4*)(dst + swz(r0 + 32, kc)) = r1v; *(uint4*)(dst + swz(r0 + 64, kc)) = r2v; *(uint4*)(dst + swz(r0 + 96, kc)) = r3v;
}

__device__ __forceinline__ float ssq8(const uint4& v) {
  const float f0 = lo_f(v.x), f1 = hi_f(v.x), f2 = lo_f(v.y), f3 = hi_f(v.y), f4 = lo_f(v.z), f5 = hi_f(v.z), f6 = lo_f(v.w), f7 = hi_f(v.w);
  return f0 * f0 + f1 * f1 + f2 * f2 + f3 * f3 + f4 * f4 + f5 * f5 + f6 * f6 + f7 * f7;
}
template <bool SS>
__device__ __forceinline__ void store_a(int tid, unsigned char* dst, const uint4& a0, const uint4& a1, const uint4& a2, const uint4& a3, float (&ss)[4]) {
  if (SS) { ss[0] += ssq8(a0); ss[1] += ssq8(a1); ss[2] += ssq8(a2); ss[3] += ssq8(a3); }
  store_tile(tid, dst, a0, a1, a2, a3);
}
template <bool SWAP>
__device__ __forceinline__ void mma_tile(f32x4 (&acc)[4][4], const unsigned char* cur, int wr, int wc, int fr, int fq) {
#pragma unroll
  for (int s = 0; s < 2; ++s) {
    bf16x8 af[4], bfr[4];
#pragma unroll
    for (int m = 0; m < 4; ++m) af[m] = *(const bf16x8*)(cur + swz(wr * 64 + m * 16 + fr, s * 4 + fq));
#pragma unroll
    for (int n = 0; n < 4; ++n) bfr[n] = *(const bf16x8*)(cur + 16384 + swz(wc * 64 + n * 16 + fr, s * 4 + fq));
#pragma unroll
    for (int m = 0; m < 4; ++m)
#pragma unroll
      for (int n = 0; n < 4; ++n)
        acc[m][n] = SWAP ? __builtin_amdgcn_mfma_f32_16x16x32_bf16(bfr[n], af[m], acc[m][n], 0, 0, 0)
                         : __builtin_amdgcn_mfma_f32_16x16x32_bf16(af[m], bfr[n], acc[m][n], 0, 0, 0);
  }
}
template <int AM, bool SS, bool SWAP>
__device__ __forceinline__ void gemm_mainloop(f32x4 (&acc)[4][4], const void* A0, const void* A1, int lda, const bf16_t* Bt, int ldb,
                                              int m0, int n0, int K, int aux, unsigned char* smem, float (&ss)[4], int rot) {
  const int tid = tid_fresh(), wid = tid >> 6, lane = tid & 63, wr = wid >> 1, wc = wid & 1, fr = lane & 15, fq = lane >> 4;
  const int nk = K >> 6, km = nk - 1;
  unsigned char* L0 = smem;
  unsigned char* L1 = smem + 32768;
  uint4 a0, a1, a2, a3, b0, b1, b2, b3;
  __syncthreads();
  if (AM == 0 || AM == 2) {
    uint4 c0, c1, c2, c3, d0, d1, d2, d3;
    load_a<AM, SS>(tid, a0, a1, a2, a3, A0, A1, lda, m0, (rot & km) << 6, aux, ss);
    load_b(tid, b0, b1, b2, b3, Bt, ldb, n0, (rot & km) << 6);
    load_a<AM, SS>(tid, c0, c1, c2, c3, A0, A1, lda, m0, ((1 + rot) & km) << 6, aux, ss);
    load_b(tid, d0, d1, d2, d3, Bt, ldb, n0, ((1 + rot) & km) << 6);
    store_a<SS>(tid, L0, a0, a1, a2, a3, ss); store_tile(tid, L0 + 16384, b0, b1, b2, b3);
    __syncthreads();
    for (int kt = 0; kt < nk; kt += 2) {
      const int k2 = ((min(kt + 2, km) + rot) & km) << 6, k3 = ((min(kt + 3, km) + rot) & km) << 6;
      load_a<AM, SS>(tid, a0, a1, a2, a3, A0, A1, lda, m0, k2, aux, ss); load_b(tid, b0, b1, b2, b3, Bt, ldb, n0, k2);
      __builtin_amdgcn_sched_barrier(0);
      mma_tile<SWAP>(acc, L0, wr, wc, fr, fq);
      store_a<SS>(tid, L1, c0, c1, c2, c3, ss); store_tile(tid, L1 + 16384, d0, d1, d2, d3);
      __syncthreads();
      load_a<AM, SS>(tid, c0, c1, c2, c3, A0, A1, lda, m0, k3, aux, ss); load_b(tid, d0, d1, d2, d3, Bt, ldb, n0, k3);
      __builtin_amdgcn_sched_barrier(0);
      mma_tile<SWAP>(acc, L1, wr, wc, fr, fq);
      if (SS) { if (kt + 2 < nk) { ss[0] += ssq8(a0); ss[1] += ssq8(a1); ss[2] += ssq8(a2); ss[3] += ssq8(a3); } }
      store_tile(tid, L0, a0, a1, a2, a3); store_tile(tid, L0 + 16384, b0, b1, b2, b3);
      __syncthreads();
    }
    asm volatile("s_waitcnt vmcnt(0)" ::: "memory");
  } else {
    load_a<AM, SS>(tid, a0, a1, a2, a3, A0, A1, lda, m0, (rot & km) << 6, aux, ss);
    load_b(tid, b0, b1, b2, b3, Bt, ldb, n0, (rot & km) << 6);
    store_a<SS>(tid, L0, a0, a1, a2, a3, ss); store_tile(tid, L0 + 16384, b0, b1, b2, b3);
    __syncthreads();
    for (int kt = 0; kt < nk; ++kt) {
      unsigned char* cur = smem + (kt & 1) * 32768;
      unsigned char* nxt = smem + ((kt + 1) & 1) * 32768;
      const bool more = (kt + 1 < nk);
      if (more) { load_a<AM, SS>(tid, a0, a1, a2, a3, A0, A1, lda, m0, ((kt + 1 + rot) & km) << 6, aux, ss); load_b(tid, b0, b1, b2, b3, Bt, ldb, n0, ((kt + 1 + rot) & km) << 6); }
      mma_tile<SWAP>(acc, cur, wr, wc, fr, fq);
      if (more) { store_a<SS>(tid, nxt, a0, a1, a2, a3, ss); store_tile(tid, nxt + 16384, b0, b1, b2, b3); }
      __syncthreads();
    }
  }
}
__device__ __forceinline__ void finish_rstd(float (&ss)[4], unsigned char* smem) {
  const int tid = tid_fresh(), r0 = tid >> 3, kc = tid & 7;
  float* rs = (float*)smem;
#pragma unroll
  for (int i = 0; i < 4; ++i) {
    float v = ss[i];
    v += __shfl_xor(v, 1); v += __shfl_xor(v, 2); v += __shfl_xor(v, 4);
    if (kc == 0) rs[r0 + 32 * i] = rsqrtf(v * (1.f / 1024.f) + 1e-6f);
  }
  __syncthreads();
}
__device__ __forceinline__ void zero_acc(f32x4 (&acc)[4][4]) {
#pragma unroll
  for (int m = 0; m < 4; ++m)
#pragma unroll
    for (int n = 0; n < 4; ++n) acc[m][n] = (f32x4){0.f, 0.f, 0.f, 0.f};
}

__device__ __forceinline__ void inproj_phase(const bf16_t* hb, const bf16_t* W, int ng, int wr0, int wr1, int wr2, int wr3,
                             bf16_t* d0, bf16_t* d1, bf16_t* d2, bf16_t* d3, int md0, int md1, int md2, int md3, unsigned char* smem) {
  const int tid = tid_fresh(), wid = tid >> 6, lane = tid & 63, wr = wid >> 1, wc = wid & 1, fr = lane & 15, fq = lane >> 4;
  const int per_m = ng * 8, ntiles = 256 * per_m;
  for (int t = blockIdx.x; t < ntiles; t += gridDim.x) {
    const int mt = t / per_m, rem = t - mt * per_m, grp = rem >> 3, nt = rem & 7;
    const int wrow = grp == 0 ? wr0 : grp == 1 ? wr1 : grp == 2 ? wr2 : wr3;
    bf16_t* dst = grp == 0 ? d0 : grp == 1 ? d1 : grp == 2 ? d2 : d3;
    const int mode = grp == 0 ? md0 : grp == 1 ? md1 : grp == 2 ? md2 : md3;
    const int m0 = mt * 128, n0 = nt * 128;
    f32x4 acc[4][4]; zero_acc(acc);
    float ss[4] = {0.f, 0.f, 0.f, 0.f};
    if (mode == 1) {
      gemm_mainloop<0, true, false>(acc, hb, nullptr, 1024, W + (size_t)wrow * 1024, 1024, m0, n0, 1024, 0, smem, ss, t * 5 + (t >> 3));
      finish_rstd(ss, smem);
      const float* rs = (const float*)smem;
#pragma unroll
      for (int m = 0; m < 4; ++m) {
        const int rl = wr * 64 + m * 16 + fq * 4;
        const float r0 = rs[rl], r1 = rs[rl + 1], r2 = rs[rl + 2], r3 = rs[rl + 3];
#pragma unroll
        for (int n = 0; n < 4; ++n) {
          const int col = n0 + wc * 64 + n * 16 + fr;
          uint2 o; o.x = pack2(acc[m][n][0] * r0, acc[m][n][1] * r1); o.y = pack2(acc[m][n][2] * r2, acc[m][n][3] * r3);
          *(uint2*)(dst + (size_t)col * TOK + m0 + rl) = o;
        }
      }
    } else {
      gemm_mainloop<0, true, true>(acc, hb, nullptr, 1024, W + (size_t)wrow * 1024, 1024, m0, n0, 1024, 0, smem, ss, t * 5 + (t >> 3));
      finish_rstd(ss, smem);
      const float* rs = (const float*)smem;
      uint2 old[4][4];
      if (mode == 2) {
#pragma unroll
        for (int m = 0; m < 4; ++m)
#pragma unroll
          for (int n = 0; n < 4; ++n) old[m][n] = *(const uint2*)(dst + (size_t)(m0 + wr * 64 + m * 16 + fr) * 1024 + n0 + wc * 64 + n * 16 + fq * 4);
      }
#pragma unroll
      for (int m = 0; m < 4; ++m) {
        const int rl = wr * 64 + m * 16 + fr;
        const float r = rs[rl];
#pragma unroll
        for (int n = 0; n < 4; ++n) {
          const int col = n0 + wc * 64 + n * 16 + fq * 4;
          bf16_t* pd = dst + (size_t)(m0 + rl) * 1024 + col;
          float v0 = acc[m][n][0] * r, v1 = acc[m][n][1] * r, v2 = acc[m][n][2] * r, v3 = acc[m][n][3] * r;
          if (mode == 2) {
            v0 = lo_f(old[m][n].x) * silu_f(v0); v1 = hi_f(old[m][n].x) * silu_f(v1); v2 = lo_f(old[m][n].y) * silu_f(v2); v3 = hi_f(old[m][n].y) * silu_f(v3);
          }
          uint2 o; o.x = pack2(v0, v1); o.y = pack2(v2, v3);
          *(uint2*)pd = o;
        }
      }
    }
  }
}

__device__ __forceinline__ void outproj_phase(const bf16_t* MA, const bf16_t* MB, const bf16_t* Wt  , const float* hsrc, float* hres, bf16_t* hbB, unsigned char* smem) {
  const int tid = tid_fresh(), wid = tid >> 6, lane = tid & 63, wr = wid >> 1, wc = wid & 1, fr = lane & 15, fq = lane >> 4;
  for (int t = blockIdx.x; t < 2048; t += gridDim.x) {
    const int mt = t >> 3, nt = t & 7, m0 = mt * 128, n0 = nt * 128;
    f32x4 acc[4][4]; zero_acc(acc);
    float ss[4] = {0.f, 0.f, 0.f, 0.f};
    gemm_mainloop<2, false, true>(acc, MA, MB, 1024, Wt, 2048, m0, n0, 2048, 0, smem, ss, t * 5 + (t >> 3));
#pragma unroll
    for (int m = 0; m < 4; ++m) {
      const int row = m0 + wr * 64 + m * 16 + fr;
      const size_t idx = (size_t)row * 1024 + n0 + wc * 64 + fq * 4;
      float4 h[4];
#pragma unroll
      for (int n = 0; n < 4; ++n) h[n] = *(const float4*)(hsrc + idx + n * 16);
#pragma unroll
      for (int n = 0; n < 4; ++n) {
        const float4 o = make_float4(h[n].x + acc[m][n][0], h[n].y + acc[m][n][1], h[n].z + acc[m][n][2], h[n].w + acc[m][n][3]);
        *(float4*)(hres + idx + n * 16) = o;
        uint2 ob; ob.x = pack2(o.x, o.y); ob.y = pack2(o.z, o.w);
        *(uint2*)(hbB + idx + n * 16) = ob;
      }
    }
  }
}

__device__ __forceinline__ void ple_phase(const bf16_t* hbB, const float* pin  , const bf16_t* Wg  , const bf16_t* Wup  ,
                          float* hres, bf16_t* hbA, unsigned char* smem) {
  const int tid = tid_fresh(), wid = tid >> 6, lane = tid & 63, wr = wid >> 1, wc = wid & 1, fr = lane & 15, fq = lane >> 4;
  for (int t = blockIdx.x; t < 2048; t += gridDim.x) {
    const int mt = t >> 3, nt = t & 7, m0 = mt * 128, n0 = nt * 128;
    f32x4 ag[4][4]; zero_acc(ag);
    float ss[4] = {0.f, 0.f, 0.f, 0.f};
    gemm_mainloop<0, true, true>(ag, hbB, nullptr, 1024, Wg, 1024, m0, n0, 1024, 0, smem, ss, t * 5 + (t >> 3));
    finish_rstd(ss, smem);
    unsigned gp[4][4][2];
    {
      const float* rs = (const float*)smem;
#pragma unroll
      for (int m = 0; m < 4; ++m) {
        const float r = rs[wr * 64 + m * 16 + fr];
#pragma unroll
        for (int n = 0; n < 4; ++n) {
          gp[m][n][0] = pack2(sigmoid_f(r * ag[m][n][0]), sigmoid_f(r * ag[m][n][1]));
          gp[m][n][1] = pack2(sigmoid_f(r * ag[m][n][2]), sigmoid_f(r * ag[m][n][3]));
        }
      }
    }
    zero_acc(ag);
    float ss2[4] = {0.f, 0.f, 0.f, 0.f};
    gemm_mainloop<1, false, true>(ag, pin, nullptr, 256, Wup, 256, m0, n0, 256, 0, smem, ss2, t + (t >> 2));
#pragma unroll
    for (int m = 0; m < 4; ++m) {
      const int rl = wr * 64 + m * 16 + fr;
      const size_t idx = (size_t)(m0 + rl) * 1024 + n0 + wc * 64 + fq * 4;
      float4 h[4];
#pragma unroll
      for (int n = 0; n < 4; ++n) h[n] = *(const float4*)(hres + idx + n * 16);
#pragma unroll
      for (int n = 0; n < 4; ++n) {
        float4 o;
        o.x = h[n].x + ag[m][n][0] * lo_f(gp[m][n][0]);
        o.y = h[n].y + ag[m][n][1] * hi_f(gp[m][n][0]);
        o.z = h[n].z + ag[m][n][2] * lo_f(gp[m][n][1]);
        o.w = h[n].w + ag[m][n][3] * hi_f(gp[m][n][1]);
        *(float4*)(hres + idx + n * 16) = o;
        uint2 ob; ob.x = pack2(o.x, o.y); ob.y = pack2(o.z, o.w);
        *(uint2*)(hbA + idx + n * 16) = ob;
      }
    }
  }
}

__device__ __forceinline__ void pool_phase(const bf16_t* XC, const bf16_t* Wp  , const float* pb, const float* ps, bf16_t* MC, unsigned char* smem) {
  const int tid = tid_fresh(), wid = tid >> 6, lane = tid & 63, wr = wid >> 1, wc = wid & 1, fr = lane & 15, fq = lane >> 4;
  for (int t = blockIdx.x; t < 2048; t += gridDim.x) {
    const int mt = t >> 3, g = (t >> 1) & 3, nt = t & 1, m0 = mt * 128, n0 = nt * 128;
    f32x4 acc[4][4]; zero_acc(acc);
    float ss[4] = {0.f, 0.f, 0.f, 0.f};
    gemm_mainloop<3, false, true>(acc, XC + g * 256, nullptr, 1024, Wp + (size_t)g * 65536, 256, m0, n0, 256, g, smem, ss, t + (t >> 2));
#pragma unroll
    for (int m = 0; m < 4; ++m) {
      const int row = m0 + wr * 64 + m * 16 + fr;
#pragma unroll
      for (int n = 0; n < 4; ++n) {
        const int col = g * 256 + n0 + wc * 64 + n * 16 + fq * 4;
        const float4 b = *(const float4*)(pb + col), s = *(const float4*)(ps + col);
        uint2 o; o.x = pack2((acc[m][n][0] + b.x) * s.x, (acc[m][n][1] + b.y) * s.y); o.y = pack2((acc[m][n][2] + b.z) * s.z, (acc[m][n][3] + b.w) * s.w);
        *(uint2*)(MC + (size_t)row * 1024 + col) = o;
      }
    }
  }
}

__device__ __forceinline__ void gmlp_phase(bf16_t* UB, const bf16_t* VB, const bf16_t* Ws  , const float* gmg, const float* gbs  , unsigned char* smem) {
  const int tid = tid_fresh(), wid = tid >> 6, lane = tid & 63, wr = wid >> 1, wc = wid & 1, fr = lane & 15, fq = lane >> 4;
  unsigned char* sW = smem;
  unsigned char* sX = smem + 32768;
  float* rstd = (float*)(smem + 32768);
  for (int it = blockIdx.x; it < 2048; it += gridDim.x) {
    const int g = it & 7, tok0 = (it >> 3) * 128;
    __syncthreads();
    for (int r = wid; r < 128; r += 4) {
      const bf16_t* src = VB + (size_t)(tok0 + r) * 1024 + lane * 8;
      float f[8], s = 0.f;
      unpack8(*(const uint4*)src, f);
#pragma unroll
      for (int e = 0; e < 8; ++e) s += f[e] * f[e];
      unpack8(*(const uint4*)(src + 512), f);
#pragma unroll
      for (int e = 0; e < 8; ++e) s += f[e] * f[e];
#pragma unroll
      for (int o = 32; o > 0; o >>= 1) s += __shfl_xor(s, o);
      if (lane == 0) rstd[r] = rsqrtf(s * (1.f / 1024.f) + 1e-6f);
    }
#pragma unroll 2
    for (int i = 0; i < 8; ++i) {
      const int id = tid + 256 * i, row = id >> 4, kc = id & 15;
      *(uint4*)(sW + row * 256 + ((kc ^ (row & 15)) << 4)) = *(const uint4*)(Ws + (size_t)g * 16384 + row * 128 + kc * 8);
    }
    __syncthreads();
    const float rq = rstd[tid & 127];
    __syncthreads();
#pragma unroll 2
    for (int i = 0; i < 8; ++i) {
      const int id = tid + 256 * i, q = id & 127, cc = id >> 7;
      float f[8]; unpack8(*(const uint4*)(VB + (size_t)(tok0 + q) * 1024 + g * 128 + cc * 8), f);
#pragma unroll
      for (int e = 0; e < 8; ++e) {
        const int c = cc * 8 + e;
        const float v = f[e] * rq * gmg[g * 128 + c];
        *(bf16_t*)(sX + c * 256 + (((q >> 3) ^ (c & 15)) << 4) + (q & 7) * 2) = f2bf(v);
      }
    }
    __syncthreads();
    f32x4 acc[4][4]; zero_acc(acc);
#pragma unroll
    for (int s = 0; s < 4; ++s) {
      bf16x8 af[4], bfr[4];
#pragma unroll
      for (int m = 0; m < 4; ++m) { const int row = wr * 64 + m * 16 + fr; af[m] = *(const bf16x8*)(sW + row * 256 + (((s * 4 + fq) ^ (row & 15)) << 4)); }
#pragma unroll
      for (int n = 0; n < 4; ++n) { const int row = wc * 64 + n * 16 + fr; bfr[n] = *(const bf16x8*)(sX + row * 256 + (((s * 4 + fq) ^ (row & 15)) << 4)); }
#pragma unroll
      for (int m = 0; m < 4; ++m)
#pragma unroll
        for (int n = 0; n < 4; ++n) acc[m][n] = __builtin_amdgcn_mfma_f32_16x16x32_bf16(bfr[n], af[m], acc[m][n], 0, 0, 0);
    }
    uint2 uo[4][4];
#pragma unroll
    for (int m = 0; m < 4; ++m)
#pragma unroll
      for (int n = 0; n < 4; ++n) uo[m][n] = *(const uint2*)(UB + (size_t)(tok0 + wr * 64 + m * 16 + fr) * 1024 + g * 128 + wc * 64 + n * 16 + fq * 4);
#pragma unroll
    for (int m = 0; m < 4; ++m) {
      const int p = wr * 64 + m * 16 + fr;
      const float bias = gbs[g * 128 + p];
#pragma unroll
      for (int n = 0; n < 4; ++n) {
        const int c = wc * 64 + n * 16 + fq * 4;
        bf16_t* pd = UB + (size_t)(tok0 + p) * 1024 + g * 128 + c;
        const uint2 u = uo[m][n];
        uint2 o; o.x = pack2(lo_f(u.x) * (acc[m][n][0] + bias), hi_f(u.x) * (acc[m][n][1] + bias));
        o.y = pack2(lo_f(u.y) * (acc[m][n][2] + bias), hi_f(u.y) * (acc[m][n][3] + bias));
        *(uint2*)pd = o;
      }
    }
  }
}

__device__ __forceinline__ void na_phase(bf16_t* Q, const bf16_t* Kb, const bf16_t* Vt, const float* rpb) {
  const int tid = tid_fresh(), wave = tid >> 6, lane = tid & 63, fr = lane & 15, fq = lane >> 4;
  const int nw = gridDim.x * 4;
  for (int it = blockIdx.x * 4 + wave; it < 8 * 64 * 16 * 4; it += nw) {
    const int wq = it & 3, h = (it >> 2) & 15, r = (it >> 6) & 63, b = it >> 12;
    const int rs = min(max(r - 4, 0), 56);
    const int w0 = (wq == 0) ? 0 : (wq == 1) ? 8 : (wq == 2) ? 24 : 32;
    const int qc = wq * 16 + fr;
    const int tokq = b * 4096 + r * 64 + qc;
    const bf16x8 qf0 = *(const bf16x8*)(Q + (size_t)tokq * 1024 + h * 64 + fq * 8);
    const bf16x8 qf1 = *(const bf16x8*)(Q + (size_t)tokq * 1024 + h * 64 + 32 + fq * 8);
    const int cs = min(max(qc - 8, 0), 48);
    const float* rp = rpb + h * (15 * 31);
    f32x4 sc[8][2];
    float mx = -1e30f;
#pragma unroll
    for (int hb = 0; hb < 2; ++hb) {
      bf16x8 kf[4][2][2];
#pragma unroll
      for (int j4 = 0; j4 < 4; ++j4)
#pragma unroll
        for (int hc = 0; hc < 2; ++hc) {
          const int tokk = b * 4096 + (rs + hb * 4 + j4) * 64 + w0 + hc * 16 + fr;
          kf[j4][hc][0] = *(const bf16x8*)(Kb + (size_t)tokk * 1024 + h * 64 + fq * 8);
          kf[j4][hc][1] = *(const bf16x8*)(Kb + (size_t)tokk * 1024 + h * 64 + 32 + fq * 8);
        }
      __builtin_amdgcn_sched_barrier(0);
#pragma unroll
      for (int j4 = 0; j4 < 4; ++j4) {
        const int jr = hb * 4 + j4;
#pragma unroll
        for (int hc = 0; hc < 2; ++hc) {
          f32x4 a = (f32x4){0.f, 0.f, 0.f, 0.f};
          a = __builtin_amdgcn_mfma_f32_16x16x32_bf16(kf[j4][hc][0], qf0, a, 0, 0, 0);
          a = __builtin_amdgcn_mfma_f32_16x16x32_bf16(kf[j4][hc][1], qf1, a, 0, 0, 0);
          const int dr = rs + jr - r + 7;
#pragma unroll
          for (int e = 0; e < 4; ++e) {
            const int kcol = w0 + hc * 16 + fq * 4 + e;
            const bool valid = (kcol >= cs) && (kcol < cs + 16);
            const int dc = min(max(kcol - qc + 15, 0), 30);
            const float v = valid ? (a[e] * 0.125f + rp[dr * 31 + dc]) : -1e30f;
            a[e] = v; mx = fmaxf(mx, v);
          }
          sc[jr][hc] = a;
        }
      }
    }
    mx = fmaxf(mx, __shfl_xor(mx, 16)); mx = fmaxf(mx, __shfl_xor(mx, 32));
    float sum = 0.f;
#pragma unroll
    for (int jr = 0; jr < 8; ++jr)
#pragma unroll
      for (int hc = 0; hc < 2; ++hc)
#pragma unroll
        for (int e = 0; e < 4; ++e) { const float pv = (sc[jr][hc][e] > -1e29f) ? __expf(sc[jr][hc][e] - mx) : 0.f; sc[jr][hc][e] = pv; sum += pv; }
    sum += __shfl_xor(sum, 16); sum += __shfl_xor(sum, 32);
    const float inv = 1.f / sum;
    f32x4 o[4];
#pragma unroll
    for (int dt = 0; dt < 4; ++dt) o[dt] = (f32x4){0.f, 0.f, 0.f, 0.f};
#pragma unroll
    for (int jp = 0; jp < 4; ++jp) {
      union { bf16x8 v; uint2 u[2]; } vf[2][4];
#pragma unroll
      for (int j2 = 0; j2 < 2; ++j2) {
        const size_t tk = (size_t)b * 4096 + (rs + jp * 2 + j2) * 64 + w0 + fq * 4;
#pragma unroll
        for (int dt = 0; dt < 4; ++dt) {
          const bf16_t* vp = Vt + (size_t)(h * 64 + dt * 16 + fr) * TOK + tk;
          vf[j2][dt].u[0] = *(const uint2*)vp; vf[j2][dt].u[1] = *(const uint2*)(vp + 16);
        }
      }
      __builtin_amdgcn_sched_barrier(0);
#pragma unroll
      for (int j2 = 0; j2 < 2; ++j2) {
        const int jr = jp * 2 + j2;
        union { bf16x8 v; unsigned u[4]; } pf;
        pf.u[0] = pack2(sc[jr][0][0] * inv, sc[jr][0][1] * inv); pf.u[1] = pack2(sc[jr][0][2] * inv, sc[jr][0][3] * inv);
        pf.u[2] = pack2(sc[jr][1][0] * inv, sc[jr][1][1] * inv); pf.u[3] = pack2(sc[jr][1][2] * inv, sc[jr][1][3] * inv);
#pragma unroll
        for (int dt = 0; dt < 4; ++dt) o[dt] = __builtin_amdgcn_mfma_f32_16x16x32_bf16(vf[j2][dt].v, pf.v, o[dt], 0, 0, 0);
      }
    }
#pragma unroll
    for (int dt = 0; dt < 4; ++dt) {
      uint2 ob; ob.x = pack2(o[dt][0], o[dt][1]); ob.y = pack2(o[dt][2], o[dt][3]);
      *(uint2*)(Q + (size_t)tokq * 1024 + h * 64 + dt * 16 + fq * 4) = ob;
    }
  }
}

__device__ __forceinline__ float2 cmul(float2 a, float2 b) { return make_float2(a.x * b.x - a.y * b.y, a.x * b.y + a.y * b.x); }
__device__ __forceinline__ float2 cadd(float2 a, float2 b) { return make_float2(a.x + b.x, a.y + b.y); }
__device__ __forceinline__ float2 csub(float2 a, float2 b) { return make_float2(a.x - b.x, a.y - b.y); }

template <bool DIF>
__device__ __forceinline__ void bfly(float2& a, float2& b, float2 w) {
  if (DIF) { const float2 s = cadd(a, b), d = csub(a, b); a = s; b = cmul(d, w); }
  else { const float2 t = cmul(b, w); const float2 s = cadd(a, t), d = csub(a, t); a = s; b = d; }
}
template <bool DIF>
__device__ __forceinline__ void fft_r8(float2* buf, const float2* __restrict__ T, int lq) {
  const int q = 1 << lq, sA = 1024 >> lq;
  for (int g = tid_fresh(); g < 1024; g += NT) {
    const int j0 = g & (q - 1), i0 = ((g >> lq) << (lq + 3)) + j0;
    float2 x[8];
#pragma unroll
    for (int p = 0; p < 8; ++p) x[p] = buf[i0 + p * q];
    if (DIF) {
#pragma unroll
      for (int p = 0; p < 4; ++p) bfly<true>(x[p], x[p + 4], T[j0 * sA + p * 1024]);
#pragma unroll
      for (int p = 0; p < 2; ++p) { const float2 w = T[j0 * 2 * sA + p * 2048]; bfly<true>(x[p], x[p + 2], w); bfly<true>(x[4 + p], x[6 + p], w); }
      { const float2 w = T[j0 * 4 * sA]; bfly<true>(x[0], x[1], w); bfly<true>(x[2], x[3], w); bfly<true>(x[4], x[5], w); bfly<true>(x[6], x[7], w); }
    } else {
      { const float2 w = T[j0 * 4 * sA]; bfly<false>(x[0], x[1], w); bfly<false>(x[2], x[3], w); bfly<false>(x[4], x[5], w); bfly<false>(x[6], x[7], w); }
#pragma unroll
      for (int p = 0; p < 2; ++p) { const float2 w = T[j0 * 2 * sA + p * 2048]; bfly<false>(x[p], x[p + 2], w); bfly<false>(x[4 + p], x[6 + p], w); }
#pragma unroll
      for (int p = 0; p < 4; ++p) bfly<false>(x[p], x[p + 4], T[j0 * sA + p * 1024]);
    }
#pragma unroll
    for (int p = 0; p < 8; ++p) buf[i0 + p * q] = x[p];
  }
  __syncthreads();
}
__device__ __forceinline__ void fft_r2(float2* buf) {
  for (int g = tid_fresh(); g < 4096; g += NT) {
    const float4 v = ((const float4*)buf)[g];
    ((float4*)buf)[g] = make_float4(v.x + v.z, v.y + v.w, v.x - v.z, v.y - v.w);
  }
  __syncthreads();
}
__device__ __forceinline__ void fft_dif(float2* buf, const float2* T) { fft_r8<true>(buf, T, 10); fft_r8<true>(buf, T, 7); fft_r8<true>(buf, T, 4); fft_r8<true>(buf, T, 1); fft_r2(buf); }
__device__ __forceinline__ void fft_dit(float2* buf, const float2* T) { fft_r2(buf); fft_r8<false>(buf, T, 1); fft_r8<false>(buf, T, 4); fft_r8<false>(buf, T, 7); fft_r8<false>(buf, T, 10); }
__device__ __forceinline__ int brev13(int k) { return (int)(__brev((unsigned)k) >> 19); }

__device__ __forceinline__ void hyena_feats(float* h3, unsigned char* smem) {
  KP PP = params_fresh();
  float* hin = (float*)smem;
  const int tid = tid_fresh(), r = tid >> 6, u = tid & 63;
  for (int it = blockIdx.x; it < 2048; it += gridDim.x) {
    const int j = it >> 10, l = (it & 1023) * 4 + r;
    const float* w0 = PP->in[I_HW0] + j * 33 * 64; const float* b0 = PP->in[I_HB0] + j * 64;
    const float* w1 = PP->in[I_HW1] + j * 4096; const float* b1 = PP->in[I_HB1] + j * 64;
    const float* w2 = PP->in[I_HW2] + j * 4096; const float* b2 = PP->in[I_HB2] + j * 64;
    const float fr = PP->in[I_HFREQ][j * 64 + u];
    __syncthreads();
    {
      const float tt = (float)l / 4095.f;
      const float ang = 6.283185307179586f * (float)l / 4096.f;
      float f = 0.f;
      if (u == 0) f = tt;
      else if (u <= 16) { const float band = 1e-4f + (float)(u - 1) * ((15.f - 1e-4f) / 15.f); f = cosf(band * ang); }
      else if (u <= 32) { const float band = 1e-4f + (float)(u - 17) * ((15.f - 1e-4f) / 15.f); f = -sinf(band * ang); }
      hin[r * 64 + u] = f;
    }
    __syncthreads();
    float a = b0[u];
    for (int k = 0; k < 33; ++k) a += hin[r * 64 + k] * w0[k * 64 + u];
    float v = sinf(fr * a);
    __syncthreads(); hin[r * 64 + u] = v; __syncthreads();
    a = b1[u];
    for (int k = 0; k < 64; ++k) a += hin[r * 64 + k] * w1[k * 64 + u];
    v = sinf(fr * a);
    __syncthreads(); hin[r * 64 + u] = v; __syncthreads();
    a = b2[u];
    for (int k = 0; k < 64; ++k) a += hin[r * 64 + k] * w2[k * 64 + u];
    v = sinf(fr * a);
    h3[((size_t)j * 4096 + l) * 64 + u] = v;
  }
}

__device__ __forceinline__ void filtgen_phase(const float* hwout, int j, const float* h3, float* kT, unsigned char* smem) {
  float* hs = (float*)smem;
  float* wsm = (float*)(smem + 32768);
  const int tid = tid_fresh(), tl = tid & 15, tc = tid >> 4;
  const float* wout = hwout + (size_t)j * 64 * 2048;
  const float mind = logf(0.01f) / 1.5f, maxd = logf(0.01f) / 0.3f;
  for (int it = blockIdx.x; it < 2048; it += gridDim.x) {
    const int l0 = (it & 63) * 64, c0 = (it >> 6) * 64;
    __syncthreads();
#pragma unroll
    for (int i = 0; i < 4; ++i) {
      const int id = tid + 256 * i, r = id >> 4, c4 = id & 15;
      const float4 hv = *(const float4*)(h3 + ((size_t)j * 4096 + l0 + r) * 64 + c4 * 4);
      float* d = hs + r * 65 + c4 * 4; d[0] = hv.x; d[1] = hv.y; d[2] = hv.z; d[3] = hv.w;
      *(float4*)(wsm + r * 64 + c4 * 4) = *(const float4*)(wout + (size_t)r * 2048 + c0 + c4 * 4);
    }
    __syncthreads();
    float acc[4][4];
#pragma unroll
    for (int i = 0; i < 4; ++i)
#pragma unroll
      for (int k = 0; k < 4; ++k) acc[i][k] = 0.f;
#pragma unroll 4
    for (int u = 0; u < 64; ++u) {
      const float4 w = *(const float4*)(wsm + u * 64 + tc * 4);
#pragma unroll
      for (int i = 0; i < 4; ++i) {
        const float hv = hs[(tl * 4 + i) * 65 + u];
        acc[i][0] += hv * w.x; acc[i][1] += hv * w.y; acc[i][2] += hv * w.z; acc[i][3] += hv * w.w;
      }
    }
#pragma unroll
    for (int k = 0; k < 4; ++k) {
      const int col = c0 + tc * 4 + k, c = col & 1023;
      const float dl = fabsf(mind + (float)c * ((maxd - mind) / 1023.f));
      float4 o;
      o.x = acc[0][k] * expf(-((float)(l0 + tl * 4 + 0) / 4095.f) * dl);
      o.y = acc[1][k] * expf(-((float)(l0 + tl * 4 + 1) / 4095.f) * dl);
      o.z = acc[2][k] * expf(-((float)(l0 + tl * 4 + 2) / 4095.f) * dl);
      o.w = acc[3][k] * expf(-((float)(l0 + tl * 4 + 3) / 4095.f) * dl);
      *(float4*)(kT + (size_t)col * 4096 + l0 + tl * 4) = o;
    }
  }
}

__device__ __forceinline__ void spectrum_phase(const float* kT, const float2* T, float4* spec, unsigned char* smem) {
  float2* buf = (float2*)smem;
  float* red = (float*)smem;
  const int tid = tid_fresh(), lane = tid & 63, wid = tid >> 6;
  for (int pi = blockIdx.x; pi < 512; pi += gridDim.x) {
    const int c1 = 2 * pi;
    const float* f0 = kT + (size_t)c1 * 4096;
    const float* b0 = kT + (size_t)(1024 + c1) * 4096;
    __syncthreads();
    float s1 = 0.f, s2 = 0.f;
#pragma unroll 4
    for (int i = 0; i < 16; ++i) {
      const int l = tid + 256 * i;
      const float a00 = f0[l], a01 = f0[4096 + l], a10 = b0[l], a11 = b0[4096 + l];
      s1 += a00 * a00; s2 += a01 * a01;
      if (l != 0) { s1 += a10 * a10; s2 += a11 * a11; }
    }
#pragma unroll
    for (int o = 32; o > 0; o >>= 1) { s1 += __shfl_xor(s1, o); s2 += __shfl_xor(s2, o); }
    if (lane == 0) { red[wid * 2] = s1; red[wid * 2 + 1] = s2; }
    __syncthreads();
    s1 = red[0] + red[2] + red[4] + red[6]; s2 = red[1] + red[3] + red[5] + red[7];
    __syncthreads();
#pragma unroll 4
    for (int i = 0; i < 16; ++i) {
      const int l = tid + 256 * i;
      const float a00 = f0[l], a01 = f0[4096 + l], a10 = b0[l], a11 = b0[4096 + l];
      buf[l] = make_float2(a00, a01);
      if (l == 0) buf[4096] = make_float2(0.f, 0.f);
      else buf[8192 - l] = make_float2(a10, a11);
    }
    __syncthreads();
    const float sc1 = rsqrtf(s1 + 1e-6f) * (1.f / 8192.f);
    const float sc2 = rsqrtf(s2 + 1e-6f) * (1.f / 8192.f);
    fft_dif(buf, T);
    for (int k = tid; k <= 4096; k += NT) {
      const float2 Pk = buf[brev13(k)], Fn = buf[brev13((8192 - k) & 8191)];
      const float2 Qc = make_float2(Fn.x, -Fn.y);
      const float2 H1 = make_float2(0.5f * (Pk.x + Qc.x) * sc1, 0.5f * (Pk.y + Qc.y) * sc1);
      const float2 H2 = make_float2(0.5f * (Pk.y - Qc.y) * sc2, -0.5f * (Pk.x - Qc.x) * sc2);
      spec[(size_t)pi * SPEC_STRIDE + k] = make_float4(0.5f * (H1.x + H2.x), 0.5f * (H1.y + H2.y), 0.5f * (H1.x - H2.x), 0.5f * (H1.y - H2.y));
    }
  }
}

__device__ __forceinline__ void z_phase(const bf16_t* X1, const bf16_t* V, const float* cw  , const float* cb  , float* zT, unsigned char* smem) {
  float* zs = (float*)smem;
  const int tid = tid_fresh(), c8 = tid & 7, tr = tid >> 3;
  for (int it = blockIdx.x; it < 8192; it += gridDim.x) {
    const int ct = it & 15, tt = it >> 4, c0 = ct * 64, t0 = tt * 64;
    __syncthreads();
    const int c = c0 + c8 * 8;
    float w1[3][8], w2[3][8], bb1[8], bb2[8];
#pragma unroll
    for (int e = 0; e < 8; ++e) {
#pragma unroll
      for (int k = 0; k < 3; ++k) { w1[k][e] = cw[k * 3072 + 1024 + c + e]; w2[k][e] = cw[k * 3072 + 2048 + c + e]; }
      bb1[e] = cb[1024 + c + e]; bb2[e] = cb[2048 + c + e];
    }
#pragma unroll
    for (int i = 0; i < 2; ++i) {
      const int tl = tr + 32 * i, t = t0 + tl, tb = t & (SEQ - 1);
      float a1[8], a2[8];
#pragma unroll
      for (int e = 0; e < 8; ++e) { a1[e] = bb1[e]; a2[e] = bb2[e]; }
#pragma unroll
      for (int k = 0; k < 3; ++k) {
        const int tbk = tb + k - 1;
        if (tbk >= 0 && tbk < SEQ) {
          float f[8], g[8];
          unpack8(*(const uint4*)(X1 + (size_t)(t + k - 1) * 1024 + c), f);
          unpack8(*(const uint4*)(V + (size_t)(t + k - 1) * 1024 + c), g);
#pragma unroll
          for (int e = 0; e < 8; ++e) { a1[e] += w1[k][e] * f[e]; a2[e] += w2[k][e] * g[e]; }
        }
      }
#pragma unroll
      for (int e = 0; e < 8; ++e) zs[(c8 * 8 + e) * 65 + tl] = a1[e] * a2[e];
    }
    __syncthreads();
    {
      const int cl = tid >> 2, tq = tid & 3;
      const int bidx = t0 >> 12, tbase = t0 & (SEQ - 1);
      float* dst = zT + ((size_t)(bidx * 1024 + c0 + cl)) * SEQ + tbase + tq * 16;
#pragma unroll
      for (int v4 = 0; v4 < 4; ++v4) {
        const float* s = zs + cl * 65 + tq * 16 + v4 * 4;
        *(float4*)(dst + v4 * 4) = make_float4(s[0], s[1], s[2], s[3]);
      }
    }
  }
}

__device__ __forceinline__ void fftconv_phase(float* zT, const float4* spec, const float2* T, const float* hd, unsigned char* smem) {
  float2* buf = (float2*)smem;
  const int tid = tid_fresh();
  for (int it = blockIdx.x; it < 4096; it += gridDim.x) {
    const int b = it & 7, pi = it >> 3, c1 = 2 * pi;
    float* z1 = zT + ((size_t)(b * 1024 + c1)) * SEQ;
    float* z2 = z1 + SEQ;
    __syncthreads();
    for (int t = tid; t < 4096; t += NT) { buf[t] = make_float2(z1[t], z2[t]); buf[4096 + t] = make_float2(0.f, 0.f); }
    __syncthreads();
    fft_dif(buf, T);
    const float4* sp = spec + (size_t)pi * SPEC_STRIDE;
    for (int k = tid; k <= 4096; k += NT) {
      const int pk = brev13(k), pn = brev13((8192 - k) & 8191);
      const float2 Xk = buf[pk], Xn = buf[pn];
      const float4 sd = sp[k];
      const float2 S = make_float2(sd.x, sd.y), D = make_float2(sd.z, sd.w);
      const float2 Wk = cadd(cmul(Xk, S), cmul(make_float2(Xn.x, -Xn.y), D));
      const float2 Wn = cadd(cmul(Xn, make_float2(S.x, -S.y)), cmul(make_float2(Xk.x, -Xk.y), make_float2(D.x, -D.y)));
      buf[pk] = make_float2(Wk.x, -Wk.y);
      buf[pn] = make_float2(Wn.x, -Wn.y);
    }
    __syncthreads();
    fft_dit(buf, T);
    const float d1 = hd[c1], d2 = hd[c1 + 1];
    for (int t = tid; t < 4096; t += NT) {
      const float2 y = buf[t];
      z1[t] = y.x + d1 * z1[t];
      z2[t] = -y.y + d2 * z2[t];
    }
  }
}

__device__ __forceinline__ void ya_phase(const bf16_t* X0, const float* yT, const float* cw, const float* cb, bf16_t* MA, unsigned char* smem) {
  float* ys = (float*)smem;
  const int tid = tid_fresh(), c8 = tid & 7, tr = tid >> 3;
  for (int it = blockIdx.x; it < 8192; it += gridDim.x) {
    const int ct = it & 15, tt = it >> 4, c0 = ct * 64, t0 = tt * 64;
    __syncthreads();
    {
      const int cl = tid >> 2, tq = tid & 3;
      const int bidx = t0 >> 12, tbase = t0 & (SEQ - 1);
      const float* src = yT + ((size_t)(bidx * 1024 + c0 + cl)) * SEQ + tbase + tq * 16;
#pragma unroll
      for (int v4 = 0; v4 < 4; ++v4) {
        const float4 v = *(const float4*)(src + v4 * 4);
        float* s = ys + cl * 65 + tq * 16 + v4 * 4;
        s[0] = v.x; s[1] = v.y; s[2] = v.z; s[3] = v.w;
      }
    }
    __syncthreads();
    const int c = c0 + c8 * 8;
    float w0[3][8], bb[8];
#pragma unroll
    for (int e = 0; e < 8; ++e) {
#pragma unroll
      for (int k = 0; k < 3; ++k) w0[k][e] = cw[k * 3072 + c + e];
      bb[e] = cb[c + e];
    }
#pragma unroll
    for (int i = 0; i < 2; ++i) {
      const int tl = tr + 32 * i, t = t0 + tl, tb = t & (SEQ - 1);
      float a[8];
#pragma unroll
      for (int e = 0; e < 8; ++e) a[e] = bb[e];
#pragma unroll
      for (int k = 0; k < 3; ++k) {
        const int tbk = tb + k - 1;
        if (tbk >= 0 && tbk < SEQ) {
          float f[8];
          unpack8(*(const uint4*)(X0 + (size_t)(t + k - 1) * 1024 + c), f);
#pragma unroll
          for (int e = 0; e < 8; ++e) a[e] += w0[k][e] * f[e];
        }
      }
#pragma unroll
      for (int e = 0; e < 8; ++e) a[e] *= ys[(c8 * 8 + e) * 65 + tl];
      *(uint4*)(MA + (size_t)t * 1024 + c) = make_uint4(pack2(a[0], a[1]), pack2(a[2], a[3]), pack2(a[4], a[5]), pack2(a[6], a[7]));
    }
  }
}

__device__ __forceinline__ void convT_job(const float* src, int K, int N, bf16_t* dst, const float* scale, unsigned char* smem) {
  float* ts = (float*)smem;
  const int tid = tid_fresh();
  const int tn = N >> 6, ntile = (K >> 6) * tn;
  for (int it = blockIdx.x; it < ntile; it += gridDim.x) {
    const int k0 = (it / tn) * 64, n0 = (it % tn) * 64;
    __syncthreads();
#pragma unroll
    for (int i = 0; i < 4; ++i) {
      const int r = (tid >> 4) + 16 * i, c4 = tid & 15;
      float4 v = *(const float4*)(src + (size_t)(k0 + r) * N + n0 + c4 * 4);
      const float s = scale ? scale[k0 + r] : 1.f;
      float* d = ts + r * 65 + c4 * 4;
      d[0] = v.x * s; d[1] = v.y * s; d[2] = v.z * s; d[3] = v.w * s;
    }
    __syncthreads();
#pragma unroll
    for (int i = 0; i < 2; ++i) {
      const int id = tid + 256 * i, nn = id >> 3, kc = id & 7;
      float f[8];
#pragma unroll
      for (int e = 0; e < 8; ++e) f[e] = ts[(kc * 8 + e) * 65 + nn];
      *(uint4*)(dst + (size_t)(n0 + nn) * K + k0 + kc * 8) = make_uint4(pack2(f[0], f[1]), pack2(f[2], f[3]), pack2(f[4], f[5]), pack2(f[6], f[7]));
    }
  }
}
__device__ __forceinline__ void conv_plain(const float* src, bf16_t* dst, size_t n) {
  const size_t stride = (size_t)gridDim.x * NT * 8;
  for (size_t i = ((size_t)blockIdx.x * NT + tid_fresh()) * 8; i < n; i += stride) {
    const float4 a = *(const float4*)(src + i), b = *(const float4*)(src + i + 4);
    *(uint4*)(dst + i) = make_uint4(pack2(a.x, a.y), pack2(a.z, a.w), pack2(b.x, b.y), pack2(b.z, b.w));
  }
}

__device__ __forceinline__ void final_norm(float* h, const float* g) {
  const int tid = tid_fresh(), wave = tid >> 6, lane = tid & 63;
  for (int row = blockIdx.x * 4 + wave; row < TOK; row += gridDim.x * 4) {
    float* p = h + (size_t)row * 1024;
    float4 v[4]; float s = 0.f;
#pragma unroll
    for (int i = 0; i < 4; ++i) { v[i] = *(const float4*)(p + i * 256 + lane * 4); s += v[i].x * v[i].x + v[i].y * v[i].y + v[i].z * v[i].z + v[i].w * v[i].w; }
#pragma unroll
    for (int o = 32; o > 0; o >>= 1) s += __shfl_xor(s, o);
    const float r = rsqrtf(s * (1.f / 1024.f) + 1e-6f);
#pragma unroll
    for (int i = 0; i < 4; ++i) {
      const float4 gg = *(const float4*)(g + i * 256 + lane * 4);
      *(float4*)(p + i * 256 + lane * 4) = make_float4(v[i].x * r * gg.x, v[i].y * r * gg.y, v[i].z * r * gg.z, v[i].w * r * gg.w);
    }
  }
}

#define GSYNC() do { asm volatile("s_waitcnt vmcnt(0) lgkmcnt(0)" ::: "memory"); __builtin_amdgcn_fence(__ATOMIC_RELEASE, "agent"); asm volatile("s_waitcnt vmcnt(0)" ::: "memory"); grid.sync(); __builtin_amdgcn_fence(__ATOMIC_ACQUIRE, "agent"); } while (0)
#define WSP(off) (params_fresh()->ws + (off))
#define INP(i) (params_fresh()->in[i])
#define WBP ((bf16_t*)WSP(WB_OFF))
#define HBA ((bf16_t*)WSP(HBA_OFF))
#define SPECP ((float4*)WSP(SPEC_OFF))
#define H3P ((float*)WSP(H3_OFF))
#define TWP ((float2*)WSP(TW_OFF))
#define SLOT(i) ((bf16_t*)WSP(R_OFF + (size_t)(i) * 64 * MiB))
#define HRES (params_fresh()->out)

__global__ void __launch_bounds__(NT, 2) mega(Params Pdummy) {
  __shared__ __attribute__((aligned(16))) unsigned char smem[65536];
  cg::grid_group grid = cg::this_grid();

  for (int j = 0; j < 2; ++j) {
    convT_job(INP(I_EWIN) + (size_t)j * 1024 * 7168, 1024, 7168, WBP + W_EIN + (size_t)j * 7340032, INP(I_NORMG) + (2 * j) * 1024, smem);
    convT_job(INP(I_OWIN) + (size_t)j * 1024 * 6144, 1024, 6144, WBP + W_OIN + (size_t)j * 6291456, INP(I_NORMG) + (2 * j + 1) * 1024, smem);
    convT_job(INP(I_EWOUT) + (size_t)j * 2048 * 1024, 2048, 1024, WBP + W_EOUT + (size_t)j * 2097152, nullptr, smem);
    convT_job(INP(I_OWOUT) + (size_t)j * 2048 * 1024, 2048, 1024, WBP + W_OOUT + (size_t)j * 2097152, nullptr, smem);
    for (int g = 0; g < 4; ++g)
      convT_job(INP(I_POOLW) + (size_t)(j * 4 + g) * 65536, 256, 256, WBP + W_POOL + (size_t)(j * 4 + g) * 65536, nullptr, smem);
  }
  for (int i = 0; i < 4; ++i) {
    convT_job(INP(I_PGATE) + (size_t)i * 1048576, 1024, 1024, WBP + W_PGATE + (size_t)i * 1048576, INP(I_PLEG) + i * 1024, smem);
    convT_job(INP(I_PUP) + (size_t)i * 262144, 256, 1024, WBP + W_PUP + (size_t)i * 262144, nullptr, smem);
  }
  conv_plain(INP(I_GMWS), WBP + W_GMWS, 262144);
  conv_plain(INP(I_X), HBA, (size_t)TOK * 1024);
  hyena_feats(H3P, smem);
  {
    float2* T = TWP;
    for (int k = blockIdx.x * NT + tid_fresh(); k < 4096; k += gridDim.x * NT) {
      float s, c; sincospif((float)k / 4096.f, &s, &c);
      T[k] = make_float2(c, -s);
    }
  }
  GSYNC();
  filtgen_phase(INP(I_HWOUT), 0, H3P, (float*)SLOT(3), smem);
  GSYNC();

#pragma unroll 1
  for (int layer = 0; layer < 4; ++layer) {
    const int j = layer >> 1;
    if ((layer & 1) == 0) {
      spectrum_phase((const float*)SLOT(3), TWP, SPECP, smem);
      inproj_phase(HBA, WBP + W_EIN + (size_t)j * 7340032, 3, 0, 1024, 2048, 0, SLOT(0), SLOT(1), SLOT(2), nullptr, 0, 0, 0, 0, smem);
      GSYNC();
      z_phase(SLOT(1), SLOT(2), INP(I_CONVW) + (size_t)j * 9216, INP(I_CONVB) + (size_t)j * 3072, (float*)SLOT(3), smem);
      GSYNC();
      fftconv_phase((float*)SLOT(3), SPECP, TWP, INP(I_HD) + j * 1024, smem);
      GSYNC();
      ya_phase(SLOT(0), (const float*)SLOT(3), INP(I_CONVW) + (size_t)j * 9216, INP(I_CONVB) + (size_t)j * 3072, SLOT(1), smem);
      GSYNC();
      inproj_phase(HBA, WBP + W_EIN + (size_t)j * 7340032, 2, 4096, 5120, 0, 0, SLOT(0), SLOT(2), nullptr, nullptr, 0, 0, 0, 0, smem);
      GSYNC();
      gmlp_phase(SLOT(0), SLOT(2), WBP + W_GMWS + (size_t)j * 131072, INP(I_GMG) + j * 1024, INP(I_GMBS) + j * 1024, smem);
      GSYNC();
      inproj_phase(HBA, WBP + W_EIN + (size_t)j * 7340032, 2, 3072, 6144, 0, 0, SLOT(1), SLOT(0), nullptr, nullptr, 2, 2, 0, 0, smem);
      GSYNC();
      outproj_phase(SLOT(1), SLOT(0), WBP + W_EOUT + (size_t)j * 2097152, (layer == 0) ? INP(I_X) : (const float*)HRES, HRES, SLOT(3), smem);
      GSYNC();
      ple_phase(SLOT(3), INP(I_P) + (size_t)layer * TOK * 256, WBP + W_PGATE + (size_t)layer * 1048576, WBP + W_PUP + (size_t)layer * 262144, HRES, HBA, smem);
      GSYNC();
    } else {
      inproj_phase(HBA, WBP + W_OIN + (size_t)j * 6291456, 4, 0, 2048, 3072, 4096, SLOT(0), SLOT(1), SLOT(2), SLOT(3), 0, 0, 0, 1, smem);
      GSYNC();
      pool_phase(SLOT(0), WBP + W_POOL + (size_t)j * 262144, INP(I_POOLB) + j * 1024, INP(I_POOLS) + j * 1024, SLOT(4), smem);
      na_phase(SLOT(1), SLOT(2), SLOT(3), INP(I_RPB) + (size_t)j * 16 * 15 * 31);
      GSYNC();
      inproj_phase(HBA, WBP + W_OIN + (size_t)j * 6291456, 2, 1024, 5120, 0, 0, SLOT(4), SLOT(1), nullptr, nullptr, 2, 2, 0, 0, smem);
      GSYNC();
      outproj_phase(SLOT(4), SLOT(1), WBP + W_OOUT + (size_t)j * 2097152, HRES, HRES, SLOT(2), smem);
      GSYNC();
      ple_phase(SLOT(2), INP(I_P) + (size_t)layer * TOK * 256, WBP + W_PGATE + (size_t)layer * 1048576, WBP + W_PUP + (size_t)layer * 262144, HRES, HBA, smem);
      if (layer == 1) filtgen_phase(INP(I_HWOUT), 1, H3P, (float*)SLOT(3), smem);
      GSYNC();
    }
  }
  final_norm(HRES, INP(I_FINALG));
}

extern "C" void kernel_launch(void* const* d_in, const int* in_sizes, int n_in, void* d_out, int out_size, void* d_ws, size_t ws_size, hipStream_t stream) {
  static int grid_blocks = 0;
  if (grid_blocks == 0) {
    if (n_in != 29 || out_size != TOK * 1024 || ws_size < WS_END) { fprintf(stderr, "kernel_launch: unexpected shapes (n_in %d out %d ws %zu)\n", n_in, out_size, ws_size); grid_blocks = -1; return; }
    int dev = 0, cus = 0, per_cu = 0;
    if (hipGetDevice(&dev) != hipSuccess || hipDeviceGetAttribute(&cus, hipDeviceAttributeMultiprocessorCount, dev) != hipSuccess) { grid_blocks = -1; return; }
    if (hipOccupancyMaxActiveBlocksPerMultiprocessor(&per_cu, (const void*)mega, NT, LDS_BYTES) != hipSuccess || per_cu < 1) { fprintf(stderr, "occupancy query failed\n"); per_cu = 1; }
    if (per_cu > 2) per_cu = 2;
    grid_blocks = cus * per_cu;
  }
  if (grid_blocks < 0) return;
  Params p{};
  for (int i = 0; i < 29; ++i) p.in[i] = (const float*)d_in[i];
  p.out = (float*)d_out; p.ws = (unsigned char*)d_ws;
  void* args[] = {&p};
  hipError_t e = hipLaunchCooperativeKernel((const void*)mega, dim3(grid_blocks), dim3(NT), args, LDS_BYTES, stream);
  if (e != hipSuccess) fprintf(stderr, "cooperative launch failed: %s (grid %d)\n", hipGetErrorString(e), grid_blocks);
}
```

```cpp
#include <hip/hip_runtime.h>
#include <hip/hip_cooperative_groups.h>
#include <cstdio>
namespace cg = cooperative_groups;

typedef unsigned short bf16_t;
typedef short bf16x8 __attribute__((ext_vector_type(8)));
typedef short bf16x4 __attribute__((ext_vector_type(4)));
typedef float f32x4 __attribute__((ext_vector_type(4)));

#define NT 256
constexpr int LDS_BYTES = 0;
constexpr size_t MiB = 1u << 20;
constexpr size_t WB_OFF = 0, HBA_OFF = 80 * MiB, SPEC_OFF = 144 * MiB, H3_OFF = 177 * MiB, TW_OFF = 179 * MiB, R_OFF = 180 * MiB, PART_OFF = 500 * MiB, WS_END = 502 * MiB;
constexpr int TOK = 32768, SEQ = 4096, DM = 1024;
constexpr size_t W_EIN = 0, W_OIN = 14680064, W_EOUT = 27262976, W_OOUT = 31457280, W_PGATE = 35651584, W_PUP = 39845888, W_POOL = 40894464, W_GMWS = 41418752;
constexpr int SPEC_STRIDE = 4104;

struct Params { const float* in[29]; float* out; unsigned char* ws; };
enum { I_X = 0, I_P, I_NORMG, I_FINALG, I_EWIN, I_CONVW, I_CONVB, I_HW0, I_HB0, I_HW1, I_HB1, I_HW2, I_HB2, I_HWOUT, I_HFREQ, I_HD, I_GMG, I_GMWS, I_GMBS, I_EWOUT, I_OWIN, I_POOLW, I_POOLB, I_POOLS, I_RPB, I_OWOUT, I_PUP, I_PGATE, I_PLEG };

__device__ __forceinline__ unsigned short f2bf(float f) { unsigned u = __float_as_uint(f); u += 0x7fffu + ((u >> 16) & 1u); return (unsigned short)(u >> 16); }
__device__ __forceinline__ float bf2f(unsigned short h) { return __uint_as_float(((unsigned)h) << 16); }
__device__ __forceinline__ unsigned pack2(float lo, float hi) { return (unsigned)f2bf(lo) | ((unsigned)f2bf(hi) << 16); }
__device__ __forceinline__ float lo_f(unsigned u) { return __uint_as_float(u << 16); }
__device__ __forceinline__ float hi_f(unsigned u) { return __uint_as_float(u & 0xffff0000u); }
__device__ __forceinline__ float silu_f(float v) { return v / (1.f + __expf(-v)); }
__device__ __forceinline__ float sigmoid_f(float v) { return 1.f / (1.f + __expf(-v)); }
__device__ __forceinline__ void unpack8(const uint4& u, float* f) { f[0] = lo_f(u.x); f[1] = hi_f(u.x); f[2] = lo_f(u.y); f[3] = hi_f(u.y); f[4] = lo_f(u.z); f[5] = hi_f(u.z); f[6] = lo_f(u.w); f[7] = hi_f(u.w); }

typedef const Params __attribute__((address_space(4)))* KP;
__device__ __forceinline__ KP params_fresh() { KP p = (KP)__builtin_amdgcn_kernarg_segment_ptr(); asm volatile("" : "+s"(p)); return p; }
__device__ __forceinline__ int tid_fresh() { int t = threadIdx.x; asm volatile("" : "+v"(t)); return t; }

__device__ __forceinline__ int swz(int row, int kc) { return row * 128 + ((kc ^ ((row >> 1) & 7)) << 4); }

template <int AM, bool SS>
__device__ __forceinline__ void load_a1(int tid, uint4& out, float& ssq, const void* A0, const void* A1, int lda, int row, int k0, int aux) {
  const int kc = tid & 7;
  if (AM == 0) {
    out = *(const uint4*)((const bf16_t*)A0 + (size_t)row * lda + k0 + kc * 8);
  } else if (AM == 2) {
    const bf16_t* src = (k0 < 1024) ? (const bf16_t*)A0 : (const bf16_t*)A1;
    out = *(const uint4*)(src + (size_t)row * lda + (k0 & 1023) + kc * 8);
  } else if (AM == 1) {
    const float* src = (const float*)A0 + (size_t)row * lda + k0 + kc * 8;
    const float4 a = *(const float4*)src, b = *(const float4*)(src + 4);
    out = make_uint4(pack2(a.x, a.y), pack2(a.z, a.w), pack2(b.x, b.y), pack2(b.z, b.w));
  } else {
    const bf16_t* src = (const bf16_t*)A0 + k0 + kc * 8;
    const int half = 1 << aux;
    const int tb = row & (SEQ - 1), base = row - tb;
    const int lo = max(tb - half, 0), hi = min(tb + half, SEQ);
    float s0 = 0.f, s1 = 0.f, s2 = 0.f, s3 = 0.f, s4 = 0.f, s5 = 0.f, s6 = 0.f, s7 = 0.f;
    const int cnt = hi - lo;
    const bf16_t* wp = src + (size_t)(base + lo) * lda;
#pragma unroll 1
    for (int d0 = 0; d0 < cnt; d0 += 8) {
      uint4 wv[8];
#pragma unroll
      for (int d = 0; d < 8; ++d) wv[d] = (d0 + d < cnt) ? *(const uint4*)(wp + (size_t)(d0 + d) * lda) : make_uint4(0u, 0u, 0u, 0u);
#pragma unroll
      for (int d = 0; d < 8; ++d) {
        s0 += lo_f(wv[d].x); s1 += hi_f(wv[d].x); s2 += lo_f(wv[d].y); s3 += hi_f(wv[d].y); s4 += lo_f(wv[d].z); s5 += hi_f(wv[d].z); s6 += lo_f(wv[d].w); s7 += hi_f(wv[d].w);
      }
    }
    const uint4 u = *(const uint4*)(src + (size_t)row * lda);
    const float inv = 1.f / (float)(hi - lo);
    out = make_uint4(pack2(s0 * inv - lo_f(u.x), s1 * inv - hi_f(u.x)), pack2(s2 * inv - lo_f(u.y), s3 * inv - hi_f(u.y)),
                     pack2(s4 * inv - lo_f(u.z), s5 * inv - hi_f(u.z)), pack2(s6 * inv - lo_f(u.w), s7 * inv - hi_f(u.w)));
  }
}
template <int AM, bool SS>
__device__ __forceinline__ void load_a(int tid, uint4& a0, uint4& a1, uint4& a2, uint4& a3, const void* A0, const void* A1, int lda, int m0, int k0, int aux, float (&ss)[4]) {
  const int row = m0 + (tid >> 3);
  load_a1<AM, SS>(tid, a0, ss[0], A0, A1, lda, row, k0, aux);
  load_a1<AM, SS>(tid, a1, ss[1], A0, A1, lda, row + 32, k0, aux);
  load_a1<AM, SS>(tid, a2, ss[2], A0, A1, lda, row + 64, k0, aux);
  load_a1<AM, SS>(tid, a3, ss[3], A0, A1, lda, row + 96, k0, aux);
}
__device__ __forceinline__ void load_b(int tid, uint4& b0, uint4& b1, uint4& b2, uint4& b3, const bf16_t* Bt, int ldb, int n0, int k0) {
  const bf16_t* p = Bt + (size_t)(n0 + (tid >> 3)) * ldb + k0 + (tid & 7) * 8;
  b0 = *(const uint4*)p; b1 = *(const uint4*)(p + (size_t)32 * ldb); b2 = *(const uint4*)(p + (size_t)64 * ldb); b3 = *(const uint4*)(p + (size_t)96 * ldb);
}
__device__ __forceinline__ void store_tile(int tid, unsigned char* dst, const uint4& r0v, const uint4& r1v, const uint4& r2v, const uint4& r3v) {
  const int r0 = tid >> 3, kc = tid & 7;
  *(uint4*)(dst + swz(r0, kc)) = r0v; *(uint4*)(dst + swz(r0 + 32, kc)) = r1v; *(uint4*)(dst + swz(r0 + 64, kc)) = r2v; *(uint4*)(dst + swz(r0 + 96, kc)) = r3v;
}

__device__ __forceinline__ float ssq8(const uint4& v) {
  const float f0 = lo_f(v.x), f1 = hi_f(v.x), f2 = lo_f(v.y), f3 = hi_f(v.y), f4 = lo_f(v.z), f5 = hi_f(v.z), f6 = lo_f(v.w), f7 = hi_f(v.w);
  return f0 * f0 + f1 * f1 + f2 * f2 + f3 * f3 + f4 * f4 + f5 * f5 + f6 * f6 + f7 * f7;
}
template <bool SS>
__device__ __forceinline__ void store_a(int tid, unsigned char* dst, const uint4& a0, const uint4& a1, const uint4& a2, const uint4& a3, float (&ss)[4]) {
  if (SS) { ss[0] += ssq8(a0); ss[1] += ssq8(a1); ss[2] += ssq8(a2); ss[3] += ssq8(a3); }
  store_tile(tid, dst, a0, a1, a2, a3);
}
template <bool SWAP>
__device__ __forceinline__ void mma_tile(f32x4 (&acc)[4][4], const unsigned char* cur, int wr, int wc, int fr, int fq) {
#pragma unroll
  for (int s = 0; s < 2; ++s) {
    bf16x8 af[4], bfr[4];
#pragma unroll
    for (int m = 0; m < 4; ++m) af[m] = *(const bf16x8*)(cur + swz(wr * 64 + m * 16 + fr, s * 4 + fq));
#pragma unroll
    for (int n = 0; n < 4; ++n) bfr[n] = *(const bf16x8*)(cur + 16384 + swz(wc * 64 + n * 16 + fr, s * 4 + fq));
    __builtin_amdgcn_s_setprio(1);
#pragma unroll
    for (int m = 0; m < 4; ++m)
#pragma unroll
      for (int n = 0; n < 4; ++n)
        acc[m][n] = SWAP ? __builtin_amdgcn_mfma_f32_16x16x32_bf16(bfr[n], af[m], acc[m][n], 0, 0, 0)
                         : __builtin_amdgcn_mfma_f32_16x16x32_bf16(af[m], bfr[n], acc[m][n], 0, 0, 0);
    __builtin_amdgcn_s_setprio(0);
  }
}
template <int AM, bool SS, bool SWAP>
__device__ __forceinline__ void gemm_mainloop(f32x4 (&acc)[4][4], const void* A0, const void* A1, int lda, const bf16_t* Bt, int ldb,
                                              int m0, int n0, int K, int aux, unsigned char* smem, float (&ss)[4], int rot) {
  const int tid = tid_fresh(), wid = tid >> 6, lane = tid & 63, wr = wid >> 1, wc = wid & 1, fr = lane & 15, fq = lane >> 4;
  const int nk = K >> 6, km = nk - 1;
  unsigned char* L0 = smem;
  unsigned char* L1 = smem + 32768;
  uint4 a0, a1, a2, a3, b0, b1, b2, b3;
  __syncthreads();
  if (AM == 0 || AM == 2) {
    uint4 c0, c1, c2, c3, d0, d1, d2, d3;
    load_a<AM, SS>(tid, a0, a1, a2, a3, A0, A1, lda, m0, (rot & km) << 6, aux, ss);
    load_b(tid, b0, b1, b2, b3, Bt, ldb, n0, (rot & km) << 6);
    load_a<AM, SS>(tid, c0, c1, c2, c3, A0, A1, lda, m0, ((1 + rot) & km) << 6, aux, ss);
    load_b(tid, d0, d1, d2, d3, Bt, ldb, n0, ((1 + rot) & km) << 6);
    store_a<SS>(tid, L0, a0, a1, a2, a3, ss); store_tile(tid, L0 + 16384, b0, b1, b2, b3);
    __syncthreads();
    for (int kt = 0; kt < nk; kt += 2) {
      const int k2 = ((min(kt + 2, km) + rot) & km) << 6, k3 = ((min(kt + 3, km) + rot) & km) << 6;
      load_a<AM, SS>(tid, a0, a1, a2, a3, A0, A1, lda, m0, k2, aux, ss); load_b(tid, b0, b1, b2, b3, Bt, ldb, n0, k2);
      __builtin_amdgcn_sched_barrier(0);
      mma_tile<SWAP>(acc, L0, wr, wc, fr, fq);
      store_a<SS>(tid, L1, c0, c1, c2, c3, ss); store_tile(tid, L1 + 16384, d0, d1, d2, d3);
      __syncthreads();
      load_a<AM, SS>(tid, c0, c1, c2, c3, A0, A1, lda, m0, k3, aux, ss); load_b(tid, d0, d1, d2, d3, Bt, ldb, n0, k3);
      __builtin_amdgcn_sched_barrier(0);
      mma_tile<SWAP>(acc, L1, wr, wc, fr, fq);
      if (SS) { if (kt + 2 < nk) { ss[0] += ssq8(a0); ss[1] += ssq8(a1); ss[2] += ssq8(a2); ss[3] += ssq8(a3); } }
      store_tile(tid, L0, a0, a1, a2, a3); store_tile(tid, L0 + 16384, b0, b1, b2, b3);
      __syncthreads();
    }
    asm volatile("s_waitcnt vmcnt(0)" ::: "memory");
  } else {
    load_a<AM, SS>(tid, a0, a1, a2, a3, A0, A1, lda, m0, (rot & km) << 6, aux, ss);
    load_b(tid, b0, b1, b2, b3, Bt, ldb, n0, (rot & km) << 6);
    store_a<SS>(tid, L0, a0, a1, a2, a3, ss); store_tile(tid, L0 + 16384, b0, b1, b2, b3);
    __syncthreads();
    for (int kt = 0; kt < nk; ++kt) {
      unsigned char* cur = smem + (kt & 1) * 32768;
      unsigned char* nxt = smem + ((kt + 1) & 1) * 32768;
      const bool more = (kt + 1 < nk);
      if (more) { load_a<AM, SS>(tid, a0, a1, a2, a3, A0, A1, lda, m0, ((kt + 1 + rot) & km) << 6, aux, ss); load_b(tid, b0, b1, b2, b3, Bt, ldb, n0, ((kt + 1 + rot) & km) << 6); }
      mma_tile<SWAP>(acc, cur, wr, wc, fr, fq);
      if (more) { store_a<SS>(tid, nxt, a0, a1, a2, a3, ss); store_tile(tid, nxt + 16384, b0, b1, b2, b3); }
      __syncthreads();
    }
  }
}
__device__ __forceinline__ void finish_rstd(float (&ss)[4], unsigned char* smem) {
  const int tid = tid_fresh(), r0 = tid >> 3, kc = tid & 7;
  float* rs = (float*)smem;
#pragma unroll
  for (int i = 0; i < 4; ++i) {
    float v = ss[i];
    v += __shfl_xor(v, 1); v += __shfl_xor(v, 2); v += __shfl_xor(v, 4);
    if (kc == 0) rs[r0 + 32 * i] = rsqrtf(v * (1.f / 1024.f) + 1e-6f);
  }
  __syncthreads();
}
__device__ __forceinline__ void zero_acc(f32x4 (&acc)[4][4]) {
#pragma unroll
  for (int m = 0; m < 4; ++m)
#pragma unroll
    for (int n = 0; n < 4; ++n) acc[m][n] = (f32x4){0.f, 0.f, 0.f, 0.f};
}

__device__ __forceinline__ bool tile_pick(int i, int nNt, int& mt, int& nt, int& L) {
  const int b = blockIdx.x;
  L = i * (int)gridDim.x + (b & 7) * ((int)gridDim.x >> 3) + (b >> 3);
  if (L >= 256 * nNt) return false;
  const int band = L / (8 * nNt), r = L - band * (8 * nNt), c = r >> 6, w = r & 63;
  mt = band * 8 + (w & 7); nt = c * 8 + (w >> 3);
  return true;
}

__device__ __forceinline__ void inproj_phase(const bf16_t* hb, const bf16_t* W, int ng, int wr0, int wr1, int wr2, int wr3,
                             bf16_t* d0, bf16_t* d1, bf16_t* d2, bf16_t* d3, int md0, int md1, int md2, int md3, unsigned char* smem, float* part = nullptr) {
  const int tid = tid_fresh(), wid = tid >> 6, lane = tid & 63, wr = wid >> 1, wc = wid & 1, fr = lane & 15, fq = lane >> 4;
  for (int i = 0;; ++i) {
    int mt, ntg, t;
    if (!tile_pick(i, ng * 8, mt, ntg, t)) break;
    const int grp = ntg >> 3, nt = ntg & 7;
    const int wrow = grp == 0 ? wr0 : grp == 1 ? wr1 : grp == 2 ? wr2 : wr3;
    bf16_t* dst = grp == 0 ? d0 : grp == 1 ? d1 : grp == 2 ? d2 : d3;
    const int mode = grp == 0 ? md0 : grp == 1 ? md1 : grp == 2 ? md2 : md3;
    const int m0 = mt * 128, n0 = nt * 128;
    f32x4 acc[4][4]; zero_acc(acc);
    float ss[4] = {0.f, 0.f, 0.f, 0.f};
    if (mode == 1) {
      gemm_mainloop<0, true, false>(acc, hb, nullptr, 1024, W + (size_t)wrow * 1024, 1024, m0, n0, 1024, 0, smem, ss, 0);
      finish_rstd(ss, smem);
      const float* rs = (const float*)smem;
#pragma unroll
      for (int m = 0; m < 4; ++m) {
        const int rl = wr * 64 + m * 16 + fq * 4;
        const float r0 = rs[rl], r1 = rs[rl + 1], r2 = rs[rl + 2], r3 = rs[rl + 3];
#pragma unroll
        for (int n = 0; n < 4; ++n) {
          const int col = n0 + wc * 64 + n * 16 + fr;
          uint2 o; o.x = pack2(acc[m][n][0] * r0, acc[m][n][1] * r1); o.y = pack2(acc[m][n][2] * r2, acc[m][n][3] * r3);
          *(uint2*)(dst + (size_t)col * TOK + m0 + rl) = o;
        }
      }
    } else {
      gemm_mainloop<0, true, true>(acc, hb, nullptr, 1024, W + (size_t)wrow * 1024, 1024, m0, n0, 1024, 0, smem, ss, 0);
      finish_rstd(ss, smem);
      const float* rs = (const float*)smem;
      uint2 old[4][4];
      if (mode == 2) {
#pragma unroll
        for (int m = 0; m < 4; ++m)
#pragma unroll
          for (int n = 0; n < 4; ++n) old[m][n] = *(const uint2*)(dst + (size_t)(m0 + wr * 64 + m * 16 + fr) * 1024 + n0 + wc * 64 + n * 16 + fq * 4);
      }
#pragma unroll
      for (int m = 0; m < 4; ++m) {
        const int rl = wr * 64 + m * 16 + fr;
        const float r = rs[rl];
        float psq = 0.f;
#pragma unroll
        for (int n = 0; n < 4; ++n) {
          const int col = n0 + wc * 64 + n * 16 + fq * 4;
          bf16_t* pd = dst + (size_t)(m0 + rl) * 1024 + col;
          float v0 = acc[m][n][0] * r, v1 = acc[m][n][1] * r, v2 = acc[m][n][2] * r, v3 = acc[m][n][3] * r;
          if (mode == 2) {
            v0 = lo_f(old[m][n].x) * silu_f(v0); v1 = hi_f(old[m][n].x) * silu_f(v1); v2 = lo_f(old[m][n].y) * silu_f(v2); v3 = hi_f(old[m][n].y) * silu_f(v3);
          }
          uint2 o; o.x = pack2(v0, v1); o.y = pack2(v2, v3);
          *(uint2*)pd = o;
          if (mode == 3) psq += v0 * v0 + v1 * v1 + v2 * v2 + v3 * v3;
        }
        if (mode == 3) {
          psq += __shfl_xor(psq, 16); psq += __shfl_xor(psq, 32);
          if (fq == 0) part[(size_t)(m0 + rl) * 16 + nt * 2 + wc] = psq;
        }
      }
    }
  }
}

__device__ __forceinline__ void outproj_phase(const bf16_t* MA, const bf16_t* MB, const bf16_t* Wt  , const float* hsrc, float* hres, bf16_t* hbB, unsigned char* smem) {
  const int tid = tid_fresh(), wid = tid >> 6, lane = tid & 63, wr = wid >> 1, wc = wid & 1, fr = lane & 15, fq = lane >> 4;
  for (int i = 0;; ++i) {
    int mt, nt, t;
    if (!tile_pick(i, 8, mt, nt, t)) break;
    const int m0 = mt * 128, n0 = nt * 128;
    f32x4 acc[4][4]; zero_acc(acc);
    float ss[4] = {0.f, 0.f, 0.f, 0.f};
    gemm_mainloop<2, false, true>(acc, MA, MB, 1024, Wt, 2048, m0, n0, 2048, 0, smem, ss, 0);
#pragma unroll
    for (int m = 0; m < 4; ++m) {
      const int row = m0 + wr * 64 + m * 16 + fr;
      const size_t idx = (size_t)row * 1024 + n0 + wc * 64 + fq * 4;
      float4 h[4];
#pragma unroll
      for (int n = 0; n < 4; ++n) h[n] = *(const float4*)(hsrc + idx + n * 16);
#pragma unroll
      for (int n = 0; n < 4; ++n) {
        const float4 o = make_float4(h[n].x + acc[m][n][0], h[n].y + acc[m][n][1], h[n].z + acc[m][n][2], h[n].w + acc[m][n][3]);
        *(float4*)(hres + idx + n * 16) = o;
        uint2 ob; ob.x = pack2(o.x, o.y); ob.y = pack2(o.z, o.w);
        *(uint2*)(hbB + idx + n * 16) = ob;
      }
    }
  }
}

__device__ __forceinline__ void ple_phase(const bf16_t* hbB, const float* pin  , const bf16_t* Wg  , const bf16_t* Wup  ,
                          float* hres, bf16_t* hbA, unsigned char* smem) {
  const int tid = tid_fresh(), wid = tid >> 6, lane = tid & 63, wr = wid >> 1, wc = wid & 1, fr = lane & 15, fq = lane >> 4;
  for (int i = 0;; ++i) {
    int mt, nt, t;
    if (!tile_pick(i, 8, mt, nt, t)) break;
    const int m0 = mt * 128, n0 = nt * 128;
    f32x4 ag[4][4]; zero_acc(ag);
    float ss[4] = {0.f, 0.f, 0.f, 0.f};
    gemm_mainloop<0, true, true>(ag, hbB, nullptr, 1024, Wg, 1024, m0, n0, 1024, 0, smem, ss, 0);
    finish_rstd(ss, smem);
    unsigned gp[4][4][2];
    {
      const float* rs = (const float*)smem;
#pragma unroll
      for (int m = 0; m < 4; ++m) {
        const float r = rs[wr * 64 + m * 16 + fr];
#pragma unroll
        for (int n = 0; n < 4; ++n) {
          gp[m][n][0] = pack2(sigmoid_f(r * ag[m][n][0]), sigmoid_f(r * ag[m][n][1]));
          gp[m][n][1] = pack2(sigmoid_f(r * ag[m][n][2]), sigmoid_f(r * ag[m][n][3]));
        }
      }
    }
    zero_acc(ag);
    float ss2[4] = {0.f, 0.f, 0.f, 0.f};
    gemm_mainloop<1, false, true>(ag, pin, nullptr, 256, Wup, 256, m0, n0, 256, 0, smem, ss2, 0);
#pragma unroll
    for (int m = 0; m < 4; ++m) {
      const int rl = wr * 64 + m * 16 + fr;
      const size_t idx = (size_t)(m0 + rl) * 1024 + n0 + wc * 64 + fq * 4;
      float4 h[4];
#pragma unroll
      for (int n = 0; n < 4; ++n) h[n] = *(const float4*)(hres + idx + n * 16);
#pragma unroll
      for (int n = 0; n < 4; ++n) {
        float4 o;
        o.x = h[n].x + ag[m][n][0] * lo_f(gp[m][n][0]);
        o.y = h[n].y + ag[m][n][1] * hi_f(gp[m][n][0]);
        o.z = h[n].z + ag[m][n][2] * lo_f(gp[m][n][1]);
        o.w = h[n].w + ag[m][n][3] * hi_f(gp[m][n][1]);
        *(float4*)(hres + idx + n * 16) = o;
        uint2 ob; ob.x = pack2(o.x, o.y); ob.y = pack2(o.z, o.w);
        *(uint2*)(hbA + idx + n * 16) = ob;
      }
    }
  }
}

__device__ __forceinline__ void pool_phase(const bf16_t* XC, const bf16_t* Wp  , const float* pb, const float* ps, bf16_t* MC, unsigned char* smem) {
  const int tid = tid_fresh(), wid = tid >> 6, lane = tid & 63, wr = wid >> 1, wc = wid & 1, fr = lane & 15, fq = lane >> 4;
  for (int t = blockIdx.x; t < 2048; t += gridDim.x) {
    const int mt = t >> 3, g = (t >> 1) & 3, nt = t & 1, m0 = mt * 128, n0 = nt * 128;
    f32x4 acc[4][4]; zero_acc(acc);
    float ss[4] = {0.f, 0.f, 0.f, 0.f};
    gemm_mainloop<3, false, true>(acc, XC + g * 256, nullptr, 1024, Wp + (size_t)g * 65536, 256, m0, n0, 256, g, smem, ss, t + (t >> 2));
#pragma unroll
    for (int m = 0; m < 4; ++m) {
      const int row = m0 + wr * 64 + m * 16 + fr;
#pragma unroll
      for (int n = 0; n < 4; ++n) {
        const int col = g * 256 + n0 + wc * 64 + n * 16 + fq * 4;
        const float4 b = *(const float4*)(pb + col), s = *(const float4*)(ps + col);
        uint2 o; o.x = pack2((acc[m][n][0] + b.x) * s.x, (acc[m][n][1] + b.y) * s.y); o.y = pack2((acc[m][n][2] + b.z) * s.z, (acc[m][n][3] + b.w) * s.w);
        *(uint2*)(MC + (size_t)row * 1024 + col) = o;
      }
    }
  }
}

__device__ __forceinline__ void gmlp_phase(bf16_t* UB, const bf16_t* VB, const bf16_t* Ws  , const float* gmg, const float* gbs  , const float* part, unsigned char* smem) {
  const int tid = tid_fresh(), wid = tid >> 6, lane = tid & 63, wr = wid >> 1, wc = wid & 1, fr = lane & 15, fq = lane >> 4;
  unsigned char* sW = smem;
  unsigned char* sX = smem + 32768;
  for (int it = blockIdx.x; it < 2048; it += gridDim.x) {
    const int g = it & 7, tok0 = (it >> 3) * 128;
    __syncthreads();
#pragma unroll 2
    for (int i = 0; i < 8; ++i) {
      const int id = tid + 256 * i, row = id >> 4, kc = id & 15;
      *(uint4*)(sW + row * 256 + ((kc ^ (row & 15)) << 4)) = *(const uint4*)(Ws + (size_t)g * 16384 + row * 128 + kc * 8);
    }
    float rq;
    {
      const float4* pp = (const float4*)(part + (size_t)(tok0 + (tid & 127)) * 16);
      const float4 p0 = pp[0], p1 = pp[1], p2 = pp[2], p3 = pp[3];
      const float sq = (p0.x + p0.y + p0.z + p0.w) + (p1.x + p1.y + p1.z + p1.w) + (p2.x + p2.y + p2.z + p2.w) + (p3.x + p3.y + p3.z + p3.w);
      rq = rsqrtf(sq * (1.f / 1024.f) + 1e-6f);
    }
    __syncthreads();
#pragma unroll 2
    for (int i = 0; i < 8; ++i) {
      const int id = tid + 256 * i, q = id & 127, cc = id >> 7;
      float f[8]; unpack8(*(const uint4*)(VB + (size_t)(tok0 + q) * 1024 + g * 128 + cc * 8), f);
#pragma unroll
      for (int e = 0; e < 8; ++e) {
        const int c = cc * 8 + e;
        const float v = f[e] * rq * gmg[g * 128 + c];
        *(bf16_t*)(sX + c * 256 + (((q >> 3) ^ (c & 15)) << 4) + (q & 7) * 2) = f2bf(v);
      }
    }
    __syncthreads();
    f32x4 acc[4][4]; zero_acc(acc);
#pragma unroll
    for (int s = 0; s < 4; ++s) {
      bf16x8 af[4], bfr[4];
#pragma unroll
      for (int m = 0; m < 4; ++m) { const int row = wr * 64 + m * 16 + fr; af[m] = *(const bf16x8*)(sW + row * 256 + (((s * 4 + fq) ^ (row & 15)) << 4)); }
#pragma unroll
      for (int n = 0; n < 4; ++n) { const int row = wc * 64 + n * 16 + fr; bfr[n] = *(const bf16x8*)(sX + row * 256 + (((s * 4 + fq) ^ (row & 15)) << 4)); }
#pragma unroll
      for (int m = 0; m < 4; ++m)
#pragma unroll
        for (int n = 0; n < 4; ++n) acc[m][n] = __builtin_amdgcn_mfma_f32_16x16x32_bf16(bfr[n], af[m], acc[m][n], 0, 0, 0);
    }
    uint2 uo[4][4];
#pragma unroll
    for (int m = 0; m < 4; ++m)
#pragma unroll
      for (int n = 0; n < 4; ++n) uo[m][n] = *(const uint2*)(UB + (size_t)(tok0 + wr * 64 + m * 16 + fr) * 1024 + g * 128 + wc * 64 + n * 16 + fq * 4);
#pragma unroll
    for (int m = 0; m < 4; ++m) {
      const int p = wr * 64 + m * 16 + fr;
      const float bias = gbs[g * 128 + p];
#pragma unroll
      for (int n = 0; n < 4; ++n) {
        const int c = wc * 64 + n * 16 + fq * 4;
        bf16_t* pd = UB + (size_t)(tok0 + p) * 1024 + g * 128 + c;
        const uint2 u = uo[m][n];
        uint2 o; o.x = pack2(lo_f(u.x) * (acc[m][n][0] + bias), hi_f(u.x) * (acc[m][n][1] + bias));
        o.y = pack2(lo_f(u.y) * (acc[m][n][2] + bias), hi_f(u.y) * (acc[m][n][3] + bias));
        *(uint2*)pd = o;
      }
    }
  }
}

__device__ __forceinline__ void na_phase(bf16_t* Q, const bf16_t* Kb, const bf16_t* Vt, const float* rpb) {
  const int tid = tid_fresh(), wave = tid >> 6, lane = tid & 63, fr = lane & 15, fq = lane >> 4;
  const int nw = gridDim.x * 4;
  for (int it = blockIdx.x * 4 + wave; it < 8 * 64 * 16 * 4; it += nw) {
    const int wq = it & 3, h = (it >> 2) & 15, r = (it >> 6) & 63, b = it >> 12;
    const int rs = min(max(r - 4, 0), 56);
    const int w0 = (wq == 0) ? 0 : (wq == 1) ? 8 : (wq == 2) ? 24 : 32;
    const int qc = wq * 16 + fr;
    const int tokq = b * 4096 + r * 64 + qc;
    const bf16x8 qf0 = *(const bf16x8*)(Q + (size_t)tokq * 1024 + h * 64 + fq * 8);
    const bf16x8 qf1 = *(const bf16x8*)(Q + (size_t)tokq * 1024 + h * 64 + 32 + fq * 8);
    const int cs = min(max(qc - 8, 0), 48);
    const float* rp = rpb + h * (15 * 31);
    f32x4 sc[8][2];
    float mx = -1e30f;
#pragma unroll
    for (int hb = 0; hb < 2; ++hb) {
      bf16x8 kf[4][2][2];
#pragma unroll
      for (int j4 = 0; j4 < 4; ++j4)
#pragma unroll
        for (int hc = 0; hc < 2; ++hc) {
          const int tokk = b * 4096 + (rs + hb * 4 + j4) * 64 + w0 + 8 * (fr >> 2) + 4 * hc + (fr & 3);
          kf[j4][hc][0] = *(const bf16x8*)(Kb + (size_t)tokk * 1024 + h * 64 + fq * 8);
          kf[j4][hc][1] = *(const bf16x8*)(Kb + (size_t)tokk * 1024 + h * 64 + 32 + fq * 8);
        }
      __builtin_amdgcn_sched_barrier(0);
#pragma unroll
      for (int j4 = 0; j4 < 4; ++j4) {
        const int jr = hb * 4 + j4;
#pragma unroll
        for (int hc = 0; hc < 2; ++hc) {
          f32x4 a = (f32x4){0.f, 0.f, 0.f, 0.f};
          a = __builtin_amdgcn_mfma_f32_16x16x32_bf16(kf[j4][hc][0], qf0, a, 0, 0, 0);
          a = __builtin_amdgcn_mfma_f32_16x16x32_bf16(kf[j4][hc][1], qf1, a, 0, 0, 0);
          const int dr = rs + jr - r + 7;
#pragma unroll
          for (int e = 0; e < 4; ++e) {
            const int kcol = w0 + 8 * fq + 4 * hc + e;
            const bool valid = (kcol >= cs) && (kcol < cs + 16);
            const int dc = min(max(kcol - qc + 15, 0), 30);
            const float v = valid ? (a[e] * 0.125f + rp[dr * 31 + dc]) : -1e30f;
            a[e] = v; mx = fmaxf(mx, v);
          }
          sc[jr][hc] = a;
        }
      }
    }
    mx = fmaxf(mx, __shfl_xor(mx, 16)); mx = fmaxf(mx, __shfl_xor(mx, 32));
    float sum = 0.f;
#pragma unroll
    for (int jr = 0; jr < 8; ++jr)
#pragma unroll
      for (int hc = 0; hc < 2; ++hc)
#pragma unroll
        for (int e = 0; e < 4; ++e) { const float pv = (sc[jr][hc][e] > -1e29f) ? __expf(sc[jr][hc][e] - mx) : 0.f; sc[jr][hc][e] = pv; sum += pv; }
    sum += __shfl_xor(sum, 16); sum += __shfl_xor(sum, 32);
    const float inv = 1.f / sum;
    f32x4 o[4];
#pragma unroll
    for (int dt = 0; dt < 4; ++dt) o[dt] = (f32x4){0.f, 0.f, 0.f, 0.f};
#pragma unroll
    for (int jp = 0; jp < 4; ++jp) {
      bf16x8 vf[2][4];
#pragma unroll
      for (int j2 = 0; j2 < 2; ++j2) {
        const size_t tk = (size_t)b * 4096 + (rs + jp * 2 + j2) * 64 + w0 + fq * 8;
#pragma unroll
        for (int dt = 0; dt < 4; ++dt) vf[j2][dt] = *(const bf16x8*)(Vt + (size_t)(h * 64 + dt * 16 + fr) * TOK + tk);
      }
      __builtin_amdgcn_sched_barrier(0);
#pragma unroll
      for (int j2 = 0; j2 < 2; ++j2) {
        const int jr = jp * 2 + j2;
        union { bf16x8 v; unsigned u[4]; } pf;
        pf.u[0] = pack2(sc[jr][0][0] * inv, sc[jr][0][1] * inv); pf.u[1] = pack2(sc[jr][0][2] * inv, sc[jr][0][3] * inv);
        pf.u[2] = pack2(sc[jr][1][0] * inv, sc[jr][1][1] * inv); pf.u[3] = pack2(sc[jr][1][2] * inv, sc[jr][1][3] * inv);
#pragma unroll
        for (int dt = 0; dt < 4; ++dt) o[dt] = __builtin_amdgcn_mfma_f32_16x16x32_bf16(vf[j2][dt], pf.v, o[dt], 0, 0, 0);
      }
    }
#pragma unroll
    for (int dt = 0; dt < 4; ++dt) {
      uint2 ob; ob.x = pack2(o[dt][0], o[dt][1]); ob.y = pack2(o[dt][2], o[dt][3]);
      *(uint2*)(Q + (size_t)tokq * 1024 + h * 64 + dt * 16 + fq * 4) = ob;
    }
  }
}

__device__ __forceinline__ float2 cmul(float2 a, float2 b) { return make_float2(a.x * b.x - a.y * b.y, a.x * b.y + a.y * b.x); }
__device__ __forceinline__ float2 cadd(float2 a, float2 b) { return make_float2(a.x + b.x, a.y + b.y); }
__device__ __forceinline__ float2 csub(float2 a, float2 b) { return make_float2(a.x - b.x, a.y - b.y); }

template <bool DIF>
__device__ __forceinline__ void bfly(float2& a, float2& b, float2 w) {
  if (DIF) { const float2 s = cadd(a, b), d = csub(a, b); a = s; b = cmul(d, w); }
  else { const float2 t = cmul(b, w); const float2 s = cadd(a, t), d = csub(a, t); a = s; b = d; }
}
#define PH(i) ((i) ^ (((i) >> 4) & 7))
template <bool DIF>
__device__ __forceinline__ void fft_r8(float2* buf, const float2* __restrict__ T, int lq) {
  const int q = 1 << lq, sA = 1024 >> lq;
  for (int g = tid_fresh(); g < 1024; g += NT) {
    const int j0 = g & (q - 1), i0 = ((g >> lq) << (lq + 3)) + j0;
    float2 x[8];
#pragma unroll
    for (int p = 0; p < 8; ++p) x[p] = buf[PH(i0 + p * q)];
    if (DIF) {
#pragma unroll
      for (int p = 0; p < 4; ++p) bfly<true>(x[p], x[p + 4], T[j0 * sA + p * 1024]);
#pragma unroll
      for (int p = 0; p < 2; ++p) { const float2 w = T[j0 * 2 * sA + p * 2048]; bfly<true>(x[p], x[p + 2], w); bfly<true>(x[4 + p], x[6 + p], w); }
      { const float2 w = T[j0 * 4 * sA]; bfly<true>(x[0], x[1], w); bfly<true>(x[2], x[3], w); bfly<true>(x[4], x[5], w); bfly<true>(x[6], x[7], w); }
    } else {
      { const float2 w = T[j0 * 4 * sA]; bfly<false>(x[0], x[1], w); bfly<false>(x[2], x[3], w); bfly<false>(x[4], x[5], w); bfly<false>(x[6], x[7], w); }
#pragma unroll
      for (int p = 0; p < 2; ++p) { const float2 w = T[j0 * 2 * sA + p * 2048]; bfly<false>(x[p], x[p + 2], w); bfly<false>(x[4 + p], x[6 + p], w); }
#pragma unroll
      for (int p = 0; p < 4; ++p) bfly<false>(x[p], x[p + 4], T[j0 * sA + p * 1024]);
    }
#pragma unroll
    for (int p = 0; p < 8; ++p) buf[PH(i0 + p * q)] = x[p];
  }
  __syncthreads();
}
__device__ __forceinline__ void fft_r2(float2* buf) {
  for (int g = tid_fresh(); g < 4096; g += NT) {
    const int i0 = PH(2 * g), i1 = PH(2 * g + 1);
    const float2 a = buf[i0], b = buf[i1];
    buf[i0] = make_float2(a.x + b.x, a.y + b.y); buf[i1] = make_float2(a.x - b.x, a.y - b.y);
  }
  __syncthreads();
}
__device__ __forceinline__ void fft_dif(float2* buf, const float2* T) { fft_r8<true>(buf, T, 10); fft_r8<true>(buf, T, 7); fft_r8<true>(buf, T, 4); fft_r8<true>(buf, T, 1); fft_r2(buf); }
__device__ __forceinline__ void fft_dit(float2* buf, const float2* T) { fft_r2(buf); fft_r8<false>(buf, T, 1); fft_r8<false>(buf, T, 4); fft_r8<false>(buf, T, 7); fft_r8<false>(buf, T, 10); }
__device__ __forceinline__ int brev13(int k) { return (int)(__brev((unsigned)k) >> 19); }

__device__ __forceinline__ void hyena_feats(float* h3, unsigned char* smem) {
  KP PP = params_fresh();
  float* hin = (float*)smem;
  const int tid = tid_fresh(), r = tid >> 6, u = tid & 63;
  for (int it = blockIdx.x; it < 2048; it += gridDim.x) {
    const int j = it >> 10, l = (it & 1023) * 4 + r;
    const float* w0 = PP->in[I_HW0] + j * 33 * 64; const float* b0 = PP->in[I_HB0] + j * 64;
    const float* w1 = PP->in[I_HW1] + j * 4096; const float* b1 = PP->in[I_HB1] + j * 64;
    const float* w2 = PP->in[I_HW2] + j * 4096; const float* b2 = PP->in[I_HB2] + j * 64;
    const float fr = PP->in[I_HFREQ][j * 64 + u];
    __syncthreads();
    {
      const float tt = (float)l / 4095.f;
      const float ang = 6.283185307179586f * (float)l / 4096.f;
      float f = 0.f;
      if (u == 0) f = tt;
      else if (u <= 16) { const float band = 1e-4f + (float)(u - 1) * ((15.f - 1e-4f) / 15.f); f = cosf(band * ang); }
      else if (u <= 32) { const float band = 1e-4f + (float)(u - 17) * ((15.f - 1e-4f) / 15.f); f = -sinf(band * ang); }
      hin[r * 64 + u] = f;
    }
    __syncthreads();
    float a = b0[u];
    for (int k = 0; k < 33; ++k) a += hin[r * 64 + k] * w0[k * 64 + u];
    float v = sinf(fr * a);
    __syncthreads(); hin[r * 64 + u] = v; __syncthreads();
    a = b1[u];
    for (int k = 0; k < 64; ++k) a += hin[r * 64 + k] * w1[k * 64 + u];
    v = sinf(fr * a);
    __syncthreads(); hin[r * 64 + u] = v; __syncthreads();
    a = b2[u];
    for (int k = 0; k < 64; ++k) a += hin[r * 64 + k] * w2[k * 64 + u];
    v = sinf(fr * a);
    h3[((size_t)j * 4096 + l) * 64 + u] = v;
  }
}

__device__ __forceinline__ void filtgen_phase(const float* hwout, int j, const float* h3, float* kT, unsigned char* smem) {
  float* hs = (float*)smem;
  float* wsm = (float*)(smem + 32768);
  const int tid = tid_fresh(), tl = tid & 15, tc = tid >> 4;
  const float* wout = hwout + (size_t)j * 64 * 2048;
  const float mind = logf(0.01f) / 1.5f, maxd = logf(0.01f) / 0.3f;
  for (int it = blockIdx.x; it < 2048; it += gridDim.x) {
    const int l0 = (it & 63) * 64, c0 = (it >> 6) * 64;
    __syncthreads();
#pragma unroll
    for (int i = 0; i < 4; ++i) {
      const int id = tid + 256 * i, r = id >> 4, c4 = id & 15;
      const float4 hv = *(const float4*)(h3 + ((size_t)j * 4096 + l0 + r) * 64 + c4 * 4);
      float* d = hs + r * 65 + c4 * 4; d[0] = hv.x; d[1] = hv.y; d[2] = hv.z; d[3] = hv.w;
      *(float4*)(wsm + r * 64 + c4 * 4) = *(const float4*)(wout + (size_t)r * 2048 + c0 + c4 * 4);
    }
    __syncthreads();
    float acc[4][4];
#pragma unroll
    for (int i = 0; i < 4; ++i)
#pragma unroll
      for (int k = 0; k < 4; ++k) acc[i][k] = 0.f;
#pragma unroll 4
    for (int u = 0; u < 64; ++u) {
      const float4 w = *(const float4*)(wsm + u * 64 + tc * 4);
#pragma unroll
      for (int i = 0; i < 4; ++i) {
        const float hv = hs[(tl * 4 + i) * 65 + u];
        acc[i][0] += hv * w.x; acc[i][1] += hv * w.y; acc[i][2] += hv * w.z; acc[i][3] += hv * w.w;
      }
    }
#pragma unroll
    for (int k = 0; k < 4; ++k) {
      const int col = c0 + tc * 4 + k, c = col & 1023;
      const float dl = fabsf(mind + (float)c * ((maxd - mind) / 1023.f));
      float4 o;
      o.x = acc[0][k] * expf(-((float)(l0 + tl * 4 + 0) / 4095.f) * dl);
      o.y = acc[1][k] * expf(-((float)(l0 + tl * 4 + 1) / 4095.f) * dl);
      o.z = acc[2][k] * expf(-((float)(l0 + tl * 4 + 2) / 4095.f) * dl);
      o.w = acc[3][k] * expf(-((float)(l0 + tl * 4 + 3) / 4095.f) * dl);
      *(float4*)(kT + (size_t)col * 4096 + l0 + tl * 4) = o;
    }
  }
}

__device__ __forceinline__ void spectrum_phase(const float* kT, const float2* T, float4* spec, unsigned char* smem) {
  float2* buf = (float2*)smem;
  float* red = (float*)smem;
  const int tid = tid_fresh(), lane = tid & 63, wid = tid >> 6;
  for (int pi = blockIdx.x; pi < 512; pi += gridDim.x) {
    const int c1 = 2 * pi;
    const float* f0 = kT + (size_t)c1 * 4096;
    const float* b0 = kT + (size_t)(1024 + c1) * 4096;
    __syncthreads();
    float s1 = 0.f, s2 = 0.f;
#pragma unroll 4
    for (int i = 0; i < 16; ++i) {
      const int l = tid + 256 * i;
      const float a00 = f0[l], a01 = f0[4096 + l], a10 = b0[l], a11 = b0[4096 + l];
      s1 += a00 * a00; s2 += a01 * a01;
      if (l != 0) { s1 += a10 * a10; s2 += a11 * a11; }
    }
#pragma unroll
    for (int o = 32; o > 0; o >>= 1) { s1 += __shfl_xor(s1, o); s2 += __shfl_xor(s2, o); }
    if (lane == 0) { red[wid * 2] = s1; red[wid * 2 + 1] = s2; }
    __syncthreads();
    s1 = red[0] + red[2] + red[4] + red[6]; s2 = red[1] + red[3] + red[5] + red[7];
    __syncthreads();
#pragma unroll 4
    for (int i = 0; i < 16; ++i) {
      const int l = tid + 256 * i;
      const float a00 = f0[l], a01 = f0[4096 + l], a10 = b0[l], a11 = b0[4096 + l];
      buf[PH(l)] = make_float2(a00, a01);
      if (l == 0) buf[PH(4096)] = make_float2(0.f, 0.f);
      else buf[PH(8192 - l)] = make_float2(a10, a11);
    }
    __syncthreads();
    const float sc1 = rsqrtf(s1 + 1e-6f) * (1.f / 8192.f);
    const float sc2 = rsqrtf(s2 + 1e-6f) * (1.f / 8192.f);
    fft_dif(buf, T);
    for (int k = tid; k <= 4096; k += NT) {
      const int pk_ = brev13(k), pn_ = brev13((8192 - k) & 8191);
      const float2 Pk = buf[PH(pk_)], Fn = buf[PH(pn_)];
      const float2 Qc = make_float2(Fn.x, -Fn.y);
      const float2 H1 = make_float2(0.5f * (Pk.x + Qc.x) * sc1, 0.5f * (Pk.y + Qc.y) * sc1);
      const float2 H2 = make_float2(0.5f * (Pk.y - Qc.y) * sc2, -0.5f * (Pk.x - Qc.x) * sc2);
      spec[(size_t)pi * SPEC_STRIDE + k] = make_float4(0.5f * (H1.x + H2.x), 0.5f * (H1.y + H2.y), 0.5f * (H1.x - H2.x), 0.5f * (H1.y - H2.y));
    }
  }
}

__device__ __forceinline__ void z_phase(const bf16_t* X1, const bf16_t* V, const float* cw  , const float* cb  , float* zT, unsigned char* smem) {
  float* zs = (float*)smem;
  const int tid = tid_fresh(), c8 = tid & 7, tr = tid >> 3;
  for (int it = blockIdx.x; it < 8192; it += gridDim.x) {
    const int ct = it & 15, tt = it >> 4, c0 = ct * 64, t0 = tt * 64;
    __syncthreads();
    const int c = c0 + c8 * 8;
    float w1[3][8], w2[3][8], bb1[8], bb2[8];
#pragma unroll
    for (int e = 0; e < 8; ++e) {
#pragma unroll
      for (int k = 0; k < 3; ++k) { w1[k][e] = cw[k * 3072 + 1024 + c + e]; w2[k][e] = cw[k * 3072 + 2048 + c + e]; }
      bb1[e] = cb[1024 + c + e]; bb2[e] = cb[2048 + c + e];
    }
#pragma unroll
    for (int i = 0; i < 2; ++i) {
      const int tl = tr + 32 * i, t = t0 + tl, tb = t & (SEQ - 1);
      float a1[8], a2[8];
#pragma unroll
      for (int e = 0; e < 8; ++e) { a1[e] = bb1[e]; a2[e] = bb2[e]; }
#pragma unroll
      for (int k = 0; k < 3; ++k) {
        const int tbk = tb + k - 1;
        if (tbk >= 0 && tbk < SEQ) {
          float f[8], g[8];
          unpack8(*(const uint4*)(X1 + (size_t)(t + k - 1) * 1024 + c), f);
          unpack8(*(const uint4*)(V + (size_t)(t + k - 1) * 1024 + c), g);
#pragma unroll
          for (int e = 0; e < 8; ++e) { a1[e] += w1[k][e] * f[e]; a2[e] += w2[k][e] * g[e]; }
        }
      }
#pragma unroll
      for (int e = 0; e < 8; ++e) zs[(c8 * 8 + e) * 65 + tl] = a1[e] * a2[e];
    }
    __syncthreads();
    {
      const int cl = tid >> 2, tq = tid & 3;
      const int bidx = t0 >> 12, tbase = t0 & (SEQ - 1);
      float* dst = zT + ((size_t)(bidx * 1024 + c0 + cl)) * SEQ + tbase + tq * 16;
#pragma unroll
      for (int v4 = 0; v4 < 4; ++v4) {
        const float* s = zs + cl * 65 + tq * 16 + v4 * 4;
        *(float4*)(dst + v4 * 4) = make_float4(s[0], s[1], s[2], s[3]);
      }
    }
  }
}

__device__ __forceinline__ void fftconv_phase(float* zT, const float4* spec, const float2* T, const float* hd, unsigned char* smem) {
  float2* buf = (float2*)smem;
  const int tid = tid_fresh();
  for (int it = blockIdx.x; it < 4096; it += gridDim.x) {
    const int b = it & 7, pi = it >> 3, c1 = 2 * pi;
    float* z1 = zT + ((size_t)(b * 1024 + c1)) * SEQ;
    float* z2 = z1 + SEQ;
    __syncthreads();
    for (int t = tid; t < 4096; t += NT) { buf[PH(t)] = make_float2(z1[t], z2[t]); buf[PH(4096 + t)] = make_float2(0.f, 0.f); }
    __syncthreads();
    fft_dif(buf, T);
    const float4* sp = spec + (size_t)pi * SPEC_STRIDE;
    for (int k = tid; k <= 4096; k += NT) {
      const int pk0 = brev13(k), pn0 = brev13((8192 - k) & 8191);
      const int pk = PH(pk0), pn = PH(pn0);
      const float2 Xk = buf[pk], Xn = buf[pn];
      const float4 sd = sp[k];
      const float2 S = make_float2(sd.x, sd.y), D = make_float2(sd.z, sd.w);
      const float2 Wk = cadd(cmul(Xk, S), cmul(make_float2(Xn.x, -Xn.y), D));
      const float2 Wn = cadd(cmul(Xn, make_float2(S.x, -S.y)), cmul(make_float2(Xk.x, -Xk.y), make_float2(D.x, -D.y)));
      buf[pk] = make_float2(Wk.x, -Wk.y);
      buf[pn] = make_float2(Wn.x, -Wn.y);
    }
    __syncthreads();
    fft_dit(buf, T);
    const float d1 = hd[c1], d2 = hd[c1 + 1];
    for (int t = tid; t < 4096; t += NT) {
      const float2 y = buf[PH(t)];
      z1[t] = y.x + d1 * z1[t];
      z2[t] = -y.y + d2 * z2[t];
    }
  }
}

__device__ __forceinline__ void ya_phase(const bf16_t* X0, const float* yT, const float* cw, const float* cb, bf16_t* MA, unsigned char* smem) {
  float* ys = (float*)smem;
  const int tid = tid_fresh(), c8 = tid & 7, tr = tid >> 3;
  for (int it = blockIdx.x; it < 8192; it += gridDim.x) {
    const int ct = it & 15, tt = it >> 4, c0 = ct * 64, t0 = tt * 64;
    __syncthreads();
    {
      const int cl = tid >> 2, tq = tid & 3;
      const int bidx = t0 >> 12, tbase = t0 & (SEQ - 1);
      const float* src = yT + ((size_t)(bidx * 1024 + c0 + cl)) * SEQ + tbase + tq * 16;
#pragma unroll
      for (int v4 = 0; v4 < 4; ++v4) {
        const float4 v = *(const float4*)(src + v4 * 4);
        float* s = ys + cl * 65 + tq * 16 + v4 * 4;
        s[0] = v.x; s[1] = v.y; s[2] = v.z; s[3] = v.w;
      }
    }
    __syncthreads();
    const int c = c0 + c8 * 8;
    float w0[3][8], bb[8];
#pragma unroll
    for (int e = 0; e < 8; ++e) {
#pragma unroll
      for (int k = 0; k < 3; ++k) w0[k][e] = cw[k * 3072 + c + e];
      bb[e] = cb[c + e];
    }
#pragma unroll
    for (int i = 0; i < 2; ++i) {
      const int tl = tr + 32 * i, t = t0 + tl, tb = t & (SEQ - 1);
      float a[8];
#pragma unroll
      for (int e = 0; e < 8; ++e) a[e] = bb[e];
#pragma unroll
      for (int k = 0; k < 3; ++k) {
        const int tbk = tb + k - 1;
        if (tbk >= 0 && tbk < SEQ) {
          float f[8];
          unpack8(*(const uint4*)(X0 + (size_t)(t + k - 1) * 1024 + c), f);
#pragma unroll
          for (int e = 0; e < 8; ++e) a[e] += w0[k][e] * f[e];
        }
      }
#pragma unroll
      for (int e = 0; e < 8; ++e) a[e] *= ys[(c8 * 8 + e) * 65 + tl];
      *(uint4*)(MA + (size_t)t * 1024 + c) = make_uint4(pack2(a[0], a[1]), pack2(a[2], a[3]), pack2(a[4], a[5]), pack2(a[6], a[7]));
    }
  }
}

__device__ __forceinline__ void convT_job(const float* src, int K, int N, bf16_t* dst, const float* scale, unsigned char* smem) {
  float* ts = (float*)smem;
  const int tid = tid_fresh();
  const int tn = N >> 6, ntile = (K >> 6) * tn;
  for (int it = blockIdx.x; it < ntile; it += gridDim.x) {
    const int k0 = (it / tn) * 64, n0 = (it % tn) * 64;
    __syncthreads();
#pragma unroll
    for (int i = 0; i < 4; ++i) {
      const int r = (tid >> 4) + 16 * i, c4 = tid & 15;
      float4 v = *(const float4*)(src + (size_t)(k0 + r) * N + n0 + c4 * 4);
      const float s = scale ? scale[k0 + r] : 1.f;
      float* d = ts + r * 65 + c4 * 4;
      d[0] = v.x * s; d[1] = v.y * s; d[2] = v.z * s; d[3] = v.w * s;
    }
    __syncthreads();
#pragma unroll
    for (int i = 0; i < 2; ++i) {
      const int id = tid + 256 * i, nn = id >> 3, kc = id & 7;
      float f[8];
#pragma unroll
      for (int e = 0; e < 8; ++e) f[e] = ts[(kc * 8 + e) * 65 + nn];
      *(uint4*)(dst + (size_t)(n0 + nn) * K + k0 + kc * 8) = make_uint4(pack2(f[0], f[1]), pack2(f[2], f[3]), pack2(f[4], f[5]), pack2(f[6], f[7]));
    }
  }
}
__device__ __forceinline__ void conv_plain(const float* src, bf16_t* dst, size_t n) {
  const size_t stride = (size_t)gridDim.x * NT * 8;
  for (size_t i = ((size_t)blockIdx.x * NT + tid_fresh()) * 8; i < n; i += stride) {
    const float4 a = *(const float4*)(src + i), b = *(const float4*)(src + i + 4);
    *(uint4*)(dst + i) = make_uint4(pack2(a.x, a.y), pack2(a.z, a.w), pack2(b.x, b.y), pack2(b.z, b.w));
  }
}

__device__ __forceinline__ void final_norm(float* h, const float* g) {
  const int tid = tid_fresh(), wave = tid >> 6, lane = tid & 63;
  for (int row = blockIdx.x * 4 + wave; row < TOK; row += gridDim.x * 4) {
    float* p = h + (size_t)row * 1024;
    float4 v[4]; float s = 0.f;
#pragma unroll
    for (int i = 0; i < 4; ++i) { v[i] = *(const float4*)(p + i * 256 + lane * 4); s += v[i].x * v[i].x + v[i].y * v[i].y + v[i].z * v[i].z + v[i].w * v[i].w; }
#pragma unroll
    for (int o = 32; o > 0; o >>= 1) s += __shfl_xor(s, o);
    const float r = rsqrtf(s * (1.f / 1024.f) + 1e-6f);
#pragma unroll
    for (int i = 0; i < 4; ++i) {
      const float4 gg = *(const float4*)(g + i * 256 + lane * 4);
      *(float4*)(p + i * 256 + lane * 4) = make_float4(v[i].x * r * gg.x, v[i].y * r * gg.y, v[i].z * r * gg.z, v[i].w * r * gg.w);
    }
  }
}

#define GSYNC() do { asm volatile("s_waitcnt vmcnt(0) lgkmcnt(0)" ::: "memory"); grid.sync(); \
    if (tid_fresh() < 64) { __builtin_amdgcn_fence(__ATOMIC_ACQUIRE, "agent"); asm volatile("s_waitcnt vmcnt(0)" ::: "memory"); } \
    __syncthreads(); } while (0)
#define WSP(off) (params_fresh()->ws + (off))
#define INP(i) (params_fresh()->in[i])
#define WBP ((bf16_t*)WSP(WB_OFF))
#define HBA ((bf16_t*)WSP(HBA_OFF))
#define SPECP ((float4*)WSP(SPEC_OFF))
#define H3P ((float*)WSP(H3_OFF))
#define TWP ((float2*)WSP(TW_OFF))
#define SLOT(i) ((bf16_t*)WSP(R_OFF + (size_t)(i) * 64 * MiB))
#define HRES (params_fresh()->out)

__global__ void __launch_bounds__(NT, 2) mega(Params Pdummy) {
  __shared__ __attribute__((aligned(16))) unsigned char smem[65536];
  cg::grid_group grid = cg::this_grid();

  for (int j = 0; j < 2; ++j) {
    convT_job(INP(I_EWIN) + (size_t)j * 1024 * 7168, 1024, 7168, WBP + W_EIN + (size_t)j * 7340032, INP(I_NORMG) + (2 * j) * 1024, smem);
    convT_job(INP(I_OWIN) + (size_t)j * 1024 * 6144, 1024, 6144, WBP + W_OIN + (size_t)j * 6291456, INP(I_NORMG) + (2 * j + 1) * 1024, smem);
    convT_job(INP(I_EWOUT) + (size_t)j * 2048 * 1024, 2048, 1024, WBP + W_EOUT + (size_t)j * 2097152, nullptr, smem);
    convT_job(INP(I_OWOUT) + (size_t)j * 2048 * 1024, 2048, 1024, WBP + W_OOUT + (size_t)j * 2097152, nullptr, smem);
    for (int g = 0; g < 4; ++g)
      convT_job(INP(I_POOLW) + (size_t)(j * 4 + g) * 65536, 256, 256, WBP + W_POOL + (size_t)(j * 4 + g) * 65536, nullptr, smem);
  }
  for (int i = 0; i < 4; ++i) {
    convT_job(INP(I_PGATE) + (size_t)i * 1048576, 1024, 1024, WBP + W_PGATE + (size_t)i * 1048576, INP(I_PLEG) + i * 1024, smem);
    convT_job(INP(I_PUP) + (size_t)i * 262144, 256, 1024, WBP + W_PUP + (size_t)i * 262144, nullptr, smem);
  }
  conv_plain(INP(I_GMWS), WBP + W_GMWS, 262144);
  conv_plain(INP(I_X), HBA, (size_t)TOK * 1024);
  hyena_feats(H3P, smem);
  {
    float2* T = TWP;
    for (int k = blockIdx.x * NT + tid_fresh(); k < 4096; k += gridDim.x * NT) {
      float s, c; sincospif((float)k / 4096.f, &s, &c);
      T[k] = make_float2(c, -s);
    }
  }
  GSYNC();
  filtgen_phase(INP(I_HWOUT), 0, H3P, (float*)SLOT(3), smem);
  GSYNC();

#pragma unroll 1
  for (int layer = 0; layer < 4; ++layer) {
    const int j = layer >> 1;
    if ((layer & 1) == 0) {
      spectrum_phase((const float*)SLOT(3), TWP, SPECP, smem);
      inproj_phase(HBA, WBP + W_EIN + (size_t)j * 7340032, 3, 0, 1024, 2048, 0, SLOT(0), SLOT(1), SLOT(2), nullptr, 0, 0, 0, 0, smem);
      GSYNC();
      z_phase(SLOT(1), SLOT(2), INP(I_CONVW) + (size_t)j * 9216, INP(I_CONVB) + (size_t)j * 3072, (float*)SLOT(3), smem);
      GSYNC();
      fftconv_phase((float*)SLOT(3), SPECP, TWP, INP(I_HD) + j * 1024, smem);
      GSYNC();
      ya_phase(SLOT(0), (const float*)SLOT(3), INP(I_CONVW) + (size_t)j * 9216, INP(I_CONVB) + (size_t)j * 3072, SLOT(1), smem);
      GSYNC();
      inproj_phase(HBA, WBP + W_EIN + (size_t)j * 7340032, 2, 4096, 5120, 0, 0, SLOT(0), SLOT(2), nullptr, nullptr, 0, 3, 0, 0, smem, (float*)WSP(PART_OFF));
      GSYNC();
      gmlp_phase(SLOT(0), SLOT(2), WBP + W_GMWS + (size_t)j * 131072, INP(I_GMG) + j * 1024, INP(I_GMBS) + j * 1024, (const float*)WSP(PART_OFF), smem);
      GSYNC();
      inproj_phase(HBA, WBP + W_EIN + (size_t)j * 7340032, 2, 3072, 6144, 0, 0, SLOT(1), SLOT(0), nullptr, nullptr, 2, 2, 0, 0, smem);
      GSYNC();
      outproj_phase(SLOT(1), SLOT(0), WBP + W_EOUT + (size_t)j * 2097152, (layer == 0) ? INP(I_X) : (const float*)HRES, HRES, SLOT(3), smem);
      GSYNC();
      ple_phase(SLOT(3), INP(I_P) + (size_t)layer * TOK * 256, WBP + W_PGATE + (size_t)layer * 1048576, WBP + W_PUP + (size_t)layer * 262144, HRES, HBA, smem);
      GSYNC();
    } else {
      inproj_phase(HBA, WBP + W_OIN + (size_t)j * 6291456, 4, 0, 2048, 3072, 4096, SLOT(0), SLOT(1), SLOT(2), SLOT(3), 0, 0, 0, 1, smem);
      GSYNC();
      pool_phase(SLOT(0), WBP + W_POOL + (size_t)j * 262144, INP(I_POOLB) + j * 1024, INP(I_POOLS) + j * 1024, SLOT(4), smem);
      na_phase(SLOT(1), SLOT(2), SLOT(3), INP(I_RPB) + (size_t)j * 16 * 15 * 31);
      GSYNC();
      inproj_phase(HBA, WBP + W_OIN + (size_t)j * 6291456, 2, 1024, 5120, 0, 0, SLOT(4), SLOT(1), nullptr, nullptr, 2, 2, 0, 0, smem);
      GSYNC();
      outproj_phase(SLOT(4), SLOT(1), WBP + W_OOUT + (size_t)j * 2097152, HRES, HRES, SLOT(2), smem);
      GSYNC();
      ple_phase(SLOT(2), INP(I_P) + (size_t)layer * TOK * 256, WBP + W_PGATE + (size_t)layer * 1048576, WBP + W_PUP + (size_t)layer * 262144, HRES, HBA, smem);
      if (layer == 1) filtgen_phase(INP(I_HWOUT), 1, H3P, (float*)SLOT(3), smem);
      GSYNC();
    }
  }
  final_norm(HRES, INP(I_FINALG));
}

extern "C" void kernel_launch(void* const* d_in, const int* in_sizes, int n_in, void* d_out, int out_size, void* d_ws, size_t ws_size, hipStream_t stream) {
  static int grid_blocks = 0;
  if (grid_blocks == 0) {
    if (n_in != 29 || out_size != TOK * 1024 || ws_size < WS_END) { fprintf(stderr, "kernel_launch: unexpected shapes (n_in %d out %d ws %zu)\n", n_in, out_size, ws_size); grid_blocks = -1; return; }
    int dev = 0, cus = 0, per_cu = 0;
    if (hipGetDevice(&dev) != hipSuccess || hipDeviceGetAttribute(&cus, hipDeviceAttributeMultiprocessorCount, dev) != hipSuccess) { grid_blocks = -1; return; }
    if (hipOccupancyMaxActiveBlocksPerMultiprocessor(&per_cu, (const void*)mega, NT, LDS_BYTES) != hipSuccess || per_cu < 1) { fprintf(stderr, "occupancy query failed\n"); per_cu = 1; }
    if (per_cu > 2) per_cu = 2;
    grid_blocks = cus * per_cu;
  }
  if (grid_blocks < 0) return;
  Params p{};
  for (int i = 0; i < 29; ++i) p.in[i] = (const float*)d_in[i];
  p.out = (float*)d_out; p.ws = (unsigned char*)d_ws;
  void* args[] = {&p};
  hipError_t e = hipLaunchCooperativeKernel((const void*)mega, dim3(grid_blocks), dim3(NT), args, LDS_BYTES, stream);
  if (e != hipSuccess) fprintf(stderr, "cooperative launch failed: %s (grid %d)\n", hipGetErrorString(e), grid_blocks);
}
```

```cpp
#include <hip/hip_runtime.h>
#include <hip/hip_cooperative_groups.h>
#include <cstdio>
namespace cg = cooperative_groups;

typedef unsigned short bf16_t;
typedef short bf16x8 __attribute__((ext_vector_type(8)));
typedef short bf16x4 __attribute__((ext_vector_type(4)));
typedef float f32x4 __attribute__((ext_vector_type(4)));

#define NT 256
constexpr int LDS_BYTES = 0;
constexpr size_t MiB = 1u << 20;
constexpr size_t WB_OFF = 0, HBA_OFF = 80 * MiB, SPEC_OFF = 144 * MiB, H3_OFF = 177 * MiB, TW_OFF = 179 * MiB, R_OFF = 180 * MiB, PART_OFF = 500 * MiB, BAR_OFF = 502 * MiB, WS_END = 503 * MiB;
constexpr int TOK = 32768, SEQ = 4096, DM = 1024;
constexpr size_t W_EIN = 0, W_OIN = 14680064, W_EOUT = 27262976, W_OOUT = 31457280, W_PGATE = 35651584, W_PUP = 39845888, W_POOL = 40894464, W_GMWS = 41418752;
constexpr int SPEC_STRIDE = 4104;

struct Params { const float* in[29]; float* out; unsigned char* ws; };
enum { I_X = 0, I_P, I_NORMG, I_FINALG, I_EWIN, I_CONVW, I_CONVB, I_HW0, I_HB0, I_HW1, I_HB1, I_HW2, I_HB2, I_HWOUT, I_HFREQ, I_HD, I_GMG, I_GMWS, I_GMBS, I_EWOUT, I_OWIN, I_POOLW, I_POOLB, I_POOLS, I_RPB, I_OWOUT, I_PUP, I_PGATE, I_PLEG };

__device__ __forceinline__ unsigned short f2bf(float f) { unsigned u = __float_as_uint(f); u += 0x7fffu + ((u >> 16) & 1u); return (unsigned short)(u >> 16); }
__device__ __forceinline__ float bf2f(unsigned short h) { return __uint_as_float(((unsigned)h) << 16); }
__device__ __forceinline__ unsigned pack2(float lo, float hi) { return (unsigned)f2bf(lo) | ((unsigned)f2bf(hi) << 16); }
__device__ __forceinline__ float lo_f(unsigned u) { return __uint_as_float(u << 16); }
__device__ __forceinline__ float hi_f(unsigned u) { return __uint_as_float(u & 0xffff0000u); }
__device__ __forceinline__ float silu_f(float v) { return v / (1.f + __expf(-v)); }
__device__ __forceinline__ float sigmoid_f(float v) { return 1.f / (1.f + __expf(-v)); }
__device__ __forceinline__ void unpack8(const uint4& u, float* f) { f[0] = lo_f(u.x); f[1] = hi_f(u.x); f[2] = lo_f(u.y); f[3] = hi_f(u.y); f[4] = lo_f(u.z); f[5] = hi_f(u.z); f[6] = lo_f(u.w); f[7] = hi_f(u.w); }

typedef const Params __attribute__((address_space(4)))* KP;
__device__ __forceinline__ KP params_fresh() { KP p = (KP)__builtin_amdgcn_kernarg_segment_ptr(); asm volatile("" : "+s"(p)); return p; }
__device__ __forceinline__ int tid_fresh() { int t = threadIdx.x; asm volatile("" : "+v"(t)); return t; }

__device__ __forceinline__ int swz(int row, int kc) { return row * 128 + ((kc ^ ((row >> 1) & 7)) << 4); }

template <int AM, bool SS>
__device__ __forceinline__ void load_a1(int tid, uint4& out, float& ssq, const void* A0, const void* A1, int lda, int row, int k0, int aux) {
  const int kc = tid & 7;
  if (AM == 0) {
    out = *(const uint4*)((const bf16_t*)A0 + (size_t)row * lda + k0 + kc * 8);
  } else if (AM == 2) {
    const bf16_t* src = (k0 < 1024) ? (const bf16_t*)A0 : (const bf16_t*)A1;
    out = *(const uint4*)(src + (size_t)row * lda + (k0 & 1023) + kc * 8);
  } else if (AM == 1) {
    const float* src = (const float*)A0 + (size_t)row * lda + k0 + kc * 8;
    const float4 a = *(const float4*)src, b = *(const float4*)(src + 4);
    out = make_uint4(pack2(a.x, a.y), pack2(a.z, a.w), pack2(b.x, b.y), pack2(b.z, b.w));
  } else {
    const bf16_t* src = (const bf16_t*)A0 + k0 + kc * 8;
    const int half = 1 << aux;
    const int tb = row & (SEQ - 1), base = row - tb;
    const int lo = max(tb - half, 0), hi = min(tb + half, SEQ);
    float s0 = 0.f, s1 = 0.f, s2 = 0.f, s3 = 0.f, s4 = 0.f, s5 = 0.f, s6 = 0.f, s7 = 0.f;
    const int cnt = hi - lo;
    const bf16_t* wp = src + (size_t)(base + lo) * lda;
#pragma unroll 1
    for (int d0 = 0; d0 < cnt; d0 += 8) {
      uint4 wv[8];
#pragma unroll
      for (int d = 0; d < 8; ++d) wv[d] = (d0 + d < cnt) ? *(const uint4*)(wp + (size_t)(d0 + d) * lda) : make_uint4(0u, 0u, 0u, 0u);
#pragma unroll
      for (int d = 0; d < 8; ++d) {
        s0 += lo_f(wv[d].x); s1 += hi_f(wv[d].x); s2 += lo_f(wv[d].y); s3 += hi_f(wv[d].y); s4 += lo_f(wv[d].z); s5 += hi_f(wv[d].z); s6 += lo_f(wv[d].w); s7 += hi_f(wv[d].w);
      }
    }
    const uint4 u = *(const uint4*)(src + (size_t)row * lda);
    const float inv = 1.f / (float)(hi - lo);
    out = make_uint4(pack2(s0 * inv - lo_f(u.x), s1 * inv - hi_f(u.x)), pack2(s2 * inv - lo_f(u.y), s3 * inv - hi_f(u.y)),
                     pack2(s4 * inv - lo_f(u.z), s5 * inv - hi_f(u.z)), pack2(s6 * inv - lo_f(u.w), s7 * inv - hi_f(u.w)));
  }
}
template <int AM, bool SS>
__device__ __forceinline__ void load_a(int tid, uint4& a0, uint4& a1, uint4& a2, uint4& a3, const void* A0, const void* A1, int lda, int m0, int k0, int aux, float (&ss)[4]) {
  const int row = m0 + (tid >> 3);
  load_a1<AM, SS>(tid, a0, ss[0], A0, A1, lda, row, k0, aux);
  load_a1<AM, SS>(tid, a1, ss[1], A0, A1, lda, row + 32, k0, aux);
  load_a1<AM, SS>(tid, a2, ss[2], A0, A1, lda, row + 64, k0, aux);
  load_a1<AM, SS>(tid, a3, ss[3], A0, A1, lda, row + 96, k0, aux);
}
__device__ __forceinline__ void load_b(int tid, uint4& b0, uint4& b1, uint4& b2, uint4& b3, const bf16_t* Bt, int ldb, int n0, int k0) {
  const bf16_t* p = Bt + (size_t)(n0 + (tid >> 3)) * ldb + k0 + (tid & 7) * 8;
  b0 = *(const uint4*)p; b1 = *(const uint4*)(p + (size_t)32 * ldb); b2 = *(const uint4*)(p + (size_t)64 * ldb); b3 = *(const uint4*)(p + (size_t)96 * ldb);
}
__device__ __forceinline__ void store_tile(int tid, unsigned char* dst, const uint4& r0v, const uint4& r1v, const uint4& r2v, const uint4& r3v) {
  const int r0 = tid >> 3, kc = tid & 7;
  *(uint4*)(dst + swz(r0, kc)) = r0v; *(uint4*)(dst + swz(r0 + 32, kc)) = r1v; *(uint4*)(dst + swz(r0 + 64, kc)) = r2v; *(uint4*)(dst + swz(r0 + 96, kc)) = r3v;
}

__device__ __forceinline__ float ssq8(const uint4& v) {
  const float f0 = lo_f(v.x), f1 = hi_f(v.x), f2 = lo_f(v.y), f3 = hi_f(v.y), f4 = lo_f(v.z), f5 = hi_f(v.z), f6 = lo_f(v.w), f7 = hi_f(v.w);
  return f0 * f0 + f1 * f1 + f2 * f2 + f3 * f3 + f4 * f4 + f5 * f5 + f6 * f6 + f7 * f7;
}
template <bool SS>
__device__ __forceinline__ void store_a(int tid, unsigned char* dst, const uint4& a0, const uint4& a1, const uint4& a2, const uint4& a3, float (&ss)[4]) {
  if (SS) { ss[0] += ssq8(a0); ss[1] += ssq8(a1); ss[2] += ssq8(a2); ss[3] += ssq8(a3); }
  store_tile(tid, dst, a0, a1, a2, a3);
}
template <bool SWAP>
__device__ __forceinline__ void mma_tile(f32x4 (&acc)[4][4], const unsigned char* cur, int wr, int wc, int fr, int fq) {
#pragma unroll
  for (int s = 0; s < 2; ++s) {
    bf16x8 af[4], bfr[4];
#pragma unroll
    for (int m = 0; m < 4; ++m) af[m] = *(const bf16x8*)(cur + swz(wr * 64 + m * 16 + fr, s * 4 + fq));
#pragma unroll
    for (int n = 0; n < 4; ++n) bfr[n] = *(const bf16x8*)(cur + 16384 + swz(wc * 64 + n * 16 + fr, s * 4 + fq));
    __builtin_amdgcn_s_setprio(1);
#pragma unroll
    for (int m = 0; m < 4; ++m)
#pragma unroll
      for (int n = 0; n < 4; ++n)
        acc[m][n] = SWAP ? __builtin_amdgcn_mfma_f32_16x16x32_bf16(bfr[n], af[m], acc[m][n], 0, 0, 0)
                         : __builtin_amdgcn_mfma_f32_16x16x32_bf16(af[m], bfr[n], acc[m][n], 0, 0, 0);
    __builtin_amdgcn_s_setprio(0);
  }
}
template <int AM, bool SS, bool SWAP>
__device__ __forceinline__ void gemm_mainloop(f32x4 (&acc)[4][4], const void* A0, const void* A1, int lda, const bf16_t* Bt, int ldb,
                                              int m0, int n0, int K, int aux, unsigned char* smem, float (&ss)[4], int rot) {
  const int tid = tid_fresh(), wid = tid >> 6, lane = tid & 63, wr = wid >> 1, wc = wid & 1, fr = lane & 15, fq = lane >> 4;
  const int nk = K >> 6, km = nk - 1;
  unsigned char* L0 = smem;
  unsigned char* L1 = smem + 32768;
  uint4 a0, a1, a2, a3, b0, b1, b2, b3;
  __syncthreads();
  if (AM == 0 || AM == 2) {
    uint4 c0, c1, c2, c3, d0, d1, d2, d3;
    load_a<AM, SS>(tid, a0, a1, a2, a3, A0, A1, lda, m0, (rot & km) << 6, aux, ss);
    load_b(tid, b0, b1, b2, b3, Bt, ldb, n0, (rot & km) << 6);
    load_a<AM, SS>(tid, c0, c1, c2, c3, A0, A1, lda, m0, ((1 + rot) & km) << 6, aux, ss);
    load_b(tid, d0, d1, d2, d3, Bt, ldb, n0, ((1 + rot) & km) << 6);
    store_a<SS>(tid, L0, a0, a1, a2, a3, ss); store_tile(tid, L0 + 16384, b0, b1, b2, b3);
    __syncthreads();
    for (int kt = 0; kt < nk; kt += 2) {
      const int k2 = ((min(kt + 2, km) + rot) & km) << 6, k3 = ((min(kt + 3, km) + rot) & km) << 6;
      load_a<AM, SS>(tid, a0, a1, a2, a3, A0, A1, lda, m0, k2, aux, ss); load_b(tid, b0, b1, b2, b3, Bt, ldb, n0, k2);
      __builtin_amdgcn_sched_barrier(0);
      mma_tile<SWAP>(acc, L0, wr, wc, fr, fq);
      store_a<SS>(tid, L1, c0, c1, c2, c3, ss); store_tile(tid, L1 + 16384, d0, d1, d2, d3);
      __syncthreads();
      load_a<AM, SS>(tid, c0, c1, c2, c3, A0, A1, lda, m0, k3, aux, ss); load_b(tid, d0, d1, d2, d3, Bt, ldb, n0, k3);
      __builtin_amdgcn_sched_barrier(0);
      mma_tile<SWAP>(acc, L1, wr, wc, fr, fq);
      if (SS) { if (kt + 2 < nk) { ss[0] += ssq8(a0); ss[1] += ssq8(a1); ss[2] += ssq8(a2); ss[3] += ssq8(a3); } }
      store_tile(tid, L0, a0, a1, a2, a3); store_tile(tid, L0 + 16384, b0, b1, b2, b3);
      __syncthreads();
    }
    asm volatile("s_waitcnt vmcnt(0)" ::: "memory");
  } else {
    load_a<AM, SS>(tid, a0, a1, a2, a3, A0, A1, lda, m0, (rot & km) << 6, aux, ss);
    load_b(tid, b0, b1, b2, b3, Bt, ldb, n0, (rot & km) << 6);
    store_a<SS>(tid, L0, a0, a1, a2, a3, ss); store_tile(tid, L0 + 16384, b0, b1, b2, b3);
    __syncthreads();
    for (int kt = 0; kt < nk; ++kt) {
      unsigned char* cur = smem + (kt & 1) * 32768;
      unsigned char* nxt = smem + ((kt + 1) & 1) * 32768;
      const bool more = (kt + 1 < nk);
      if (more) { load_a<AM, SS>(tid, a0, a1, a2, a3, A0, A1, lda, m0, ((kt + 1 + rot) & km) << 6, aux, ss); load_b(tid, b0, b1, b2, b3, Bt, ldb, n0, ((kt + 1 + rot) & km) << 6); }
      mma_tile<SWAP>(acc, cur, wr, wc, fr, fq);
      if (more) { store_a<SS>(tid, nxt, a0, a1, a2, a3, ss); store_tile(tid, nxt + 16384, b0, b1, b2, b3); }
      __syncthreads();
    }
  }
}
__device__ __forceinline__ void finish_rstd(float (&ss)[4], unsigned char* smem) {
  const int tid = tid_fresh(), r0 = tid >> 3, kc = tid & 7;
  float* rs = (float*)smem;
#pragma unroll
  for (int i = 0; i < 4; ++i) {
    float v = ss[i];
    v += __shfl_xor(v, 1); v += __shfl_xor(v, 2); v += __shfl_xor(v, 4);
    if (kc == 0) rs[r0 + 32 * i] = rsqrtf(v * (1.f / 1024.f) + 1e-6f);
  }
  __syncthreads();
}
__device__ __forceinline__ void zero_acc(f32x4 (&acc)[4][4]) {
#pragma unroll
  for (int m = 0; m < 4; ++m)
#pragma unroll
    for (int n = 0; n < 4; ++n) acc[m][n] = (f32x4){0.f, 0.f, 0.f, 0.f};
}

__device__ __forceinline__ bool tile_pick(int i, int nNt, int& mt, int& nt, int& L) {
  const int b = blockIdx.x;
  L = i * (int)gridDim.x + (b & 7) * ((int)gridDim.x >> 3) + (b >> 3);
  if (L >= 256 * nNt) return false;
  const int band = L / (8 * nNt), r = L - band * (8 * nNt), c = r >> 6, w = r & 63;
  mt = band * 8 + (w & 7); nt = c * 8 + (w >> 3);
  return true;
}

__device__ __forceinline__ void inproj_phase(const bf16_t* hb, const bf16_t* W, int ng, int wr0, int wr1, int wr2, int wr3,
                             bf16_t* d0, bf16_t* d1, bf16_t* d2, bf16_t* d3, int md0, int md1, int md2, int md3, unsigned char* smem, float* part = nullptr) {
  const int tid = tid_fresh(), wid = tid >> 6, lane = tid & 63, wr = wid >> 1, wc = wid & 1, fr = lane & 15, fq = lane >> 4;
  for (int i = 0;; ++i) {
    int mt, ntg, t;
    if (!tile_pick(i, ng * 8, mt, ntg, t)) break;
    const int grp = ntg >> 3, nt = ntg & 7;
    const int wrow = grp == 0 ? wr0 : grp == 1 ? wr1 : grp == 2 ? wr2 : wr3;
    bf16_t* dst = grp == 0 ? d0 : grp == 1 ? d1 : grp == 2 ? d2 : d3;
    const int mode = grp == 0 ? md0 : grp == 1 ? md1 : grp == 2 ? md2 : md3;
    const int m0 = mt * 128, n0 = nt * 128;
    f32x4 acc[4][4]; zero_acc(acc);
    float ss[4] = {0.f, 0.f, 0.f, 0.f};
    if (mode == 1) {
      gemm_mainloop<0, true, false>(acc, hb, nullptr, 1024, W + (size_t)wrow * 1024, 1024, m0, n0, 1024, 0, smem, ss, 0);
      finish_rstd(ss, smem);
      const float* rs = (const float*)smem;
#pragma unroll
      for (int m = 0; m < 4; ++m) {
        const int rl = wr * 64 + m * 16 + fq * 4;
        const float r0 = rs[rl], r1 = rs[rl + 1], r2 = rs[rl + 2], r3 = rs[rl + 3];
#pragma unroll
        for (int n = 0; n < 4; ++n) {
          const int col = n0 + wc * 64 + n * 16 + fr;
          uint2 o; o.x = pack2(acc[m][n][0] * r0, acc[m][n][1] * r1); o.y = pack2(acc[m][n][2] * r2, acc[m][n][3] * r3);
          *(uint2*)(dst + (size_t)col * TOK + m0 + rl) = o;
        }
      }
    } else {
      gemm_mainloop<0, true, true>(acc, hb, nullptr, 1024, W + (size_t)wrow * 1024, 1024, m0, n0, 1024, 0, smem, ss, 0);
      finish_rstd(ss, smem);
      const float* rs = (const float*)smem;
      uint2 old[4][4];
      if (mode == 2) {
#pragma unroll
        for (int m = 0; m < 4; ++m)
#pragma unroll
          for (int n = 0; n < 4; ++n) old[m][n] = *(const uint2*)(dst + (size_t)(m0 + wr * 64 + m * 16 + fr) * 1024 + n0 + wc * 64 + n * 16 + fq * 4);
      }
#pragma unroll
      for (int m = 0; m < 4; ++m) {
        const int rl = wr * 64 + m * 16 + fr;
        const float r = rs[rl];
        float psq = 0.f;
#pragma unroll
        for (int n = 0; n < 4; ++n) {
          const int col = n0 + wc * 64 + n * 16 + fq * 4;
          bf16_t* pd = dst + (size_t)(m0 + rl) * 1024 + col;
          float v0 = acc[m][n][0] * r, v1 = acc[m][n][1] * r, v2 = acc[m][n][2] * r, v3 = acc[m][n][3] * r;
          if (mode == 2) {
            v0 = lo_f(old[m][n].x) * silu_f(v0); v1 = hi_f(old[m][n].x) * silu_f(v1); v2 = lo_f(old[m][n].y) * silu_f(v2); v3 = hi_f(old[m][n].y) * silu_f(v3);
          }
          uint2 o; o.x = pack2(v0, v1); o.y = pack2(v2, v3);
          *(uint2*)pd = o;
          if (mode == 3) psq += v0 * v0 + v1 * v1 + v2 * v2 + v3 * v3;
        }
        if (mode == 3) {
          psq += __shfl_xor(psq, 16); psq += __shfl_xor(psq, 32);
          if (fq == 0) part[(size_t)(m0 + rl) * 16 + nt * 2 + wc] = psq;
        }
      }
    }
  }
}

__device__ __forceinline__ void outproj_phase(const bf16_t* MA, const bf16_t* MB, const bf16_t* Wt  , const float* hsrc, float* hres, bf16_t* hbB, unsigned char* smem) {
  const int tid = tid_fresh(), wid = tid >> 6, lane = tid & 63, wr = wid >> 1, wc = wid & 1, fr = lane & 15, fq = lane >> 4;
  for (int i = 0;; ++i) {
    int mt, nt, t;
    if (!tile_pick(i, 8, mt, nt, t)) break;
    const int m0 = mt * 128, n0 = nt * 128;
    f32x4 acc[4][4]; zero_acc(acc);
    float ss[4] = {0.f, 0.f, 0.f, 0.f};
    gemm_mainloop<2, false, true>(acc, MA, MB, 1024, Wt, 2048, m0, n0, 2048, 0, smem, ss, 0);
#pragma unroll
    for (int m = 0; m < 4; ++m) {
      const int row = m0 + wr * 64 + m * 16 + fr;
      const size_t idx = (size_t)row * 1024 + n0 + wc * 64 + fq * 4;
      float4 h[4];
#pragma unroll
      for (int n = 0; n < 4; ++n) h[n] = *(const float4*)(hsrc + idx + n * 16);
#pragma unroll
      for (int n = 0; n < 4; ++n) {
        const float4 o = make_float4(h[n].x + acc[m][n][0], h[n].y + acc[m][n][1], h[n].z + acc[m][n][2], h[n].w + acc[m][n][3]);
        *(float4*)(hres + idx + n * 16) = o;
        uint2 ob; ob.x = pack2(o.x, o.y); ob.y = pack2(o.z, o.w);
        *(uint2*)(hbB + idx + n * 16) = ob;
      }
    }
  }
}

__device__ __forceinline__ void ple_phase(const bf16_t* hbB, const float* pin  , const bf16_t* Wg  , const bf16_t* Wup  ,
                          float* hres, bf16_t* hbA, unsigned char* smem) {
  const int tid = tid_fresh(), wid = tid >> 6, lane = tid & 63, wr = wid >> 1, wc = wid & 1, fr = lane & 15, fq = lane >> 4;
  for (int i = 0;; ++i) {
    int mt, nt, t;
    if (!tile_pick(i, 8, mt, nt, t)) break;
    const int m0 = mt * 128, n0 = nt * 128;
    f32x4 ag[4][4]; zero_acc(ag);
    float ss[4] = {0.f, 0.f, 0.f, 0.f};
    gemm_mainloop<0, true, true>(ag, hbB, nullptr, 1024, Wg, 1024, m0, n0, 1024, 0, smem, ss, 0);
    finish_rstd(ss, smem);
    unsigned gp[4][4][2];
    {
      const float* rs = (const float*)smem;
#pragma unroll
      for (int m = 0; m < 4; ++m) {
        const float r = rs[wr * 64 + m * 16 + fr];
#pragma unroll
        for (int n = 0; n < 4; ++n) {
          gp[m][n][0] = pack2(sigmoid_f(r * ag[m][n][0]), sigmoid_f(r * ag[m][n][1]));
          gp[m][n][1] = pack2(sigmoid_f(r * ag[m][n][2]), sigmoid_f(r * ag[m][n][3]));
        }
      }
    }
    zero_acc(ag);
    float ss2[4] = {0.f, 0.f, 0.f, 0.f};
    gemm_mainloop<1, false, true>(ag, pin, nullptr, 256, Wup, 256, m0, n0, 256, 0, smem, ss2, 0);
#pragma unroll
    for (int m = 0; m < 4; ++m) {
      const int rl = wr * 64 + m * 16 + fr;
      const size_t idx = (size_t)(m0 + rl) * 1024 + n0 + wc * 64 + fq * 4;
      float4 h[4];
#pragma unroll
      for (int n = 0; n < 4; ++n) h[n] = *(const float4*)(hres + idx + n * 16);
#pragma unroll
      for (int n = 0; n < 4; ++n) {
        float4 o;
        o.x = h[n].x + ag[m][n][0] * lo_f(gp[m][n][0]);
        o.y = h[n].y + ag[m][n][1] * hi_f(gp[m][n][0]);
        o.z = h[n].z + ag[m][n][2] * lo_f(gp[m][n][1]);
        o.w = h[n].w + ag[m][n][3] * hi_f(gp[m][n][1]);
        *(float4*)(hres + idx + n * 16) = o;
        uint2 ob; ob.x = pack2(o.x, o.y); ob.y = pack2(o.z, o.w);
        *(uint2*)(hbA + idx + n * 16) = ob;
      }
    }
  }
}

__device__ __forceinline__ void pool_phase(const bf16_t* XC, const bf16_t* Wp  , const float* pb, const float* ps, bf16_t* MC, unsigned char* smem) {
  const int tid = tid_fresh(), wid = tid >> 6, lane = tid & 63, wr = wid >> 1, wc = wid & 1, fr = lane & 15, fq = lane >> 4;
  for (int t = blockIdx.x; t < 2048; t += gridDim.x) {
    const int mt = t >> 3, g = (t >> 1) & 3, nt = t & 1, m0 = mt * 128, n0 = nt * 128;
    f32x4 acc[4][4]; zero_acc(acc);
    float ss[4] = {0.f, 0.f, 0.f, 0.f};
    gemm_mainloop<3, false, true>(acc, XC + g * 256, nullptr, 1024, Wp + (size_t)g * 65536, 256, m0, n0, 256, g, smem, ss, t + (t >> 2));
#pragma unroll
    for (int m = 0; m < 4; ++m) {
      const int row = m0 + wr * 64 + m * 16 + fr;
#pragma unroll
      for (int n = 0; n < 4; ++n) {
        const int col = g * 256 + n0 + wc * 64 + n * 16 + fq * 4;
        const float4 b = *(const float4*)(pb + col), s = *(const float4*)(ps + col);
        uint2 o; o.x = pack2((acc[m][n][0] + b.x) * s.x, (acc[m][n][1] + b.y) * s.y); o.y = pack2((acc[m][n][2] + b.z) * s.z, (acc[m][n][3] + b.w) * s.w);
        *(uint2*)(MC + (size_t)row * 1024 + col) = o;
      }
    }
  }
}

__device__ __forceinline__ void gmlp_phase(bf16_t* UB, const bf16_t* VB, const bf16_t* Ws  , const float* gmg, const float* gbs  , const float* part, unsigned char* smem) {
  const int tid = tid_fresh(), wid = tid >> 6, lane = tid & 63, wr = wid >> 1, wc = wid & 1, fr = lane & 15, fq = lane >> 4;
  unsigned char* sW = smem;
  unsigned char* sX = smem + 32768;
  for (int it = blockIdx.x; it < 2048; it += gridDim.x) {
    const int g = it & 7, tok0 = (it >> 3) * 128;
    __syncthreads();
#pragma unroll 2
    for (int i = 0; i < 8; ++i) {
      const int id = tid + 256 * i, row = id >> 4, kc = id & 15;
      *(uint4*)(sW + row * 256 + ((kc ^ (row & 15)) << 4)) = *(const uint4*)(Ws + (size_t)g * 16384 + row * 128 + kc * 8);
    }
    float rq;
    {
      const float4* pp = (const float4*)(part + (size_t)(tok0 + (tid & 127)) * 16);
      const float4 p0 = pp[0], p1 = pp[1], p2 = pp[2], p3 = pp[3];
      const float sq = (p0.x + p0.y + p0.z + p0.w) + (p1.x + p1.y + p1.z + p1.w) + (p2.x + p2.y + p2.z + p2.w) + (p3.x + p3.y + p3.z + p3.w);
      rq = rsqrtf(sq * (1.f / 1024.f) + 1e-6f);
    }
    __syncthreads();
#pragma unroll 2
    for (int i = 0; i < 8; ++i) {
      const int id = tid + 256 * i, q = id & 127, cc = id >> 7;
      float f[8]; unpack8(*(const uint4*)(VB + (size_t)(tok0 + q) * 1024 + g * 128 + cc * 8), f);
#pragma unroll
      for (int e = 0; e < 8; ++e) {
        const int c = cc * 8 + e;
        const float v = f[e] * rq * gmg[g * 128 + c];
        *(bf16_t*)(sX + c * 256 + (((q >> 3) ^ (c & 15)) << 4) + (q & 7) * 2) = f2bf(v);
      }
    }
    __syncthreads();
    f32x4 acc[4][4]; zero_acc(acc);
#pragma unroll
    for (int s = 0; s < 4; ++s) {
      bf16x8 af[4], bfr[4];
#pragma unroll
      for (int m = 0; m < 4; ++m) { const int row = wr * 64 + m * 16 + fr; af[m] = *(const bf16x8*)(sW + row * 256 + (((s * 4 + fq) ^ (row & 15)) << 4)); }
#pragma unroll
      for (int n = 0; n < 4; ++n) { const int row = wc * 64 + n * 16 + fr; bfr[n] = *(const bf16x8*)(sX + row * 256 + (((s * 4 + fq) ^ (row & 15)) << 4)); }
#pragma unroll
      for (int m = 0; m < 4; ++m)
#pragma unroll
        for (int n = 0; n < 4; ++n) acc[m][n] = __builtin_amdgcn_mfma_f32_16x16x32_bf16(bfr[n], af[m], acc[m][n], 0, 0, 0);
    }
    uint2 uo[4][4];
#pragma unroll
    for (int m = 0; m < 4; ++m)
#pragma unroll
      for (int n = 0; n < 4; ++n) uo[m][n] = *(const uint2*)(UB + (size_t)(tok0 + wr * 64 + m * 16 + fr) * 1024 + g * 128 + wc * 64 + n * 16 + fq * 4);
#pragma unroll
    for (int m = 0; m < 4; ++m) {
      const int p = wr * 64 + m * 16 + fr;
      const float bias = gbs[g * 128 + p];
#pragma unroll
      for (int n = 0; n < 4; ++n) {
        const int c = wc * 64 + n * 16 + fq * 4;
        bf16_t* pd = UB + (size_t)(tok0 + p) * 1024 + g * 128 + c;
        const uint2 u = uo[m][n];
        uint2 o; o.x = pack2(lo_f(u.x) * (acc[m][n][0] + bias), hi_f(u.x) * (acc[m][n][1] + bias));
        o.y = pack2(lo_f(u.y) * (acc[m][n][2] + bias), hi_f(u.y) * (acc[m][n][3] + bias));
        *(uint2*)pd = o;
      }
    }
  }
}

__device__ __forceinline__ void na_phase(bf16_t* Q, const bf16_t* Kb, const bf16_t* Vt, const float* rpb) {
  const int tid = tid_fresh(), wave = tid >> 6, lane = tid & 63, fr = lane & 15, fq = lane >> 4;
  const int nw = gridDim.x * 4;
  for (int it = blockIdx.x * 4 + wave; it < 8 * 64 * 16 * 4; it += nw) {
    const int wq = it & 3, h = (it >> 2) & 15, r = (it >> 6) & 63, b = it >> 12;
    const int rs = min(max(r - 4, 0), 56);
    const int w0 = (wq == 0) ? 0 : (wq == 1) ? 8 : (wq == 2) ? 24 : 32;
    const int qc = wq * 16 + fr;
    const int tokq = b * 4096 + r * 64 + qc;
    const bf16x8 qf0 = *(const bf16x8*)(Q + (size_t)tokq * 1024 + h * 64 + fq * 8);
    const bf16x8 qf1 = *(const bf16x8*)(Q + (size_t)tokq * 1024 + h * 64 + 32 + fq * 8);
    const int cs = min(max(qc - 8, 0), 48);
    const float* rp = rpb + h * (15 * 31);
    f32x4 sc[8][2];
    float mx = -1e30f;
#pragma unroll
    for (int hb = 0; hb < 2; ++hb) {
      bf16x8 kf[4][2][2];
#pragma unroll
      for (int j4 = 0; j4 < 4; ++j4)
#pragma unroll
        for (int hc = 0; hc < 2; ++hc) {
          const int tokk = b * 4096 + (rs + hb * 4 + j4) * 64 + w0 + 8 * (fr >> 2) + 4 * hc + (fr & 3);
          kf[j4][hc][0] = *(const bf16x8*)(Kb + (size_t)tokk * 1024 + h * 64 + fq * 8);
          kf[j4][hc][1] = *(const bf16x8*)(Kb + (size_t)tokk * 1024 + h * 64 + 32 + fq * 8);
        }
      __builtin_amdgcn_sched_barrier(0);
#pragma unroll
      for (int j4 = 0; j4 < 4; ++j4) {
        const int jr = hb * 4 + j4;
#pragma unroll
        for (int hc = 0; hc < 2; ++hc) {
          f32x4 a = (f32x4){0.f, 0.f, 0.f, 0.f};
          a = __builtin_amdgcn_mfma_f32_16x16x32_bf16(kf[j4][hc][0], qf0, a, 0, 0, 0);
          a = __builtin_amdgcn_mfma_f32_16x16x32_bf16(kf[j4][hc][1], qf1, a, 0, 0, 0);
          const int dr = rs + jr - r + 7;
#pragma unroll
          for (int e = 0; e < 4; ++e) {
            const int kcol = w0 + 8 * fq + 4 * hc + e;
            const bool valid = (kcol >= cs) && (kcol < cs + 16);
            const int dc = min(max(kcol - qc + 15, 0), 30);
            const float v = valid ? (a[e] * 0.125f + rp[dr * 31 + dc]) : -1e30f;
            a[e] = v; mx = fmaxf(mx, v);
          }
          sc[jr][hc] = a;
        }
      }
    }
    mx = fmaxf(mx, __shfl_xor(mx, 16)); mx = fmaxf(mx, __shfl_xor(mx, 32));
    float sum = 0.f;
#pragma unroll
    for (int jr = 0; jr < 8; ++jr)
#pragma unroll
      for (int hc = 0; hc < 2; ++hc)
#pragma unroll
        for (int e = 0; e < 4; ++e) { const float pv = (sc[jr][hc][e] > -1e29f) ? __expf(sc[jr][hc][e] - mx) : 0.f; sc[jr][hc][e] = pv; sum += pv; }
    sum += __shfl_xor(sum, 16); sum += __shfl_xor(sum, 32);
    const float inv = 1.f / sum;
    f32x4 o[4];
#pragma unroll
    for (int dt = 0; dt < 4; ++dt) o[dt] = (f32x4){0.f, 0.f, 0.f, 0.f};
#pragma unroll
    for (int jp = 0; jp < 4; ++jp) {
      bf16x8 vf[2][4];
#pragma unroll
      for (int j2 = 0; j2 < 2; ++j2) {
        const size_t tk = (size_t)b * 4096 + (rs + jp * 2 + j2) * 64 + w0 + fq * 8;
#pragma unroll
        for (int dt = 0; dt < 4; ++dt) vf[j2][dt] = *(const bf16x8*)(Vt + (size_t)(h * 64 + dt * 16 + fr) * TOK + tk);
      }
      __builtin_amdgcn_sched_barrier(0);
#pragma unroll
      for (int j2 = 0; j2 < 2; ++j2) {
        const int jr = jp * 2 + j2;
        union { bf16x8 v; unsigned u[4]; } pf;
        pf.u[0] = pack2(sc[jr][0][0] * inv, sc[jr][0][1] * inv); pf.u[1] = pack2(sc[jr][0][2] * inv, sc[jr][0][3] * inv);
        pf.u[2] = pack2(sc[jr][1][0] * inv, sc[jr][1][1] * inv); pf.u[3] = pack2(sc[jr][1][2] * inv, sc[jr][1][3] * inv);
#pragma unroll
        for (int dt = 0; dt < 4; ++dt) o[dt] = __builtin_amdgcn_mfma_f32_16x16x32_bf16(vf[j2][dt], pf.v, o[dt], 0, 0, 0);
      }
    }
#pragma unroll
    for (int dt = 0; dt < 4; ++dt) {
      uint2 ob; ob.x = pack2(o[dt][0], o[dt][1]); ob.y = pack2(o[dt][2], o[dt][3]);
      *(uint2*)(Q + (size_t)tokq * 1024 + h * 64 + dt * 16 + fq * 4) = ob;
    }
  }
}

__device__ __forceinline__ float2 cmul(float2 a, float2 b) { return make_float2(a.x * b.x - a.y * b.y, a.x * b.y + a.y * b.x); }
__device__ __forceinline__ float2 cadd(float2 a, float2 b) { return make_float2(a.x + b.x, a.y + b.y); }
__device__ __forceinline__ float2 csub(float2 a, float2 b) { return make_float2(a.x - b.x, a.y - b.y); }

template <bool DIF>
__device__ __forceinline__ void bfly(float2& a, float2& b, float2 w) {
  if (DIF) { const float2 s = cadd(a, b), d = csub(a, b); a = s; b = cmul(d, w); }
  else { const float2 t = cmul(b, w); const float2 s = cadd(a, t), d = csub(a, t); a = s; b = d; }
}
#define PH(i) ((i) ^ (((i) >> 4) & 7))
template <bool DIF>
__device__ __forceinline__ void fft_r8(float2* buf, const float2* __restrict__ T, int lq) {
  const int q = 1 << lq, sA = 1024 >> lq;
  for (int g = tid_fresh(); g < 1024; g += NT) {
    const int j0 = g & (q - 1), i0 = ((g >> lq) << (lq + 3)) + j0;
    float2 x[8];
#pragma unroll
    for (int p = 0; p < 8; ++p) x[p] = buf[PH(i0 + p * q)];
    if (DIF) {
#pragma unroll
      for (int p = 0; p < 4; ++p) bfly<true>(x[p], x[p + 4], T[j0 * sA + p * 1024]);
#pragma unroll
      for (int p = 0; p < 2; ++p) { const float2 w = T[j0 * 2 * sA + p * 2048]; bfly<true>(x[p], x[p + 2], w); bfly<true>(x[4 + p], x[6 + p], w); }
      { const float2 w = T[j0 * 4 * sA]; bfly<true>(x[0], x[1], w); bfly<true>(x[2], x[3], w); bfly<true>(x[4], x[5], w); bfly<true>(x[6], x[7], w); }
    } else {
      { const float2 w = T[j0 * 4 * sA]; bfly<false>(x[0], x[1], w); bfly<false>(x[2], x[3], w); bfly<false>(x[4], x[5], w); bfly<false>(x[6], x[7], w); }
#pragma unroll
      for (int p = 0; p < 2; ++p) { const float2 w = T[j0 * 2 * sA + p * 2048]; bfly<false>(x[p], x[p + 2], w); bfly<false>(x[4 + p], x[6 + p], w); }
#pragma unroll
      for (int p = 0; p < 4; ++p) bfly<false>(x[p], x[p + 4], T[j0 * sA + p * 1024]);
    }
#pragma unroll
    for (int p = 0; p < 8; ++p) buf[PH(i0 + p * q)] = x[p];
  }
  __syncthreads();
}
__device__ __forceinline__ void fft_r2(float2* buf) {
  for (int g = tid_fresh(); g < 4096; g += NT) {
    const int i0 = PH(2 * g), i1 = PH(2 * g + 1);
    const float2 a = buf[i0], b = buf[i1];
    buf[i0] = make_float2(a.x + b.x, a.y + b.y); buf[i1] = make_float2(a.x - b.x, a.y - b.y);
  }
  __syncthreads();
}
__device__ __forceinline__ void fft_dif(float2* buf, const float2* T) { fft_r8<true>(buf, T, 10); fft_r8<true>(buf, T, 7); fft_r8<true>(buf, T, 4); fft_r8<true>(buf, T, 1); fft_r2(buf); }
__device__ __forceinline__ void fft_dit(float2* buf, const float2* T) { fft_r2(buf); fft_r8<false>(buf, T, 1); fft_r8<false>(buf, T, 4); fft_r8<false>(buf, T, 7); fft_r8<false>(buf, T, 10); }
__device__ __forceinline__ int brev13(int k) { return (int)(__brev((unsigned)k) >> 19); }

__device__ __forceinline__ void hyena_feats(float* h3, unsigned char* smem) {
  KP PP = params_fresh();
  float* hin = (float*)smem;
  const int tid = tid_fresh(), r = tid >> 6, u = tid & 63;
  for (int it = blockIdx.x; it < 2048; it += gridDim.x) {
    const int j = it >> 10, l = (it & 1023) * 4 + r;
    const float* w0 = PP->in[I_HW0] + j * 33 * 64; const float* b0 = PP->in[I_HB0] + j * 64;
    const float* w1 = PP->in[I_HW1] + j * 4096; const float* b1 = PP->in[I_HB1] + j * 64;
    const float* w2 = PP->in[I_HW2] + j * 4096; const float* b2 = PP->in[I_HB2] + j * 64;
    const float fr = PP->in[I_HFREQ][j * 64 + u];
    __syncthreads();
    {
      const float tt = (float)l / 4095.f;
      const float ang = 6.283185307179586f * (float)l / 4096.f;
      float f = 0.f;
      if (u == 0) f = tt;
      else if (u <= 16) { const float band = 1e-4f + (float)(u - 1) * ((15.f - 1e-4f) / 15.f); f = cosf(band * ang); }
      else if (u <= 32) { const float band = 1e-4f + (float)(u - 17) * ((15.f - 1e-4f) / 15.f); f = -sinf(band * ang); }
      hin[r * 64 + u] = f;
    }
    __syncthreads();
    float a = b0[u];
    for (int k = 0; k < 33; ++k) a += hin[r * 64 + k] * w0[k * 64 + u];
    float v = sinf(fr * a);
    __syncthreads(); hin[r * 64 + u] = v; __syncthreads();
    a = b1[u];
    for (int k = 0; k < 64; ++k) a += hin[r * 64 + k] * w1[k * 64 + u];
    v = sinf(fr * a);
    __syncthreads(); hin[r * 64 + u] = v; __syncthreads();
    a = b2[u];
    for (int k = 0; k < 64; ++k) a += hin[r * 64 + k] * w2[k * 64 + u];
    v = sinf(fr * a);
    h3[((size_t)j * 4096 + l) * 64 + u] = v;
  }
}

__device__ __forceinline__ void filtgen_phase(const float* hwout, int j, const float* h3, float* kT, unsigned char* smem) {
  float* hs = (float*)smem;
  float* wsm = (float*)(smem + 32768);
  const int tid = tid_fresh(), tl = tid & 15, tc = tid >> 4;
  const float* wout = hwout + (size_t)j * 64 * 2048;
  const float mind = logf(0.01f) / 1.5f, maxd = logf(0.01f) / 0.3f;
  for (int it = blockIdx.x; it < 2048; it += gridDim.x) {
    const int l0 = (it & 63) * 64, c0 = (it >> 6) * 64;
    __syncthreads();
#pragma unroll
    for (int i = 0; i < 4; ++i) {
      const int id = tid + 256 * i, r = id >> 4, c4 = id & 15;
      const float4 hv = *(const float4*)(h3 + ((size_t)j * 4096 + l0 + r) * 64 + c4 * 4);
      float* d = hs + r * 65 + c4 * 4; d[0] = hv.x; d[1] = hv.y; d[2] = hv.z; d[3] = hv.w;
      *(float4*)(wsm + r * 64 + c4 * 4) = *(const float4*)(wout + (size_t)r * 2048 + c0 + c4 * 4);
    }
    __syncthreads();
    float acc[4][4];
#pragma unroll
    for (int i = 0; i < 4; ++i)
#pragma unroll
      for (int k = 0; k < 4; ++k) acc[i][k] = 0.f;
#pragma unroll 4
    for (int u = 0; u < 64; ++u) {
      const float4 w = *(const float4*)(wsm + u * 64 + tc * 4);
#pragma unroll
      for (int i = 0; i < 4; ++i) {
        const float hv = hs[(tl * 4 + i) * 65 + u];
        acc[i][0] += hv * w.x; acc[i][1] += hv * w.y; acc[i][2] += hv * w.z; acc[i][3] += hv * w.w;
      }
    }
#pragma unroll
    for (int k = 0; k < 4; ++k) {
      const int col = c0 + tc * 4 + k, c = col & 1023;
      const float dl = fabsf(mind + (float)c * ((maxd - mind) / 1023.f));
      float4 o;
      o.x = acc[0][k] * expf(-((float)(l0 + tl * 4 + 0) / 4095.f) * dl);
      o.y = acc[1][k] * expf(-((float)(l0 + tl * 4 + 1) / 4095.f) * dl);
      o.z = acc[2][k] * expf(-((float)(l0 + tl * 4 + 2) / 4095.f) * dl);
      o.w = acc[3][k] * expf(-((float)(l0 + tl * 4 + 3) / 4095.f) * dl);
      *(float4*)(kT + (size_t)col * 4096 + l0 + tl * 4) = o;
    }
  }
}

__device__ __forceinline__ void spectrum_phase(const float* kT, const float2* T, float4* spec, unsigned char* smem) {
  float2* buf = (float2*)smem;
  float* red = (float*)smem;
  const int tid = tid_fresh(), lane = tid & 63, wid = tid >> 6;
  for (int pi = blockIdx.x; pi < 512; pi += gridDim.x) {
    const int c1 = 2 * pi;
    const float* f0 = kT + (size_t)c1 * 4096;
    const float* b0 = kT + (size_t)(1024 + c1) * 4096;
    __syncthreads();
    float s1 = 0.f, s2 = 0.f;
#pragma unroll 4
    for (int i = 0; i < 16; ++i) {
      const int l = tid + 256 * i;
      const float a00 = f0[l], a01 = f0[4096 + l], a10 = b0[l], a11 = b0[4096 + l];
      s1 += a00 * a00; s2 += a01 * a01;
      if (l != 0) { s1 += a10 * a10; s2 += a11 * a11; }
    }
#pragma unroll
    for (int o = 32; o > 0; o >>= 1) { s1 += __shfl_xor(s1, o); s2 += __shfl_xor(s2, o); }
    if (lane == 0) { red[wid * 2] = s1; red[wid * 2 + 1] = s2; }
    __syncthreads();
    s1 = red[0] + red[2] + red[4] + red[6]; s2 = red[1] + red[3] + red[5] + red[7];
    __syncthreads();
#pragma unroll 4
    for (int i = 0; i < 16; ++i) {
      const int l = tid + 256 * i;
      const float a00 = f0[l], a01 = f0[4096 + l], a10 = b0[l], a11 = b0[4096 + l];
      buf[PH(l)] = make_float2(a00, a01);
      if (l == 0) buf[PH(4096)] = make_float2(0.f, 0.f);
      else buf[PH(8192 - l)] = make_float2(a10, a11);
    }
    __syncthreads();
    const float sc1 = rsqrtf(s1 + 1e-6f) * (1.f / 8192.f);
    const float sc2 = rsqrtf(s2 + 1e-6f) * (1.f / 8192.f);
    fft_dif(buf, T);
    for (int k = tid; k <= 4096; k += NT) {
      const int pk_ = brev13(k), pn_ = brev13((8192 - k) & 8191);
      const float2 Pk = buf[PH(pk_)], Fn = buf[PH(pn_)];
      const float2 Qc = make_float2(Fn.x, -Fn.y);
      const float2 H1 = make_float2(0.5f * (Pk.x + Qc.x) * sc1, 0.5f * (Pk.y + Qc.y) * sc1);
      const float2 H2 = make_float2(0.5f * (Pk.y - Qc.y) * sc2, -0.5f * (Pk.x - Qc.x) * sc2);
      spec[(size_t)pi * SPEC_STRIDE + k] = make_float4(0.5f * (H1.x + H2.x), 0.5f * (H1.y + H2.y), 0.5f * (H1.x - H2.x), 0.5f * (H1.y - H2.y));
    }
  }
}

__device__ __forceinline__ void z_phase(const bf16_t* X1, const bf16_t* V, const float* cw  , const float* cb  , float* zT, unsigned char* smem) {
  float* zs = (float*)smem;
  const int tid = tid_fresh(), c8 = tid & 7, tr = tid >> 3;
  for (int it = blockIdx.x; it < 8192; it += gridDim.x) {
    const int ct = it & 15, tt = it >> 4, c0 = ct * 64, t0 = tt * 64;
    __syncthreads();
    const int c = c0 + c8 * 8;
    float w1[3][8], w2[3][8], bb1[8], bb2[8];
#pragma unroll
    for (int e = 0; e < 8; ++e) {
#pragma unroll
      for (int k = 0; k < 3; ++k) { w1[k][e] = cw[k * 3072 + 1024 + c + e]; w2[k][e] = cw[k * 3072 + 2048 + c + e]; }
      bb1[e] = cb[1024 + c + e]; bb2[e] = cb[2048 + c + e];
    }
#pragma unroll
    for (int i = 0; i < 2; ++i) {
      const int tl = tr + 32 * i, t = t0 + tl, tb = t & (SEQ - 1);
      float a1[8], a2[8];
#pragma unroll
      for (int e = 0; e < 8; ++e) { a1[e] = bb1[e]; a2[e] = bb2[e]; }
#pragma unroll
      for (int k = 0; k < 3; ++k) {
        const int tbk = tb + k - 1;
        if (tbk >= 0 && tbk < SEQ) {
          float f[8], g[8];
          unpack8(*(const uint4*)(X1 + (size_t)(t + k - 1) * 1024 + c), f);
          unpack8(*(const uint4*)(V + (size_t)(t + k - 1) * 1024 + c), g);
#pragma unroll
          for (int e = 0; e < 8; ++e) { a1[e] += w1[k][e] * f[e]; a2[e] += w2[k][e] * g[e]; }
        }
      }
#pragma unroll
      for (int e = 0; e < 8; ++e) zs[(c8 * 8 + e) * 65 + tl] = a1[e] * a2[e];
    }
    __syncthreads();
    {
      const int cl = tid >> 2, tq = tid & 3;
      const int bidx = t0 >> 12, tbase = t0 & (SEQ - 1);
      float* dst = zT + ((size_t)(bidx * 1024 + c0 + cl)) * SEQ + tbase + tq * 16;
#pragma unroll
      for (int v4 = 0; v4 < 4; ++v4) {
        const float* s = zs + cl * 65 + tq * 16 + v4 * 4;
        *(float4*)(dst + v4 * 4) = make_float4(s[0], s[1], s[2], s[3]);
      }
    }
  }
}

__device__ __forceinline__ void fftconv_phase(float* zT, const float4* spec, const float2* T, const float* hd, unsigned char* smem) {
  float2* buf = (float2*)smem;
  const int tid = tid_fresh();
  for (int it = blockIdx.x; it < 4096; it += gridDim.x) {
    const int b = (it >> 3) & 7, pi = (it & 7) + 8 * (it >> 6), c1 = 2 * pi;
    float* z1 = zT + ((size_t)(b * 1024 + c1)) * SEQ;
    float* z2 = z1 + SEQ;
    __syncthreads();
    for (int t = tid; t < 4096; t += NT) { buf[PH(t)] = make_float2(z1[t], z2[t]); buf[PH(4096 + t)] = make_float2(0.f, 0.f); }
    __syncthreads();
    fft_dif(buf, T);
    const float4* sp = spec + (size_t)pi * SPEC_STRIDE;
    for (int k = tid; k <= 4096; k += NT) {
      const int pk0 = brev13(k), pn0 = brev13((8192 - k) & 8191);
      const int pk = PH(pk0), pn = PH(pn0);
      const float2 Xk = buf[pk], Xn = buf[pn];
      const float4 sd = sp[k];
      const float2 S = make_float2(sd.x, sd.y), D = make_float2(sd.z, sd.w);
      const float2 Wk = cadd(cmul(Xk, S), cmul(make_float2(Xn.x, -Xn.y), D));
      const float2 Wn = cadd(cmul(Xn, make_float2(S.x, -S.y)), cmul(make_float2(Xk.x, -Xk.y), make_float2(D.x, -D.y)));
      buf[pk] = make_float2(Wk.x, -Wk.y);
      buf[pn] = make_float2(Wn.x, -Wn.y);
    }
    __syncthreads();
    fft_dit(buf, T);
    const float d1 = hd[c1], d2 = hd[c1 + 1];
    for (int t = tid; t < 4096; t += NT) {
      const float2 y = buf[PH(t)];
      z1[t] = y.x + d1 * z1[t];
      z2[t] = -y.y + d2 * z2[t];
    }
  }
}

__device__ __forceinline__ void ya_phase(const bf16_t* X0, const float* yT, const float* cw, const float* cb, bf16_t* MA, unsigned char* smem) {
  float* ys = (float*)smem;
  const int tid = tid_fresh(), c8 = tid & 7, tr = tid >> 3;
  for (int it = blockIdx.x; it < 8192; it += gridDim.x) {
    const int ct = it & 15, tt = it >> 4, c0 = ct * 64, t0 = tt * 64;
    __syncthreads();
    {
      const int cl = tid >> 2, tq = tid & 3;
      const int bidx = t0 >> 12, tbase = t0 & (SEQ - 1);
      const float* src = yT + ((size_t)(bidx * 1024 + c0 + cl)) * SEQ + tbase + tq * 16;
#pragma unroll
      for (int v4 = 0; v4 < 4; ++v4) {
        const float4 v = *(const float4*)(src + v4 * 4);
        float* s = ys + cl * 65 + tq * 16 + v4 * 4;
        s[0] = v.x; s[1] = v.y; s[2] = v.z; s[3] = v.w;
      }
    }
    __syncthreads();
    const int c = c0 + c8 * 8;
    float w0[3][8], bb[8];
#pragma unroll
    for (int e = 0; e < 8; ++e) {
#pragma unroll
      for (int k = 0; k < 3; ++k) w0[k][e] = cw[k * 3072 + c + e];
      bb[e] = cb[c + e];
    }
#pragma unroll
    for (int i = 0; i < 2; ++i) {
      const int tl = tr + 32 * i, t = t0 + tl, tb = t & (SEQ - 1);
      float a[8];
#pragma unroll
      for (int e = 0; e < 8; ++e) a[e] = bb[e];
#pragma unroll
      for (int k = 0; k < 3; ++k) {
        const int tbk = tb + k - 1;
        if (tbk >= 0 && tbk < SEQ) {
          float f[8];
          unpack8(*(const uint4*)(X0 + (size_t)(t + k - 1) * 1024 + c), f);
#pragma unroll
          for (int e = 0; e < 8; ++e) a[e] += w0[k][e] * f[e];
        }
      }
#pragma unroll
      for (int e = 0; e < 8; ++e) a[e] *= ys[(c8 * 8 + e) * 65 + tl];
      *(uint4*)(MA + (size_t)t * 1024 + c) = make_uint4(pack2(a[0], a[1]), pack2(a[2], a[3]), pack2(a[4], a[5]), pack2(a[6], a[7]));
    }
  }
}

__device__ __forceinline__ void convT_job(const float* src, int K, int N, bf16_t* dst, const float* scale, unsigned char* smem) {
  float* ts = (float*)smem;
  const int tid = tid_fresh();
  const int tn = N >> 6, ntile = (K >> 6) * tn;
  for (int it = blockIdx.x; it < ntile; it += gridDim.x) {
    const int k0 = (it / tn) * 64, n0 = (it % tn) * 64;
    __syncthreads();
#pragma unroll
    for (int i = 0; i < 4; ++i) {
      const int r = (tid >> 4) + 16 * i, c4 = tid & 15;
      float4 v = *(const float4*)(src + (size_t)(k0 + r) * N + n0 + c4 * 4);
      const float s = scale ? scale[k0 + r] : 1.f;
      float* d = ts + r * 65 + c4 * 4;
      d[0] = v.x * s; d[1] = v.y * s; d[2] = v.z * s; d[3] = v.w * s;
    }
    __syncthreads();
#pragma unroll
    for (int i = 0; i < 2; ++i) {
      const int id = tid + 256 * i, nn = id >> 3, kc = id & 7;
      float f[8];
#pragma unroll
      for (int e = 0; e < 8; ++e) f[e] = ts[(kc * 8 + e) * 65 + nn];
      *(uint4*)(dst + (size_t)(n0 + nn) * K + k0 + kc * 8) = make_uint4(pack2(f[0], f[1]), pack2(f[2], f[3]), pack2(f[4], f[5]), pack2(f[6], f[7]));
    }
  }
}
__device__ __forceinline__ void conv_plain(const float* src, bf16_t* dst, size_t n) {
  const size_t stride = (size_t)gridDim.x * NT * 8;
  for (size_t i = ((size_t)blockIdx.x * NT + tid_fresh()) * 8; i < n; i += stride) {
    const float4 a = *(const float4*)(src + i), b = *(const float4*)(src + i + 4);
    *(uint4*)(dst + i) = make_uint4(pack2(a.x, a.y), pack2(a.z, a.w), pack2(b.x, b.y), pack2(b.z, b.w));
  }
}

__device__ __forceinline__ void final_norm(float* h, const float* g) {
  const int tid = tid_fresh(), wave = tid >> 6, lane = tid & 63;
  for (int row = blockIdx.x * 4 + wave; row < TOK; row += gridDim.x * 4) {
    float* p = h + (size_t)row * 1024;
    float4 v[4]; float s = 0.f;
#pragma unroll
    for (int i = 0; i < 4; ++i) { v[i] = *(const float4*)(p + i * 256 + lane * 4); s += v[i].x * v[i].x + v[i].y * v[i].y + v[i].z * v[i].z + v[i].w * v[i].w; }
#pragma unroll
    for (int o = 32; o > 0; o >>= 1) s += __shfl_xor(s, o);
    const float r = rsqrtf(s * (1.f / 1024.f) + 1e-6f);
#pragma unroll
    for (int i = 0; i < 4; ++i) {
      const float4 gg = *(const float4*)(g + i * 256 + lane * 4);
      *(float4*)(p + i * 256 + lane * 4) = make_float4(v[i].x * r * gg.x, v[i].y * r * gg.y, v[i].z * r * gg.z, v[i].w * r * gg.w);
    }
  }
}


#define XB_TMO      128
#define XB_XCNT(j)  (256  + 64 * (j))
#define XB_XSUB(j)  (1280 + 64 * (j))
#define XB_XGEN(j)  (2304 + 64 * (j))
#define XB_TOP      3328
#define XB_TOPGEN   3392
#define XCD_BAR_WORDS 3456
#define XB_SPIN_CAP (1u << 18)
__device__ __forceinline__ unsigned xb_ld(unsigned* p)              { return __hip_atomic_load(p, __ATOMIC_RELAXED, __HIP_MEMORY_SCOPE_AGENT); }
__device__ __forceinline__ unsigned xb_add(unsigned* p, unsigned v) { return __hip_atomic_fetch_add(p, v, __ATOMIC_RELAXED, __HIP_MEMORY_SCOPE_AGENT); }
__device__ __forceinline__ unsigned xb_xcc_id() { unsigned v; asm volatile("s_getreg_b32 %0, hwreg(HW_REG_XCC_ID, 0, 4)" : "=s"(v)); return v & 0xFu; }
#define XB_SPIN(cond, bar) do { unsigned _sp = 0; while (cond) { __builtin_amdgcn_s_sleep(1); \
    if ((++_sp & 255u) == 0u) { if (xb_ld(&(bar)[XB_TMO])) break; if (_sp > XB_SPIN_CAP) { atomicAdd(&(bar)[XB_TMO], 1u); break; } } } } while (0)
__device__ __forceinline__ void xcd_barrier(unsigned* bar) {
  asm volatile("s_waitcnt vmcnt(0) lgkmcnt(0)" ::: "memory");
  __syncthreads();
  if (tid_fresh() == 0) {
    __builtin_amdgcn_s_waitcnt(0);
    const unsigned x = xb_xcc_id();
    int bi = blockIdx.x; asm volatile("" : "+s"(bi));
    const uint2 census = *(const uint2*)(bar + XCD_BAR_WORDS + 2 * bi);
    const unsigned nloc = census.x, nx = census.y;
    const unsigned old = xb_add(&bar[XB_XSUB(x)], 1u);
    const unsigned gen = old / nloc;
    if (old + 1u == (gen + 1u) * nloc) {
      __builtin_amdgcn_fence(__ATOMIC_RELEASE, "agent");
      asm volatile("s_waitcnt vmcnt(0)" ::: "memory");
      const unsigned og = xb_add(&bar[XB_TOP], 1u);
      const unsigned tg = og / nx;
      if (og + 1u == (tg + 1u) * nx) xb_add(&bar[XB_TOPGEN], 1u);
      else XB_SPIN(xb_ld(&bar[XB_TOPGEN]) == tg, bar);
      __builtin_amdgcn_fence(__ATOMIC_ACQUIRE, "agent");
      xb_add(&bar[XB_XGEN(x)], 1u);
      asm volatile("s_waitcnt vmcnt(0)" ::: "memory");
    } else {
      XB_SPIN(xb_ld(&bar[XB_XGEN(x)]) == gen, bar);
      __builtin_amdgcn_fence(__ATOMIC_ACQUIRE, "agent");
      asm volatile("s_waitcnt vmcnt(0)" ::: "memory");
    }
  }
  __syncthreads();
}

#define GSYNC() do { asm volatile("s_waitcnt vmcnt(0) lgkmcnt(0)" ::: "memory"); grid.sync(); \
    if (tid_fresh() < 64) { __builtin_amdgcn_fence(__ATOMIC_ACQUIRE, "agent"); asm volatile("s_waitcnt vmcnt(0)" ::: "memory"); } \
    __syncthreads(); } while (0)
#define XSYNC() xcd_barrier((unsigned*)WSP(BAR_OFF))
#define WSP(off) (params_fresh()->ws + (off))
#define INP(i) (params_fresh()->in[i])
#define WBP ((bf16_t*)WSP(WB_OFF))
#define HBA ((bf16_t*)WSP(HBA_OFF))
#define SPECP ((float4*)WSP(SPEC_OFF))
#define H3P ((float*)WSP(H3_OFF))
#define TWP ((float2*)WSP(TW_OFF))
#define SLOT(i) ((bf16_t*)WSP(R_OFF + (size_t)(i) * 64 * MiB))
#define HRES (params_fresh()->out)

__global__ void __launch_bounds__(NT, 2) mega(Params Pdummy) {
  __shared__ __attribute__((aligned(16))) unsigned char smem[65536];
  cg::grid_group grid = cg::this_grid();
  if (tid_fresh() == 0) (void)xb_add(&((unsigned*)WSP(BAR_OFF))[XB_XCNT(xb_xcc_id())], 1u);

  for (int j = 0; j < 2; ++j) {
    convT_job(INP(I_EWIN) + (size_t)j * 1024 * 7168, 1024, 7168, WBP + W_EIN + (size_t)j * 7340032, INP(I_NORMG) + (2 * j) * 1024, smem);
    convT_job(INP(I_OWIN) + (size_t)j * 1024 * 6144, 1024, 6144, WBP + W_OIN + (size_t)j * 6291456, INP(I_NORMG) + (2 * j + 1) * 1024, smem);
    convT_job(INP(I_EWOUT) + (size_t)j * 2048 * 1024, 2048, 1024, WBP + W_EOUT + (size_t)j * 2097152, nullptr, smem);
    convT_job(INP(I_OWOUT) + (size_t)j * 2048 * 1024, 2048, 1024, WBP + W_OOUT + (size_t)j * 2097152, nullptr, smem);
    for (int g = 0; g < 4; ++g)
      convT_job(INP(I_POOLW) + (size_t)(j * 4 + g) * 65536, 256, 256, WBP + W_POOL + (size_t)(j * 4 + g) * 65536, nullptr, smem);
  }
  for (int i = 0; i < 4; ++i) {
    convT_job(INP(I_PGATE) + (size_t)i * 1048576, 1024, 1024, WBP + W_PGATE + (size_t)i * 1048576, INP(I_PLEG) + i * 1024, smem);
    convT_job(INP(I_PUP) + (size_t)i * 262144, 256, 1024, WBP + W_PUP + (size_t)i * 262144, nullptr, smem);
  }
  conv_plain(INP(I_GMWS), WBP + W_GMWS, 262144);
  conv_plain(INP(I_X), HBA, (size_t)TOK * 1024);
  hyena_feats(H3P, smem);
  {
    float2* T = TWP;
    for (int k = blockIdx.x * NT + tid_fresh(); k < 4096; k += gridDim.x * NT) {
      float s, c; sincospif((float)k / 4096.f, &s, &c);
      T[k] = make_float2(c, -s);
    }
  }
  GSYNC();
  if (tid_fresh() == 0) {
    unsigned* bar = (unsigned*)WSP(BAR_OFF);
    const unsigned x = xb_xcc_id();
    unsigned nloc = 0u, nx = 0u;
#pragma unroll
    for (unsigned jx = 0; jx < 16; ++jx) { const unsigned c = xb_ld(&bar[XB_XCNT(jx)]); nx += (c > 0u) ? 1u : 0u; nloc = (jx == x) ? c : nloc; }
    bar[XCD_BAR_WORDS + 2 * blockIdx.x] = nloc > 0u ? nloc : 1u;
    bar[XCD_BAR_WORDS + 2 * blockIdx.x + 1] = nx > 0u ? nx : 1u;
  }
  filtgen_phase(INP(I_HWOUT), 0, H3P, (float*)SLOT(3), smem);
  XSYNC();

#pragma unroll 1
  for (int layer = 0; layer < 4; ++layer) {
    const int j = layer >> 1;
    if ((layer & 1) == 0) {
      spectrum_phase((const float*)SLOT(3), TWP, SPECP, smem);
      inproj_phase(HBA, WBP + W_EIN + (size_t)j * 7340032, 3, 0, 1024, 2048, 0, SLOT(0), SLOT(1), SLOT(2), nullptr, 0, 0, 0, 0, smem);
      XSYNC();
      z_phase(SLOT(1), SLOT(2), INP(I_CONVW) + (size_t)j * 9216, INP(I_CONVB) + (size_t)j * 3072, (float*)SLOT(3), smem);
      XSYNC();
      fftconv_phase((float*)SLOT(3), SPECP, TWP, INP(I_HD) + j * 1024, smem);
      XSYNC();
      ya_phase(SLOT(0), (const float*)SLOT(3), INP(I_CONVW) + (size_t)j * 9216, INP(I_CONVB) + (size_t)j * 3072, SLOT(1), smem);
      XSYNC();
      inproj_phase(HBA, WBP + W_EIN + (size_t)j * 7340032, 2, 4096, 5120, 0, 0, SLOT(0), SLOT(2), nullptr, nullptr, 0, 3, 0, 0, smem, (float*)WSP(PART_OFF));
      XSYNC();
      gmlp_phase(SLOT(0), SLOT(2), WBP + W_GMWS + (size_t)j * 131072, INP(I_GMG) + j * 1024, INP(I_GMBS) + j * 1024, (const float*)WSP(PART_OFF), smem);
      XSYNC();
      inproj_phase(HBA, WBP + W_EIN + (size_t)j * 7340032, 2, 3072, 6144, 0, 0, SLOT(1), SLOT(0), nullptr, nullptr, 2, 2, 0, 0, smem);
      XSYNC();
      outproj_phase(SLOT(1), SLOT(0), WBP + W_EOUT + (size_t)j * 2097152, (layer == 0) ? INP(I_X) : (const float*)HRES, HRES, SLOT(3), smem);
      XSYNC();
      ple_phase(SLOT(3), INP(I_P) + (size_t)layer * TOK * 256, WBP + W_PGATE + (size_t)layer * 1048576, WBP + W_PUP + (size_t)layer * 262144, HRES, HBA, smem);
      XSYNC();
    } else {
      inproj_phase(HBA, WBP + W_OIN + (size_t)j * 6291456, 4, 0, 2048, 3072, 4096, SLOT(0), SLOT(1), SLOT(2), SLOT(3), 0, 0, 0, 1, smem);
      XSYNC();
      pool_phase(SLOT(0), WBP + W_POOL + (size_t)j * 262144, INP(I_POOLB) + j * 1024, INP(I_POOLS) + j * 1024, SLOT(4), smem);
      na_phase(SLOT(1), SLOT(2), SLOT(3), INP(I_RPB) + (size_t)j * 16 * 15 * 31);
      XSYNC();
      inproj_phase(HBA, WBP + W_OIN + (size_t)j * 6291456, 2, 1024, 5120, 0, 0, SLOT(4), SLOT(1), nullptr, nullptr, 2, 2, 0, 0, smem);
      XSYNC();
      outproj_phase(SLOT(4), SLOT(1), WBP + W_OOUT + (size_t)j * 2097152, HRES, HRES, SLOT(2), smem);
      XSYNC();
      ple_phase(SLOT(2), INP(I_P) + (size_t)layer * TOK * 256, WBP + W_PGATE + (size_t)layer * 1048576, WBP + W_PUP + (size_t)layer * 262144, HRES, HBA, smem);
      if (layer == 1) filtgen_phase(INP(I_HWOUT), 1, H3P, (float*)SLOT(3), smem);
      XSYNC();
    }
  }
  final_norm(HRES, INP(I_FINALG));
}

extern "C" void kernel_launch(void* const* d_in, const int* in_sizes, int n_in, void* d_out, int out_size, void* d_ws, size_t ws_size, hipStream_t stream) {
  static int grid_blocks = 0;
  if (grid_blocks == 0) {
    if (n_in != 29 || out_size != TOK * 1024 || ws_size < WS_END) { fprintf(stderr, "kernel_launch: unexpected shapes (n_in %d out %d ws %zu)\n", n_in, out_size, ws_size); grid_blocks = -1; return; }
    int dev = 0, cus = 0, per_cu = 0;
    if (hipGetDevice(&dev) != hipSuccess || hipDeviceGetAttribute(&cus, hipDeviceAttributeMultiprocessorCount, dev) != hipSuccess) { grid_blocks = -1; return; }
    if (hipOccupancyMaxActiveBlocksPerMultiprocessor(&per_cu, (const void*)mega, NT, LDS_BYTES) != hipSuccess || per_cu < 1) { fprintf(stderr, "occupancy query failed\n"); per_cu = 1; }
    if (per_cu > 2) per_cu = 2;
    grid_blocks = cus * per_cu;
  }
  if (grid_blocks < 0) return;
  Params p{};
  for (int i = 0; i < 29; ++i) p.in[i] = (const float*)d_in[i];
  p.out = (float*)d_out; p.ws = (unsigned char*)d_ws;
  if (hipMemsetAsync((unsigned char*)d_ws + BAR_OFF, 0, XCD_BAR_WORDS * sizeof(unsigned), stream) != hipSuccess) { fprintf(stderr, "memset of barrier words failed\n"); return; }
  void* args[] = {&p};
  hipError_t e = hipLaunchCooperativeKernel((const void*)mega, dim3(grid_blocks), dim3(NT), args, LDS_BYTES, stream);
  if (e != hipSuccess) fprintf(stderr, "cooperative launch failed: %s (grid %d)\n", hipGetErrorString(e), grid_blocks);
}
```

```cpp
#include <hip/hip_runtime.h>
#include <hip/hip_cooperative_groups.h>
#include <cstdio>
namespace cg = cooperative_groups;

typedef unsigned short bf16_t;
typedef short bf16x8 __attribute__((ext_vector_type(8)));
typedef short bf16x4 __attribute__((ext_vector_type(4)));
typedef float f32x4 __attribute__((ext_vector_type(4)));

#define NT 256
constexpr int LDS_BYTES = 0;
constexpr size_t MiB = 1u << 20;
constexpr size_t WB_OFF = 0, HBA_OFF = 80 * MiB, SPEC_OFF = 144 * MiB, H3_OFF = 177 * MiB, TW_OFF = 179 * MiB, R_OFF = 180 * MiB, PART_OFF = 500 * MiB, BAR_OFF = 502 * MiB, WS_END = 503 * MiB;
constexpr int TOK = 32768, SEQ = 4096, DM = 1024;
constexpr size_t W_EIN = 0, W_OIN = 14680064, W_EOUT = 27262976, W_OOUT = 31457280, W_PGATE = 35651584, W_PUP = 39845888, W_POOL = 40894464, W_GMWS = 41418752;
constexpr int SPEC_STRIDE = 4104;

struct Params { const float* in[29]; float* out; unsigned char* ws; };
enum { I_X = 0, I_P, I_NORMG, I_FINALG, I_EWIN, I_CONVW, I_CONVB, I_HW0, I_HB0, I_HW1, I_HB1, I_HW2, I_HB2, I_HWOUT, I_HFREQ, I_HD, I_GMG, I_GMWS, I_GMBS, I_EWOUT, I_OWIN, I_POOLW, I_POOLB, I_POOLS, I_RPB, I_OWOUT, I_PUP, I_PGATE, I_PLEG };

__device__ __forceinline__ unsigned short f2bf(float f) { unsigned u = __float_as_uint(f); u += 0x7fffu + ((u >> 16) & 1u); return (unsigned short)(u >> 16); }
__device__ __forceinline__ float bf2f(unsigned short h) { return __uint_as_float(((unsigned)h) << 16); }
__device__ __forceinline__ unsigned pack2(float lo, float hi) { return (unsigned)f2bf(lo) | ((unsigned)f2bf(hi) << 16); }
__device__ __forceinline__ float lo_f(unsigned u) { return __uint_as_float(u << 16); }
__device__ __forceinline__ float hi_f(unsigned u) { return __uint_as_float(u & 0xffff0000u); }
__device__ __forceinline__ float silu_f(float v) { return v / (1.f + __expf(-v)); }
__device__ __forceinline__ float sigmoid_f(float v) { return 1.f / (1.f + __expf(-v)); }
__device__ __forceinline__ void unpack8(const uint4& u, float* f) { f[0] = lo_f(u.x); f[1] = hi_f(u.x); f[2] = lo_f(u.y); f[3] = hi_f(u.y); f[4] = lo_f(u.z); f[5] = hi_f(u.z); f[6] = lo_f(u.w); f[7] = hi_f(u.w); }

typedef const Params __attribute__((address_space(4)))* KP;
__device__ __forceinline__ KP params_fresh() { KP p = (KP)__builtin_amdgcn_kernarg_segment_ptr(); asm volatile("" : "+s"(p)); return p; }
__device__ __forceinline__ int tid_fresh() { int t = threadIdx.x; asm volatile("" : "+v"(t)); return t; }

__device__ __forceinline__ int swz(int row, int kc) { return row * 128 + ((kc ^ ((row >> 1) & 7)) << 4); }

template <int AM, bool SS>
__device__ __forceinline__ void load_a1(int tid, uint4& out, float& ssq, const void* A0, const void* A1, int lda, int row, int k0, int aux) {
  const int kc = tid & 7;
  if (AM == 0) {
    out = *(const uint4*)((const bf16_t*)A0 + (size_t)row * lda + k0 + kc * 8);
  } else if (AM == 2) {
    const bf16_t* src = (k0 < 1024) ? (const bf16_t*)A0 : (const bf16_t*)A1;
    out = *(const uint4*)(src + (size_t)row * lda + (k0 & 1023) + kc * 8);
  } else if (AM == 1) {
    const float* src = (const float*)A0 + (size_t)row * lda + k0 + kc * 8;
    const float4 a = *(const float4*)src, b = *(const float4*)(src + 4);
    out = make_uint4(pack2(a.x, a.y), pack2(a.z, a.w), pack2(b.x, b.y), pack2(b.z, b.w));
  } else {
    const bf16_t* src = (const bf16_t*)A0 + k0 + kc * 8;
    const int half = 1 << aux;
    const int tb = row & (SEQ - 1), base = row - tb;
    const int lo = max(tb - half, 0), hi = min(tb + half, SEQ);
    float s0 = 0.f, s1 = 0.f, s2 = 0.f, s3 = 0.f, s4 = 0.f, s5 = 0.f, s6 = 0.f, s7 = 0.f;
    const int cnt = hi - lo;
    const bf16_t* wp = src + (size_t)(base + lo) * lda;
#pragma unroll 1
    for (int d0 = 0; d0 < cnt; d0 += 8) {
      uint4 wv[8];
#pragma unroll
      for (int d = 0; d < 8; ++d) wv[d] = (d0 + d < cnt) ? *(const uint4*)(wp + (size_t)(d0 + d) * lda) : make_uint4(0u, 0u, 0u, 0u);
#pragma unroll
      for (int d = 0; d < 8; ++d) {
        s0 += lo_f(wv[d].x); s1 += hi_f(wv[d].x); s2 += lo_f(wv[d].y); s3 += hi_f(wv[d].y); s4 += lo_f(wv[d].z); s5 += hi_f(wv[d].z); s6 += lo_f(wv[d].w); s7 += hi_f(wv[d].w);
      }
    }
    const uint4 u = *(const uint4*)(src + (size_t)row * lda);
    const float inv = 1.f / (float)(hi - lo);
    out = make_uint4(pack2(s0 * inv - lo_f(u.x), s1 * inv - hi_f(u.x)), pack2(s2 * inv - lo_f(u.y), s3 * inv - hi_f(u.y)),
                     pack2(s4 * inv - lo_f(u.z), s5 * inv - hi_f(u.z)), pack2(s6 * inv - lo_f(u.w), s7 * inv - hi_f(u.w)));
  }
}
template <int AM, bool SS>
__device__ __forceinline__ void load_a(int tid, uint4& a0, uint4& a1, uint4& a2, uint4& a3, const void* A0, const void* A1, int lda, int m0, int k0, int aux, float (&ss)[4]) {
  const int row = m0 + (tid >> 3);
  load_a1<AM, SS>(tid, a0, ss[0], A0, A1, lda, row, k0, aux);
  load_a1<AM, SS>(tid, a1, ss[1], A0, A1, lda, row + 32, k0, aux);
  load_a1<AM, SS>(tid, a2, ss[2], A0, A1, lda, row + 64, k0, aux);
  load_a1<AM, SS>(tid, a3, ss[3], A0, A1, lda, row + 96, k0, aux);
}
__device__ __forceinline__ void load_b(int tid, uint4& b0, uint4& b1, uint4& b2, uint4& b3, const bf16_t* Bt, int ldb, int n0, int k0) {
  const bf16_t* p = Bt + (size_t)(n0 + (tid >> 3)) * ldb + k0 + (tid & 7) * 8;
  b0 = *(const uint4*)p; b1 = *(const uint4*)(p + (size_t)32 * ldb); b2 = *(const uint4*)(p + (size_t)64 * ldb); b3 = *(const uint4*)(p + (size_t)96 * ldb);
}
__device__ __forceinline__ void store_tile(int tid, unsigned char* dst, const uint4& r0v, const uint4& r1v, const uint4& r2v, const uint4& r3v) {
  const int r0 = tid >> 3, kc = tid & 7;
  *(uint4*)(dst + swz(r0, kc)) = r0v; *(uint4*)(dst + swz(r0 + 32, kc)) = r1v; *(uint4*)(dst + swz(r0 + 64, kc)) = r2v; *(uint4*)(dst + swz(r0 + 96, kc)) = r3v;
}

__device__ __forceinline__ float ssq8(const uint4& v) {
  const float f0 = lo_f(v.x), f1 = hi_f(v.x), f2 = lo_f(v.y), f3 = hi_f(v.y), f4 = lo_f(v.z), f5 = hi_f(v.z), f6 = lo_f(v.w), f7 = hi_f(v.w);
  return f0 * f0 + f1 * f1 + f2 * f2 + f3 * f3 + f4 * f4 + f5 * f5 + f6 * f6 + f7 * f7;
}
template <bool SS>
__device__ __forceinline__ void store_a(int tid, unsigned char* dst, const uint4& a0, const uint4& a1, const uint4& a2, const uint4& a3, float (&ss)[4]) {
  if (SS) { ss[0] += ssq8(a0); ss[1] += ssq8(a1); ss[2] += ssq8(a2); ss[3] += ssq8(a3); }
  store_tile(tid, dst, a0, a1, a2, a3);
}
template <bool SWAP>
__device__ __forceinline__ void mma_tile(f32x4 (&acc)[4][4], const unsigned char* cur, int wr, int wc, int fr, int fq) {
#pragma unroll
  for (int s = 0; s < 2; ++s) {
    bf16x8 af[4], bfr[4];
#pragma unroll
    for (int m = 0; m < 4; ++m) af[m] = *(const bf16x8*)(cur + swz(wr * 64 + m * 16 + fr, s * 4 + fq));
#pragma unroll
    for (int n = 0; n < 4; ++n) bfr[n] = *(const bf16x8*)(cur + 16384 + swz(wc * 64 + n * 16 + fr, s * 4 + fq));
#pragma unroll
    for (int m = 0; m < 4; ++m)
#pragma unroll
      for (int n = 0; n < 4; ++n)
        acc[m][n] = SWAP ? __builtin_amdgcn_mfma_f32_16x16x32_bf16(bfr[n], af[m], acc[m][n], 0, 0, 0)
                         : __builtin_amdgcn_mfma_f32_16x16x32_bf16(af[m], bfr[n], acc[m][n], 0, 0, 0);
  }
}
template <int AM, bool SS, bool SWAP>
__device__ __forceinline__ void gemm_mainloop(f32x4 (&acc)[4][4], const void* A0, const void* A1, int lda, const bf16_t* Bt, int ldb,
                                              int m0, int n0, int K, int aux, unsigned char* smem, float (&ss)[4], int rot) {
  const int tid = tid_fresh(), wid = tid >> 6, lane = tid & 63, wr = wid >> 1, wc = wid & 1, fr = lane & 15, fq = lane >> 4;
  const int nk = K >> 6, km = nk - 1;
  unsigned char* L0 = smem;
  unsigned char* L1 = smem + 32768;
  uint4 a0, a1, a2, a3, b0, b1, b2, b3;
  __syncthreads();
  if (AM == 0 || AM == 2) {
    uint4 c0, c1, c2, c3, d0, d1, d2, d3;
    load_a<AM, SS>(tid, a0, a1, a2, a3, A0, A1, lda, m0, (rot & km) << 6, aux, ss);
    load_b(tid, b0, b1, b2, b3, Bt, ldb, n0, (rot & km) << 6);
    load_a<AM, SS>(tid, c0, c1, c2, c3, A0, A1, lda, m0, ((1 + rot) & km) << 6, aux, ss);
    load_b(tid, d0, d1, d2, d3, Bt, ldb, n0, ((1 + rot) & km) << 6);
    store_a<SS>(tid, L0, a0, a1, a2, a3, ss); store_tile(tid, L0 + 16384, b0, b1, b2, b3);
    __syncthreads();
#define SGB_PIPE() do { __builtin_amdgcn_sched_group_barrier(0x100, 8, 0); \
      _Pragma("unroll") for (int q_ = 0; q_ < 8; ++q_) { __builtin_amdgcn_sched_group_barrier(0x008, 1, 0); __builtin_amdgcn_sched_group_barrier(0x020, 1, 0); __builtin_amdgcn_sched_group_barrier(0x008, 1, 0); __builtin_amdgcn_sched_group_barrier(0x100, 1, 0); } \
      _Pragma("unroll") for (int q_ = 0; q_ < 8; ++q_) { __builtin_amdgcn_sched_group_barrier(0x008, 1, 0); __builtin_amdgcn_sched_group_barrier(0x200, 1, 0); __builtin_amdgcn_sched_group_barrier(0x008, 1, 0); } } while (0)
    for (int kt = 0; kt < nk; kt += 2) {
      const int k2 = ((min(kt + 2, km) + rot) & km) << 6, k3 = ((min(kt + 3, km) + rot) & km) << 6;
      load_a<AM, SS>(tid, a0, a1, a2, a3, A0, A1, lda, m0, k2, aux, ss); load_b(tid, b0, b1, b2, b3, Bt, ldb, n0, k2);
      mma_tile<SWAP>(acc, L0, wr, wc, fr, fq);
      store_a<SS>(tid, L1, c0, c1, c2, c3, ss); store_tile(tid, L1 + 16384, d0, d1, d2, d3);
      SGB_PIPE();
      __syncthreads();
      load_a<AM, SS>(tid, c0, c1, c2, c3, A0, A1, lda, m0, k3, aux, ss); load_b(tid, d0, d1, d2, d3, Bt, ldb, n0, k3);
      mma_tile<SWAP>(acc, L1, wr, wc, fr, fq);
      if (SS) { if (kt + 2 < nk) { ss[0] += ssq8(a0); ss[1] += ssq8(a1); ss[2] += ssq8(a2); ss[3] += ssq8(a3); } }
      store_tile(tid, L0, a0, a1, a2, a3); store_tile(tid, L0 + 16384, b0, b1, b2, b3);
      SGB_PIPE();
      __syncthreads();
    }
#undef SGB_PIPE
    asm volatile("s_waitcnt vmcnt(0)" ::: "memory");
  } else {
    load_a<AM, SS>(tid, a0, a1, a2, a3, A0, A1, lda, m0, (rot & km) << 6, aux, ss);
    load_b(tid, b0, b1, b2, b3, Bt, ldb, n0, (rot & km) << 6);
    store_a<SS>(tid, L0, a0, a1, a2, a3, ss); store_tile(tid, L0 + 16384, b0, b1, b2, b3);
    __syncthreads();
    for (int kt = 0; kt < nk; ++kt) {
      unsigned char* cur = smem + (kt & 1) * 32768;
      unsigned char* nxt = smem + ((kt + 1) & 1) * 32768;
      const bool more = (kt + 1 < nk);
      if (more) { load_a<AM, SS>(tid, a0, a1, a2, a3, A0, A1, lda, m0, ((kt + 1 + rot) & km) << 6, aux, ss); load_b(tid, b0, b1, b2, b3, Bt, ldb, n0, ((kt + 1 + rot) & km) << 6); }
      mma_tile<SWAP>(acc, cur, wr, wc, fr, fq);
      if (more) { store_a<SS>(tid, nxt, a0, a1, a2, a3, ss); store_tile(tid, nxt + 16384, b0, b1, b2, b3); }
      __syncthreads();
    }
  }
}
__device__ __forceinline__ void finish_rstd(float (&ss)[4], unsigned char* smem) {
  const int tid = tid_fresh(), r0 = tid >> 3, kc = tid & 7;
  float* rs = (float*)smem;
#pragma unroll
  for (int i = 0; i < 4; ++i) {
    float v = ss[i];
    v += __shfl_xor(v, 1); v += __shfl_xor(v, 2); v += __shfl_xor(v, 4);
    if (kc == 0) rs[r0 + 32 * i] = rsqrtf(v * (1.f / 1024.f) + 1e-6f);
  }
  __syncthreads();
}
__device__ __forceinline__ void zero_acc(f32x4 (&acc)[4][4]) {
#pragma unroll
  for (int m = 0; m < 4; ++m)
#pragma unroll
    for (int n = 0; n < 4; ++n) acc[m][n] = (f32x4){0.f, 0.f, 0.f, 0.f};
}

__device__ __forceinline__ bool tile_pick(int i, int nNt, int& mt, int& nt, int& L) {
  const int b = blockIdx.x;
  L = i * (int)gridDim.x + (b & 7) * ((int)gridDim.x >> 3) + (b >> 3);
  if (L >= 256 * nNt) return false;
  const int band = L / (8 * nNt), r = L - band * (8 * nNt), c = r >> 6, w = r & 63;
  mt = band * 8 + (w & 7); nt = c * 8 + (w >> 3);
  return true;
}

__device__ __forceinline__ void inproj_phase(const bf16_t* hb, const bf16_t* W, int ng, int wr0, int wr1, int wr2, int wr3,
                             bf16_t* d0, bf16_t* d1, bf16_t* d2, bf16_t* d3, int md0, int md1, int md2, int md3, unsigned char* smem, float* part = nullptr) {
  const int tid = tid_fresh(), wid = tid >> 6, lane = tid & 63, wr = wid >> 1, wc = wid & 1, fr = lane & 15, fq = lane >> 4;
  for (int i = 0;; ++i) {
    int mt, ntg, t;
    if (!tile_pick(i, ng * 8, mt, ntg, t)) break;
    const int grp = ntg >> 3, nt = ntg & 7;
    const int wrow = grp == 0 ? wr0 : grp == 1 ? wr1 : grp == 2 ? wr2 : wr3;
    bf16_t* dst = grp == 0 ? d0 : grp == 1 ? d1 : grp == 2 ? d2 : d3;
    const int mode = grp == 0 ? md0 : grp == 1 ? md1 : grp == 2 ? md2 : md3;
    const int m0 = mt * 128, n0 = nt * 128;
    f32x4 acc[4][4]; zero_acc(acc);
    float ss[4] = {0.f, 0.f, 0.f, 0.f};
    if (mode == 1) {
      gemm_mainloop<0, true, false>(acc, hb, nullptr, 1024, W + (size_t)wrow * 1024, 1024, m0, n0, 1024, 0, smem, ss, 0);
      finish_rstd(ss, smem);
      const float* rs = (const float*)smem;
#pragma unroll
      for (int m = 0; m < 4; ++m) {
        const int rl = wr * 64 + m * 16 + fq * 4;
        const float r0 = rs[rl], r1 = rs[rl + 1], r2 = rs[rl + 2], r3 = rs[rl + 3];
#pragma unroll
        for (int n = 0; n < 4; ++n) {
          const int col = n0 + wc * 64 + n * 16 + fr;
          uint2 o; o.x = pack2(acc[m][n][0] * r0, acc[m][n][1] * r1); o.y = pack2(acc[m][n][2] * r2, acc[m][n][3] * r3);
          *(uint2*)(dst + (size_t)col * TOK + m0 + rl) = o;
        }
      }
    } else {
      gemm_mainloop<0, true, true>(acc, hb, nullptr, 1024, W + (size_t)wrow * 1024, 1024, m0, n0, 1024, 0, smem, ss, 0);
      finish_rstd(ss, smem);
      const float* rs = (const float*)smem;
      uint2 old[4][4];
      if (mode == 2) {
#pragma unroll
        for (int m = 0; m < 4; ++m)
#pragma unroll
          for (int n = 0; n < 4; ++n) old[m][n] = *(const uint2*)(dst + (size_t)(m0 + wr * 64 + m * 16 + fr) * 1024 + n0 + wc * 64 + n * 16 + fq * 4);
      }
#pragma unroll
      for (int m = 0; m < 4; ++m) {
        const int rl = wr * 64 + m * 16 + fr;
        const float r = rs[rl];
        float psq = 0.f;
#pragma unroll
        for (int n = 0; n < 4; ++n) {
          const int col = n0 + wc * 64 + n * 16 + fq * 4;
          bf16_t* pd = dst + (size_t)(m0 + rl) * 1024 + col;
          float v0 = acc[m][n][0] * r, v1 = acc[m][n][1] * r, v2 = acc[m][n][2] * r, v3 = acc[m][n][3] * r;
          if (mode == 2) {
            v0 = lo_f(old[m][n].x) * silu_f(v0); v1 = hi_f(old[m][n].x) * silu_f(v1); v2 = lo_f(old[m][n].y) * silu_f(v2); v3 = hi_f(old[m][n].y) * silu_f(v3);
          }
          uint2 o; o.x = pack2(v0, v1); o.y = pack2(v2, v3);
          *(uint2*)pd = o;
          if (mode == 3) psq += v0 * v0 + v1 * v1 + v2 * v2 + v3 * v3;
        }
        if (mode == 3) {
          psq += __shfl_xor(psq, 16); psq += __shfl_xor(psq, 32);
          if (fq == 0) part[(size_t)(m0 + rl) * 16 + nt * 2 + wc] = psq;
        }
      }
    }
  }
}

__device__ __forceinline__ void outproj_phase(const bf16_t* MA, const bf16_t* MB, const bf16_t* Wt  , const float* hsrc, float* hres, bf16_t* hbB, unsigned char* smem) {
  const int tid = tid_fresh(), wid = tid >> 6, lane = tid & 63, wr = wid >> 1, wc = wid & 1, fr = lane & 15, fq = lane >> 4;
  for (int i = 0;; ++i) {
    int mt, nt, t;
    if (!tile_pick(i, 8, mt, nt, t)) break;
    const int m0 = mt * 128, n0 = nt * 128;
    f32x4 acc[4][4]; zero_acc(acc);
    float ss[4] = {0.f, 0.f, 0.f, 0.f};
    gemm_mainloop<2, false, true>(acc, MA, MB, 1024, Wt, 2048, m0, n0, 2048, 0, smem, ss, 0);
#pragma unroll
    for (int m = 0; m < 4; ++m) {
      const int row = m0 + wr * 64 + m * 16 + fr;
      const size_t idx = (size_t)row * 1024 + n0 + wc * 64 + fq * 4;
      float4 h[4];
#pragma unroll
      for (int n = 0; n < 4; ++n) h[n] = *(const float4*)(hsrc + idx + n * 16);
#pragma unroll
      for (int n = 0; n < 4; ++n) {
        const float4 o = make_float4(h[n].x + acc[m][n][0], h[n].y + acc[m][n][1], h[n].z + acc[m][n][2], h[n].w + acc[m][n][3]);
        *(float4*)(hres + idx + n * 16) = o;
        uint2 ob; ob.x = pack2(o.x, o.y); ob.y = pack2(o.z, o.w);
        *(uint2*)(hbB + idx + n * 16) = ob;
      }
    }
  }
}

__device__ __forceinline__ void ple_phase(const bf16_t* hbB, const float* pin  , const bf16_t* Wg  , const bf16_t* Wup  ,
                          float* hres, bf16_t* hbA, unsigned char* smem) {
  const int tid = tid_fresh(), wid = tid >> 6, lane = tid & 63, wr = wid >> 1, wc = wid & 1, fr = lane & 15, fq = lane >> 4;
  for (int i = 0;; ++i) {
    int mt, nt, t;
    if (!tile_pick(i, 8, mt, nt, t)) break;
    const int m0 = mt * 128, n0 = nt * 128;
    f32x4 ag[4][4]; zero_acc(ag);
    float ss[4] = {0.f, 0.f, 0.f, 0.f};
    gemm_mainloop<0, true, true>(ag, hbB, nullptr, 1024, Wg, 1024, m0, n0, 1024, 0, smem, ss, 0);
    finish_rstd(ss, smem);
    unsigned gp[4][4][2];
    {
      const float* rs = (const float*)smem;
#pragma unroll
      for (int m = 0; m < 4; ++m) {
        const float r = rs[wr * 64 + m * 16 + fr];
#pragma unroll
        for (int n = 0; n < 4; ++n) {
          gp[m][n][0] = pack2(sigmoid_f(r * ag[m][n][0]), sigmoid_f(r * ag[m][n][1]));
          gp[m][n][1] = pack2(sigmoid_f(r * ag[m][n][2]), sigmoid_f(r * ag[m][n][3]));
        }
      }
    }
    zero_acc(ag);
    float ss2[4] = {0.f, 0.f, 0.f, 0.f};
    gemm_mainloop<1, false, true>(ag, pin, nullptr, 256, Wup, 256, m0, n0, 256, 0, smem, ss2, 0);
#pragma unroll
    for (int m = 0; m < 4; ++m) {
      const int rl = wr * 64 + m * 16 + fr;
      const size_t idx = (size_t)(m0 + rl) * 1024 + n0 + wc * 64 + fq * 4;
      float4 h[4];
#pragma unroll
      for (int n = 0; n < 4; ++n) h[n] = *(const float4*)(hres + idx + n * 16);
#pragma unroll
      for (int n = 0; n < 4; ++n) {
        float4 o;
        o.x = h[n].x + ag[m][n][0] * lo_f(gp[m][n][0]);
        o.y = h[n].y + ag[m][n][1] * hi_f(gp[m][n][0]);
        o.z = h[n].z + ag[m][n][2] * lo_f(gp[m][n][1]);
        o.w = h[n].w + ag[m][n][3] * hi_f(gp[m][n][1]);
        *(float4*)(hres + idx + n * 16) = o;
        uint2 ob; ob.x = pack2(o.x, o.y); ob.y = pack2(o.z, o.w);
        *(uint2*)(hbA + idx + n * 16) = ob;
      }
    }
  }
}

__device__ __forceinline__ void pool_phase(const bf16_t* XC, const bf16_t* Wp  , const float* pb, const float* ps, bf16_t* MC, unsigned char* smem) {
  const int tid = tid_fresh(), wid = tid >> 6, lane = tid & 63, wr = wid >> 1, wc = wid & 1, fr = lane & 15, fq = lane >> 4;
  unsigned char* sA = smem;
  unsigned char* sB = smem + 16384;
  unsigned char* sXs = smem + 32768;
  for (int t = blockIdx.x; t < 2048; t += gridDim.x) {
    const int mt = t >> 3, g = (t >> 1) & 3, nt = t & 1, m0 = mt * 128, n0 = nt * 128;
    const int half = 1 << g;
    const int tb0 = m0 & (SEQ - 1);
    const bf16_t* Bt = Wp + (size_t)g * 65536;
    f32x4 acc[4][4]; zero_acc(acc);
    uint4 xr[5], b0, b1, b2, b3;
#pragma unroll
    for (int i = 0; i < 5; ++i) {
      const int id = tid + 256 * i, row = id >> 3, kc = id & 7, tb = tb0 - 8 + row;
      xr[i] = (id < 1152 && tb >= 0 && tb < SEQ) ? *(const uint4*)(XC + (size_t)(m0 - 8 + row) * 1024 + g * 256 + kc * 8) : make_uint4(0u, 0u, 0u, 0u);
    }
    load_b(tid, b0, b1, b2, b3, Bt, 256, n0, 0);
    __syncthreads();
#pragma unroll 1
    for (int ks = 0; ks < 4; ++ks) {
#pragma unroll
      for (int i = 0; i < 5; ++i) { const int id = tid + 256 * i; if (id < 1152) *(uint4*)(sXs + id * 16) = xr[i]; }
      store_tile(tid, sB, b0, b1, b2, b3);
      __syncthreads();
      if (ks < 3) {
        const int k1 = (ks + 1) * 64;
#pragma unroll
        for (int i = 0; i < 5; ++i) {
          const int id = tid + 256 * i, row = id >> 3, kc = id & 7, tb = tb0 - 8 + row;
          xr[i] = (id < 1152 && tb >= 0 && tb < SEQ) ? *(const uint4*)(XC + (size_t)(m0 - 8 + row) * 1024 + g * 256 + k1 + kc * 8) : make_uint4(0u, 0u, 0u, 0u);
        }
        load_b(tid, b0, b1, b2, b3, Bt, 256, n0, k1);
      }
#pragma unroll
      for (int i = 0; i < 4; ++i) {
        const int row = (tid >> 3) + 32 * i, kc = tid & 7, tb = tb0 + row;
        const int lo = max(tb - half, 0), hi = min(tb + half, SEQ);
        float s0 = 0.f, s1 = 0.f, s2 = 0.f, s3 = 0.f, s4 = 0.f, s5 = 0.f, s6 = 0.f, s7 = 0.f;
        for (int tt = lo; tt < hi; ++tt) {
          const uint4 u = *(const uint4*)(sXs + (tt - tb0 + 8) * 128 + kc * 16);
          s0 += lo_f(u.x); s1 += hi_f(u.x); s2 += lo_f(u.y); s3 += hi_f(u.y); s4 += lo_f(u.z); s5 += hi_f(u.z); s6 += lo_f(u.w); s7 += hi_f(u.w);
        }
        const uint4 u = *(const uint4*)(sXs + (row + 8) * 128 + kc * 16);
        const float inv = 1.f / (float)(hi - lo);
        *(uint4*)(sA + swz(row, kc)) = make_uint4(pack2(s0 * inv - lo_f(u.x), s1 * inv - hi_f(u.x)), pack2(s2 * inv - lo_f(u.y), s3 * inv - hi_f(u.y)),
                                                  pack2(s4 * inv - lo_f(u.z), s5 * inv - hi_f(u.z)), pack2(s6 * inv - lo_f(u.w), s7 * inv - hi_f(u.w)));
      }
      __syncthreads();
      mma_tile<true>(acc, smem, wr, wc, fr, fq);
      __syncthreads();
    }
#pragma unroll
    for (int m = 0; m < 4; ++m) {
      const int row = m0 + wr * 64 + m * 16 + fr;
#pragma unroll
      for (int n = 0; n < 4; ++n) {
        const int col = g * 256 + n0 + wc * 64 + n * 16 + fq * 4;
        const float4 b = *(const float4*)(pb + col), sc = *(const float4*)(ps + col);
        uint2 o; o.x = pack2((acc[m][n][0] + b.x) * sc.x, (acc[m][n][1] + b.y) * sc.y); o.y = pack2((acc[m][n][2] + b.z) * sc.z, (acc[m][n][3] + b.w) * sc.w);
        *(uint2*)(MC + (size_t)row * 1024 + col) = o;
      }
    }
  }
}

__device__ __forceinline__ void gmlp_phase(bf16_t* UB, const bf16_t* VB, const bf16_t* Ws  , const float* gmg, const float* gbs  , const float* part, unsigned char* smem) {
  const int tid = tid_fresh(), wid = tid >> 6, lane = tid & 63, wr = wid >> 1, wc = wid & 1, fr = lane & 15, fq = lane >> 4;
  unsigned char* sW = smem;
  unsigned char* sX = smem + 32768;
  for (int it = blockIdx.x; it < 2048; it += gridDim.x) {
    const int g = it & 7, tok0 = (it >> 3) * 128;
    __syncthreads();
#pragma unroll 2
    for (int i = 0; i < 8; ++i) {
      const int id = tid + 256 * i, row = id >> 4, kc = id & 15;
      *(uint4*)(sW + row * 256 + ((kc ^ (row & 15)) << 4)) = *(const uint4*)(Ws + (size_t)g * 16384 + row * 128 + kc * 8);
    }
    float rq;
    {
      const float4* pp = (const float4*)(part + (size_t)(tok0 + (tid & 127)) * 16);
      const float4 p0 = pp[0], p1 = pp[1], p2 = pp[2], p3 = pp[3];
      const float sq = (p0.x + p0.y + p0.z + p0.w) + (p1.x + p1.y + p1.z + p1.w) + (p2.x + p2.y + p2.z + p2.w) + (p3.x + p3.y + p3.z + p3.w);
      rq = rsqrtf(sq * (1.f / 1024.f) + 1e-6f);
    }
    __syncthreads();
#pragma unroll 2
    for (int i = 0; i < 8; ++i) {
      const int id = tid + 256 * i, q = id & 127, cc = id >> 7;
      float f[8]; unpack8(*(const uint4*)(VB + (size_t)(tok0 + q) * 1024 + g * 128 + cc * 8), f);
#pragma unroll
      for (int e = 0; e < 8; ++e) {
        const int c = cc * 8 + e;
        const float v = f[e] * rq * gmg[g * 128 + c];
        *(bf16_t*)(sX + c * 256 + (((q >> 3) ^ (c & 15)) << 4) + (q & 7) * 2) = f2bf(v);
      }
    }
    __syncthreads();
    f32x4 acc[4][4]; zero_acc(acc);
#pragma unroll
    for (int s = 0; s < 4; ++s) {
      bf16x8 af[4], bfr[4];
#pragma unroll
      for (int m = 0; m < 4; ++m) { const int row = wr * 64 + m * 16 + fr; af[m] = *(const bf16x8*)(sW + row * 256 + (((s * 4 + fq) ^ (row & 15)) << 4)); }
#pragma unroll
      for (int n = 0; n < 4; ++n) { const int row = wc * 64 + n * 16 + fr; bfr[n] = *(const bf16x8*)(sX + row * 256 + (((s * 4 + fq) ^ (row & 15)) << 4)); }
#pragma unroll
      for (int m = 0; m < 4; ++m)
#pragma unroll
        for (int n = 0; n < 4; ++n) acc[m][n] = __builtin_amdgcn_mfma_f32_16x16x32_bf16(bfr[n], af[m], acc[m][n], 0, 0, 0);
    }
    uint2 uo[4][4];
#pragma unroll
    for (int m = 0; m < 4; ++m)
#pragma unroll
      for (int n = 0; n < 4; ++n) uo[m][n] = *(const uint2*)(UB + (size_t)(tok0 + wr * 64 + m * 16 + fr) * 1024 + g * 128 + wc * 64 + n * 16 + fq * 4);
#pragma unroll
    for (int m = 0; m < 4; ++m) {
      const int p = wr * 64 + m * 16 + fr;
      const float bias = gbs[g * 128 + p];
#pragma unroll
      for (int n = 0; n < 4; ++n) {
        const int c = wc * 64 + n * 16 + fq * 4;
        bf16_t* pd = UB + (size_t)(tok0 + p) * 1024 + g * 128 + c;
        const uint2 u = uo[m][n];
        uint2 o; o.x = pack2(lo_f(u.x) * (acc[m][n][0] + bias), hi_f(u.x) * (acc[m][n][1] + bias));
        o.y = pack2(lo_f(u.y) * (acc[m][n][2] + bias), hi_f(u.y) * (acc[m][n][3] + bias));
        *(uint2*)pd = o;
      }
    }
  }
}

__device__ __forceinline__ void na_phase(bf16_t* Q, const bf16_t* Kb, const bf16_t* Vt, const float* rpb, unsigned char* smem) {
  const int tid = tid_fresh(), wq = tid >> 6, lane = tid & 63, fr = lane & 15, fq = lane >> 4;
  for (int it = blockIdx.x; it < 8 * 64 * 16; it += gridDim.x) {
    const int h = it & 15, r = (it >> 4) & 63, b = it >> 10;
    const int rs = min(max(r - 4, 0), 56);
    const int w0 = (wq == 0) ? 0 : (wq == 1) ? 8 : (wq == 2) ? 24 : 32;
    const int qc = wq * 16 + fr;
    const int tokq = b * 4096 + r * 64 + qc;
    const bf16x8 qf0 = *(const bf16x8*)(Q + (size_t)tokq * 1024 + h * 64 + fq * 8);
    const bf16x8 qf1 = *(const bf16x8*)(Q + (size_t)tokq * 1024 + h * 64 + 32 + fq * 8);
    const int cs = min(max(qc - 8, 0), 48);
    const float* rp = rpb + h * (15 * 31);
    const size_t tok0 = (size_t)b * 4096 + rs * 64;
    __syncthreads();
#pragma unroll 1
    for (int i0 = 0; i0 < 16; i0 += 16) {
      uint4 kv[16];
#pragma unroll
      for (int i = 0; i < 16; ++i) {
        const int id = tid + 256 * (i0 + i), key = id >> 3, kc = id & 7;
        kv[i] = *(const uint4*)(Kb + (tok0 + key) * 1024 + h * 64 + kc * 8);
      }
#pragma unroll
      for (int i = 0; i < 16; ++i) {
        const int id = tid + 256 * (i0 + i), key = id >> 3, kc = id & 7;
        *(uint4*)(smem + key * 128 + ((kc ^ ((key >> 1) & 7)) << 4)) = kv[i];
      }
    }
    __syncthreads();
    uint4 vvA[4];
#pragma unroll
    for (int i = 0; i < 4; ++i) {
      const int id = tid + 256 * i, d = id >> 6, c16 = id & 63;
      vvA[i] = *(const uint4*)(Vt + (size_t)(h * 64 + d) * TOK + tok0 + c16 * 8);
    }
    f32x4 sc[8][2];
    float mx = -1e30f;
#pragma unroll
    for (int jr = 0; jr < 8; ++jr) {
#pragma unroll
      for (int hc = 0; hc < 2; ++hc) {
        const int key = jr * 64 + w0 + 8 * (fr >> 2) + 4 * hc + (fr & 3);
        const unsigned char* kp = smem + key * 128;
        const int kx = (key >> 1) & 7;
        const bf16x8 kf0 = *(const bf16x8*)(kp + ((fq ^ kx) << 4));
        const bf16x8 kf1 = *(const bf16x8*)(kp + (((4 + fq) ^ kx) << 4));
        f32x4 a = (f32x4){0.f, 0.f, 0.f, 0.f};
        a = __builtin_amdgcn_mfma_f32_16x16x32_bf16(kf0, qf0, a, 0, 0, 0);
        a = __builtin_amdgcn_mfma_f32_16x16x32_bf16(kf1, qf1, a, 0, 0, 0);
        const int dr = rs + jr - r + 7;
#pragma unroll
        for (int e = 0; e < 4; ++e) {
          const int kcol = w0 + 8 * fq + 4 * hc + e;
          const bool valid = (kcol >= cs) && (kcol < cs + 16);
          const int dc = min(max(kcol - qc + 15, 0), 30);
          const float v = valid ? (a[e] * 0.125f + rp[dr * 31 + dc]) : -1e30f;
          a[e] = v; mx = fmaxf(mx, v);
        }
        sc[jr][hc] = a;
      }
    }
    mx = fmaxf(mx, __shfl_xor(mx, 16)); mx = fmaxf(mx, __shfl_xor(mx, 32));
    float sum = 0.f;
#pragma unroll
    for (int jr = 0; jr < 8; ++jr)
#pragma unroll
      for (int hc = 0; hc < 2; ++hc)
#pragma unroll
        for (int e = 0; e < 4; ++e) { const float pv = (sc[jr][hc][e] > -1e29f) ? __expf(sc[jr][hc][e] - mx) : 0.f; sc[jr][hc][e] = pv; sum += pv; }
    sum += __shfl_xor(sum, 16); sum += __shfl_xor(sum, 32);
    const float inv = 1.f / sum;
    __syncthreads();
    {
#pragma unroll
      for (int i = 0; i < 4; ++i) {
        const int id = tid + 256 * i, d = id >> 6, c16 = id & 63;
        *(uint4*)(smem + d * 1024 + ((c16 ^ (d & 15)) << 4)) = vvA[i];
      }
#pragma unroll 1
      for (int i0 = 4; i0 < 16; i0 += 6) {
        uint4 vvB[6];
#pragma unroll
        for (int i = 0; i < 6; ++i) {
          const int id = tid + 256 * (i0 + i), d = id >> 6, c16 = id & 63;
          vvB[i] = *(const uint4*)(Vt + (size_t)(h * 64 + d) * TOK + tok0 + c16 * 8);
        }
#pragma unroll
        for (int i = 0; i < 6; ++i) {
          const int id = tid + 256 * (i0 + i), d = id >> 6, c16 = id & 63;
          *(uint4*)(smem + d * 1024 + ((c16 ^ (d & 15)) << 4)) = vvB[i];
        }
      }
    }
    __syncthreads();
    f32x4 o[4];
#pragma unroll
    for (int dt = 0; dt < 4; ++dt) o[dt] = (f32x4){0.f, 0.f, 0.f, 0.f};
#pragma unroll
    for (int jr = 0; jr < 8; ++jr) {
      union { bf16x8 v; unsigned u[4]; } pf;
      pf.u[0] = pack2(sc[jr][0][0] * inv, sc[jr][0][1] * inv); pf.u[1] = pack2(sc[jr][0][2] * inv, sc[jr][0][3] * inv);
      pf.u[2] = pack2(sc[jr][1][0] * inv, sc[jr][1][1] * inv); pf.u[3] = pack2(sc[jr][1][2] * inv, sc[jr][1][3] * inv);
      const int c16 = jr * 8 + (w0 >> 3) + fq;
#pragma unroll
      for (int dt = 0; dt < 4; ++dt) {
        const int d = dt * 16 + fr;
        const bf16x8 vf = *(const bf16x8*)(smem + d * 1024 + ((c16 ^ (d & 15)) << 4));
        o[dt] = __builtin_amdgcn_mfma_f32_16x16x32_bf16(vf, pf.v, o[dt], 0, 0, 0);
      }
    }
#pragma unroll
    for (int dt = 0; dt < 4; ++dt) {
      uint2 ob; ob.x = pack2(o[dt][0], o[dt][1]); ob.y = pack2(o[dt][2], o[dt][3]);
      *(uint2*)(Q + (size_t)tokq * 1024 + h * 64 + dt * 16 + fq * 4) = ob;
    }
  }
}

__device__ __forceinline__ float2 cmul(float2 a, float2 b) { return make_float2(a.x * b.x - a.y * b.y, a.x * b.y + a.y * b.x); }
__device__ __forceinline__ float2 cadd(float2 a, float2 b) { return make_float2(a.x + b.x, a.y + b.y); }
__device__ __forceinline__ float2 csub(float2 a, float2 b) { return make_float2(a.x - b.x, a.y - b.y); }

template <bool DIF>
__device__ __forceinline__ void bfly(float2& a, float2& b, float2 w) {
  if (DIF) { const float2 s = cadd(a, b), d = csub(a, b); a = s; b = cmul(d, w); }
  else { const float2 t = cmul(b, w); const float2 s = cadd(a, t), d = csub(a, t); a = s; b = d; }
}
#define PH(i) ((i) ^ (((i) >> 4) & 7))
template <bool DIF>
__device__ __forceinline__ void fft_r8(float2* buf, const float2* __restrict__ T, int lq) {
  const int q = 1 << lq, sA = 1024 >> lq;
  for (int g = tid_fresh(); g < 1024; g += NT) {
    const int j0 = g & (q - 1), i0 = ((g >> lq) << (lq + 3)) + j0;
    float2 x[8];
#pragma unroll
    for (int p = 0; p < 8; ++p) x[p] = buf[PH(i0 + p * q)];
    if (DIF) {
#pragma unroll
      for (int p = 0; p < 4; ++p) bfly<true>(x[p], x[p + 4], T[j0 * sA + p * 1024]);
#pragma unroll
      for (int p = 0; p < 2; ++p) { const float2 w = T[j0 * 2 * sA + p * 2048]; bfly<true>(x[p], x[p + 2], w); bfly<true>(x[4 + p], x[6 + p], w); }
      { const float2 w = T[j0 * 4 * sA]; bfly<true>(x[0], x[1], w); bfly<true>(x[2], x[3], w); bfly<true>(x[4], x[5], w); bfly<true>(x[6], x[7], w); }
    } else {
      { const float2 w = T[j0 * 4 * sA]; bfly<false>(x[0], x[1], w); bfly<false>(x[2], x[3], w); bfly<false>(x[4], x[5], w); bfly<false>(x[6], x[7], w); }
#pragma unroll
      for (int p = 0; p < 2; ++p) { const float2 w = T[j0 * 2 * sA + p * 2048]; bfly<false>(x[p], x[p + 2], w); bfly<false>(x[4 + p], x[6 + p], w); }
#pragma unroll
      for (int p = 0; p < 4; ++p) bfly<false>(x[p], x[p + 4], T[j0 * sA + p * 1024]);
    }
#pragma unroll
    for (int p = 0; p < 8; ++p) buf[PH(i0 + p * q)] = x[p];
  }
  __syncthreads();
}
__device__ __forceinline__ void fft_r2(float2* buf) {
  for (int g = tid_fresh(); g < 4096; g += NT) {
    const int i0 = PH(2 * g), i1 = PH(2 * g + 1);
    const float2 a = buf[i0], b = buf[i1];
    buf[i0] = make_float2(a.x + b.x, a.y + b.y); buf[i1] = make_float2(a.x - b.x, a.y - b.y);
  }
  __syncthreads();
}
__device__ __forceinline__ void fft_dif(float2* buf, const float2* T) { fft_r8<true>(buf, T, 10); fft_r8<true>(buf, T, 7); fft_r8<true>(buf, T, 4); fft_r8<true>(buf, T, 1); fft_r2(buf); }
__device__ __forceinline__ void fft_dit(float2* buf, const float2* T) { fft_r2(buf); fft_r8<false>(buf, T, 1); fft_r8<false>(buf, T, 4); fft_r8<false>(buf, T, 7); fft_r8<false>(buf, T, 10); }
__device__ __forceinline__ int brev13(int k) { return (int)(__brev((unsigned)k) >> 19); }

__device__ __forceinline__ void hyena_feats(float* h3, unsigned char* smem) {
  KP PP = params_fresh();
  float* hin = (float*)smem;
  const int tid = tid_fresh(), r = tid >> 6, u = tid & 63;
  for (int it = blockIdx.x; it < 2048; it += gridDim.x) {
    const int j = it >> 10, l = (it & 1023) * 4 + r;
    const float* w0 = PP->in[I_HW0] + j * 33 * 64; const float* b0 = PP->in[I_HB0] + j * 64;
    const float* w1 = PP->in[I_HW1] + j * 4096; const float* b1 = PP->in[I_HB1] + j * 64;
    const float* w2 = PP->in[I_HW2] + j * 4096; const float* b2 = PP->in[I_HB2] + j * 64;
    const float fr = PP->in[I_HFREQ][j * 64 + u];
    __syncthreads();
    {
      const float tt = (float)l / 4095.f;
      const float ang = 6.283185307179586f * (float)l / 4096.f;
      float f = 0.f;
      if (u == 0) f = tt;
      else if (u <= 16) { const float band = 1e-4f + (float)(u - 1) * ((15.f - 1e-4f) / 15.f); f = cosf(band * ang); }
      else if (u <= 32) { const float band = 1e-4f + (float)(u - 17) * ((15.f - 1e-4f) / 15.f); f = -sinf(band * ang); }
      hin[r * 64 + u] = f;
    }
    __syncthreads();
    float a = b0[u];
    for (int k = 0; k < 33; ++k) a += hin[r * 64 + k] * w0[k * 64 + u];
    float v = sinf(fr * a);
    __syncthreads(); hin[r * 64 + u] = v; __syncthreads();
    a = b1[u];
    for (int k = 0; k < 64; ++k) a += hin[r * 64 + k] * w1[k * 64 + u];
    v = sinf(fr * a);
    __syncthreads(); hin[r * 64 + u] = v; __syncthreads();
    a = b2[u];
    for (int k = 0; k < 64; ++k) a += hin[r * 64 + k] * w2[k * 64 + u];
    v = sinf(fr * a);
    h3[((size_t)j * 4096 + l) * 64 + u] = v;
  }
}

__device__ __forceinline__ void filtgen_phase(const float* hwout, int j, const float* h3, float* kT, unsigned char* smem) {
  float* hs = (float*)smem;
  float* wsm = (float*)(smem + 32768);
  const int tid = tid_fresh(), tl = tid & 15, tc = tid >> 4;
  const float* wout = hwout + (size_t)j * 64 * 2048;
  const float mind = logf(0.01f) / 1.5f, maxd = logf(0.01f) / 0.3f;
  for (int it = blockIdx.x; it < 2048; it += gridDim.x) {
    const int l0 = (it & 63) * 64, c0 = (it >> 6) * 64;
    __syncthreads();
#pragma unroll
    for (int i = 0; i < 4; ++i) {
      const int id = tid + 256 * i, r = id >> 4, c4 = id & 15;
      const float4 hv = *(const float4*)(h3 + ((size_t)j * 4096 + l0 + r) * 64 + c4 * 4);
      float* d = hs + r * 65 + c4 * 4; d[0] = hv.x; d[1] = hv.y; d[2] = hv.z; d[3] = hv.w;
      *(float4*)(wsm + r * 64 + c4 * 4) = *(const float4*)(wout + (size_t)r * 2048 + c0 + c4 * 4);
    }
    __syncthreads();
    float acc[4][4];
#pragma unroll
    for (int i = 0; i < 4; ++i)
#pragma unroll
      for (int k = 0; k < 4; ++k) acc[i][k] = 0.f;
#pragma unroll 4
    for (int u = 0; u < 64; ++u) {
      const float4 w = *(const float4*)(wsm + u * 64 + tc * 4);
#pragma unroll
      for (int i = 0; i < 4; ++i) {
        const float hv = hs[(tl * 4 + i) * 65 + u];
        acc[i][0] += hv * w.x; acc[i][1] += hv * w.y; acc[i][2] += hv * w.z; acc[i][3] += hv * w.w;
      }
    }
#pragma unroll
    for (int k = 0; k < 4; ++k) {
      const int col = c0 + tc * 4 + k, c = col & 1023;
      const float dl = fabsf(mind + (float)c * ((maxd - mind) / 1023.f));
      float4 o;
      o.x = acc[0][k] * expf(-((float)(l0 + tl * 4 + 0) / 4095.f) * dl);
      o.y = acc[1][k] * expf(-((float)(l0 + tl * 4 + 1) / 4095.f) * dl);
      o.z = acc[2][k] * expf(-((float)(l0 + tl * 4 + 2) / 4095.f) * dl);
      o.w = acc[3][k] * expf(-((float)(l0 + tl * 4 + 3) / 4095.f) * dl);
      *(float4*)(kT + (size_t)col * 4096 + l0 + tl * 4) = o;
    }
  }
}

__device__ __forceinline__ void spectrum_phase(const float* kT, const float2* T, float4* spec, unsigned char* smem) {
  float2* buf = (float2*)smem;
  float* red = (float*)smem;
  const int tid = tid_fresh(), lane = tid & 63, wid = tid >> 6;
  for (int pi = blockIdx.x; pi < 512; pi += gridDim.x) {
    const int c1 = 2 * pi;
    const float* f0 = kT + (size_t)c1 * 4096;
    const float* b0 = kT + (size_t)(1024 + c1) * 4096;
    __syncthreads();
    float s1 = 0.f, s2 = 0.f;
#pragma unroll 4
    for (int i = 0; i < 16; ++i) {
      const int l = tid + 256 * i;
      const float a00 = f0[l], a01 = f0[4096 + l], a10 = b0[l], a11 = b0[4096 + l];
      s1 += a00 * a00; s2 += a01 * a01;
      if (l != 0) { s1 += a10 * a10; s2 += a11 * a11; }
    }
#pragma unroll
    for (int o = 32; o > 0; o >>= 1) { s1 += __shfl_xor(s1, o); s2 += __shfl_xor(s2, o); }
    if (lane == 0) { red[wid * 2] = s1; red[wid * 2 + 1] = s2; }
    __syncthreads();
    s1 = red[0] + red[2] + red[4] + red[6]; s2 = red[1] + red[3] + red[5] + red[7];
    __syncthreads();
#pragma unroll 4
    for (int i = 0; i < 16; ++i) {
      const int l = tid + 256 * i;
      const float a00 = f0[l], a01 = f0[4096 + l], a10 = b0[l], a11 = b0[4096 + l];
      buf[PH(l)] = make_float2(a00, a01);
      if (l == 0) buf[PH(4096)] = make_float2(0.f, 0.f);
      else buf[PH(8192 - l)] = make_float2(a10, a11);
    }
    __syncthreads();
    const float sc1 = rsqrtf(s1 + 1e-6f) * (1.f / 8192.f);
    const float sc2 = rsqrtf(s2 + 1e-6f) * (1.f / 8192.f);
    fft_dif(buf, T);
    for (int k = tid; k <= 4096; k += NT) {
      const int pk_ = brev13(k), pn_ = brev13((8192 - k) & 8191);
      const float2 Pk = buf[PH(pk_)], Fn = buf[PH(pn_)];
      const float2 Qc = make_float2(Fn.x, -Fn.y);
      const float2 H1 = make_float2(0.5f * (Pk.x + Qc.x) * sc1, 0.5f * (Pk.y + Qc.y) * sc1);
      const float2 H2 = make_float2(0.5f * (Pk.y - Qc.y) * sc2, -0.5f * (Pk.x - Qc.x) * sc2);
      spec[(size_t)pi * SPEC_STRIDE + k] = make_float4(0.5f * (H1.x + H2.x), 0.5f * (H1.y + H2.y), 0.5f * (H1.x - H2.x), 0.5f * (H1.y - H2.y));
    }
  }
}

__device__ __forceinline__ void z_phase(const bf16_t* X1, const bf16_t* V, const float* cw  , const float* cb  , float* zT, unsigned char* smem) {
  float* zs = (float*)smem;
  const int tid = tid_fresh(), c8 = tid & 7, tr = tid >> 3;
  for (int it = blockIdx.x; it < 8192; it += gridDim.x) {
    const int ct = it & 15, tt = it >> 4, c0 = ct * 64, t0 = tt * 64;
    __syncthreads();
    const int c = c0 + c8 * 8;
    float w1[3][8], w2[3][8], bb1[8], bb2[8];
#pragma unroll
    for (int e = 0; e < 8; ++e) {
#pragma unroll
      for (int k = 0; k < 3; ++k) { w1[k][e] = cw[k * 3072 + 1024 + c + e]; w2[k][e] = cw[k * 3072 + 2048 + c + e]; }
      bb1[e] = cb[1024 + c + e]; bb2[e] = cb[2048 + c + e];
    }
#pragma unroll
    for (int i = 0; i < 2; ++i) {
      const int tl = tr + 32 * i, t = t0 + tl, tb = t & (SEQ - 1);
      float a1[8], a2[8];
#pragma unroll
      for (int e = 0; e < 8; ++e) { a1[e] = bb1[e]; a2[e] = bb2[e]; }
#pragma unroll
      for (int k = 0; k < 3; ++k) {
        const int tbk = tb + k - 1;
        if (tbk >= 0 && tbk < SEQ) {
          float f[8], g[8];
          unpack8(*(const uint4*)(X1 + (size_t)(t + k - 1) * 1024 + c), f);
          unpack8(*(const uint4*)(V + (size_t)(t + k - 1) * 1024 + c), g);
#pragma unroll
          for (int e = 0; e < 8; ++e) { a1[e] += w1[k][e] * f[e]; a2[e] += w2[k][e] * g[e]; }
        }
      }
#pragma unroll
      for (int e = 0; e < 8; ++e) zs[(c8 * 8 + e) * 65 + tl] = a1[e] * a2[e];
    }
    __syncthreads();
    {
      const int cl = tid >> 2, tq = tid & 3;
      const int bidx = t0 >> 12, tbase = t0 & (SEQ - 1);
      float* dst = zT + ((size_t)(bidx * 1024 + c0 + cl)) * SEQ + tbase + tq * 16;
#pragma unroll
      for (int v4 = 0; v4 < 4; ++v4) {
        const float* s = zs + cl * 65 + tq * 16 + v4 * 4;
        *(float4*)(dst + v4 * 4) = make_float4(s[0], s[1], s[2], s[3]);
      }
    }
  }
}

__device__ __forceinline__ void fftconv_phase(float* zT, const float4* spec, const float2* T, const float* hd, unsigned char* smem) {
  float2* buf = (float2*)smem;
  const int tid = tid_fresh();
  for (int it = blockIdx.x; it < 4096; it += gridDim.x) {
    const int b = (it >> 3) & 7, pi = (it & 7) + 8 * (it >> 6), c1 = 2 * pi;
    float* z1 = zT + ((size_t)(b * 1024 + c1)) * SEQ;
    float* z2 = z1 + SEQ;
    __syncthreads();
    for (int t = tid; t < 4096; t += NT) { buf[PH(t)] = make_float2(z1[t], z2[t]); buf[PH(4096 + t)] = make_float2(0.f, 0.f); }
    __syncthreads();
    fft_dif(buf, T);
    const float4* sp = spec + (size_t)pi * SPEC_STRIDE;
    for (int k = tid; k <= 4096; k += NT) {
      const int pk0 = brev13(k), pn0 = brev13((8192 - k) & 8191);
      const int pk = PH(pk0), pn = PH(pn0);
      const float2 Xk = buf[pk], Xn = buf[pn];
      const float4 sd = sp[k];
      const float2 S = make_float2(sd.x, sd.y), D = make_float2(sd.z, sd.w);
      const float2 Wk = cadd(cmul(Xk, S), cmul(make_float2(Xn.x, -Xn.y), D));
      const float2 Wn = cadd(cmul(Xn, make_float2(S.x, -S.y)), cmul(make_float2(Xk.x, -Xk.y), make_float2(D.x, -D.y)));
      buf[pk] = make_float2(Wk.x, -Wk.y);
      buf[pn] = make_float2(Wn.x, -Wn.y);
    }
    __syncthreads();
    fft_dit(buf, T);
    const float d1 = hd[c1], d2 = hd[c1 + 1];
    for (int t = tid; t < 4096; t += NT) {
      const float2 y = buf[PH(t)];
      z1[t] = y.x + d1 * z1[t];
      z2[t] = -y.y + d2 * z2[t];
    }
  }
}

__device__ __forceinline__ void ya_phase(const bf16_t* X0, const float* yT, const float* cw, const float* cb, bf16_t* MA, unsigned char* smem) {
  float* ys = (float*)smem;
  const int tid = tid_fresh(), c8 = tid & 7, tr = tid >> 3;
  for (int it = blockIdx.x; it < 8192; it += gridDim.x) {
    const int ct = it & 15, tt = it >> 4, c0 = ct * 64, t0 = tt * 64;
    __syncthreads();
    {
      const int cl = tid >> 2, tq = tid & 3;
      const int bidx = t0 >> 12, tbase = t0 & (SEQ - 1);
      const float* src = yT + ((size_t)(bidx * 1024 + c0 + cl)) * SEQ + tbase + tq * 16;
#pragma unroll
      for (int v4 = 0; v4 < 4; ++v4) {
        const float4 v = *(const float4*)(src + v4 * 4);
        float* s = ys + cl * 65 + tq * 16 + v4 * 4;
        s[0] = v.x; s[1] = v.y; s[2] = v.z; s[3] = v.w;
      }
    }
    __syncthreads();
    const int c = c0 + c8 * 8;
    float w0[3][8], bb[8];
#pragma unroll
    for (int e = 0; e < 8; ++e) {
#pragma unroll
      for (int k = 0; k < 3; ++k) w0[k][e] = cw[k * 3072 + c + e];
      bb[e] = cb[c + e];
    }
#pragma unroll
    for (int i = 0; i < 2; ++i) {
      const int tl = tr + 32 * i, t = t0 + tl, tb = t & (SEQ - 1);
      float a[8];
#pragma unroll
      for (int e = 0; e < 8; ++e) a[e] = bb[e];
#pragma unroll
      for (int k = 0; k < 3; ++k) {
        const int tbk = tb + k - 1;
        if (tbk >= 0 && tbk < SEQ) {
          float f[8];
          unpack8(*(const uint4*)(X0 + (size_t)(t + k - 1) * 1024 + c), f);
#pragma unroll
          for (int e = 0; e < 8; ++e) a[e] += w0[k][e] * f[e];
        }
      }
#pragma unroll
      for (int e = 0; e < 8; ++e) a[e] *= ys[(c8 * 8 + e) * 65 + tl];
      *(uint4*)(MA + (size_t)t * 1024 + c) = make_uint4(pack2(a[0], a[1]), pack2(a[2], a[3]), pack2(a[4], a[5]), pack2(a[6], a[7]));
    }
  }
}

__device__ __forceinline__ void convT_job(const float* src, int K, int N, bf16_t* dst, const float* scale, unsigned char* smem) {
  float* ts = (float*)smem;
  const int tid = tid_fresh();
  const int tn = N >> 6, ntile = (K >> 6) * tn;
  for (int it = blockIdx.x; it < ntile; it += gridDim.x) {
    const int k0 = (it / tn) * 64, n0 = (it % tn) * 64;
    __syncthreads();
#pragma unroll
    for (int i = 0; i < 4; ++i) {
      const int r = (tid >> 4) + 16 * i, c4 = tid & 15;
      float4 v = *(const float4*)(src + (size_t)(k0 + r) * N + n0 + c4 * 4);
      const float s = scale ? scale[k0 + r] : 1.f;
      float* d = ts + r * 65 + c4 * 4;
      d[0] = v.x * s; d[1] = v.y * s; d[2] = v.z * s; d[3] = v.w * s;
    }
    __syncthreads();
#pragma unroll
    for (int i = 0; i < 2; ++i) {
      const int id = tid + 256 * i, nn = id >> 3, kc = id & 7;
      float f[8];
#pragma unroll
      for (int e = 0; e < 8; ++e) f[e] = ts[(kc * 8 + e) * 65 + nn];
      *(uint4*)(dst + (size_t)(n0 + nn) * K + k0 + kc * 8) = make_uint4(pack2(f[0], f[1]), pack2(f[2], f[3]), pack2(f[4], f[5]), pack2(f[6], f[7]));
    }
  }
}
__device__ __forceinline__ void conv_plain(const float* src, bf16_t* dst, size_t n) {
  const size_t stride = (size_t)gridDim.x * NT * 8;
  for (size_t i = ((size_t)blockIdx.x * NT + tid_fresh()) * 8; i < n; i += stride) {
    const float4 a = *(const float4*)(src + i), b = *(const float4*)(src + i + 4);
    *(uint4*)(dst + i) = make_uint4(pack2(a.x, a.y), pack2(a.z, a.w), pack2(b.x, b.y), pack2(b.z, b.w));
  }
}

__device__ __forceinline__ void final_norm(float* h, const float* g) {
  const int tid = tid_fresh(), wave = tid >> 6, lane = tid & 63;
  for (int row = blockIdx.x * 4 + wave; row < TOK; row += gridDim.x * 4) {
    float* p = h + (size_t)row * 1024;
    float4 v[4]; float s = 0.f;
#pragma unroll
    for (int i = 0; i < 4; ++i) { v[i] = *(const float4*)(p + i * 256 + lane * 4); s += v[i].x * v[i].x + v[i].y * v[i].y + v[i].z * v[i].z + v[i].w * v[i].w; }
#pragma unroll
    for (int o = 32; o > 0; o >>= 1) s += __shfl_xor(s, o);
    const float r = rsqrtf(s * (1.f / 1024.f) + 1e-6f);
#pragma unroll
    for (int i = 0; i < 4; ++i) {
      const float4 gg = *(const float4*)(g + i * 256 + lane * 4);
      *(float4*)(p + i * 256 + lane * 4) = make_float4(v[i].x * r * gg.x, v[i].y * r * gg.y, v[i].z * r * gg.z, v[i].w * r * gg.w);
    }
  }
}


#define XB_TMO      128
#define XB_XCNT(j)  (256  + 64 * (j))
#define XB_XSUB(j)  (1280 + 64 * (j))
#define XB_XGEN(j)  (2304 + 64 * (j))
#define XB_TOP      3328
#define XB_TOPGEN   3392
#define XCD_BAR_WORDS 3456
#define XB_SPIN_CAP (1u << 18)
__device__ __forceinline__ unsigned xb_ld(unsigned* p)              { return __hip_atomic_load(p, __ATOMIC_RELAXED, __HIP_MEMORY_SCOPE_AGENT); }
__device__ __forceinline__ unsigned xb_add(unsigned* p, unsigned v) { return __hip_atomic_fetch_add(p, v, __ATOMIC_RELAXED, __HIP_MEMORY_SCOPE_AGENT); }
__device__ __forceinline__ unsigned xb_xcc_id() { unsigned v; asm volatile("s_getreg_b32 %0, hwreg(HW_REG_XCC_ID, 0, 4)" : "=s"(v)); return v & 0xFu; }
#define XB_SPIN(cond, bar) do { unsigned _sp = 0; while (cond) { __builtin_amdgcn_s_sleep(1); \
    if ((++_sp & 255u) == 0u) { if (xb_ld(&(bar)[XB_TMO])) break; if (_sp > XB_SPIN_CAP) { atomicAdd(&(bar)[XB_TMO], 1u); break; } } } } while (0)
__device__ __forceinline__ void xcd_barrier(unsigned* bar) {
  asm volatile("s_waitcnt vmcnt(0) lgkmcnt(0)" ::: "memory");
  __syncthreads();
  if (tid_fresh() == 0) {
    __builtin_amdgcn_s_waitcnt(0);
    const unsigned x = xb_xcc_id();
    int bi = blockIdx.x; asm volatile("" : "+s"(bi));
    const uint2 census = *(const uint2*)(bar + XCD_BAR_WORDS + 2 * bi);
    const unsigned nloc = census.x, nx = census.y;
    const unsigned old = xb_add(&bar[XB_XSUB(x)], 1u);
    const unsigned gen = old / nloc;
    if (old + 1u == (gen + 1u) * nloc) {
      __builtin_amdgcn_fence(__ATOMIC_RELEASE, "agent");
      asm volatile("s_waitcnt vmcnt(0)" ::: "memory");
      const unsigned og = xb_add(&bar[XB_TOP], 1u);
      const unsigned tg = og / nx;
      if (og + 1u == (tg + 1u) * nx) xb_add(&bar[XB_TOPGEN], 1u);
      else XB_SPIN(xb_ld(&bar[XB_TOPGEN]) == tg, bar);
      __builtin_amdgcn_fence(__ATOMIC_ACQUIRE, "agent");
      xb_add(&bar[XB_XGEN(x)], 1u);
      asm volatile("s_waitcnt vmcnt(0)" ::: "memory");
    } else {
      XB_SPIN(xb_ld(&bar[XB_XGEN(x)]) == gen, bar);
      __builtin_amdgcn_fence(__ATOMIC_ACQUIRE, "agent");
      asm volatile("s_waitcnt vmcnt(0)" ::: "memory");
    }
  }
  __syncthreads();
}

#define GSYNC() do { asm volatile("s_waitcnt vmcnt(0) lgkmcnt(0)" ::: "memory"); grid.sync(); \
    if (tid_fresh() < 64) { __builtin_amdgcn_fence(__ATOMIC_ACQUIRE, "agent"); asm volatile("s_waitcnt vmcnt(0)" ::: "memory"); } \
    __syncthreads(); } while (0)
#define XSYNC() xcd_barrier((unsigned*)WSP(BAR_OFF))
#define WSP(off) (params_fresh()->ws + (off))
#define INP(i) (params_fresh()->in[i])
#define WBP ((bf16_t*)WSP(WB_OFF))
#define HBA ((bf16_t*)WSP(HBA_OFF))
#define SPECP ((float4*)WSP(SPEC_OFF))
#define H3P ((float*)WSP(H3_OFF))
#define TWP ((float2*)WSP(TW_OFF))
#define SLOT(i) ((bf16_t*)WSP(R_OFF + (size_t)(i) * 64 * MiB))
#define HRES (params_fresh()->out)

__global__ void __launch_bounds__(NT, 2) mega(Params Pdummy) {
  __shared__ __attribute__((aligned(16))) unsigned char smem[65536];
  cg::grid_group grid = cg::this_grid();
  if (tid_fresh() == 0) (void)xb_add(&((unsigned*)WSP(BAR_OFF))[XB_XCNT(xb_xcc_id())], 1u);

  for (int j = 0; j < 2; ++j) {
    convT_job(INP(I_EWIN) + (size_t)j * 1024 * 7168, 1024, 7168, WBP + W_EIN + (size_t)j * 7340032, INP(I_NORMG) + (2 * j) * 1024, smem);
    convT_job(INP(I_OWIN) + (size_t)j * 1024 * 6144, 1024, 6144, WBP + W_OIN + (size_t)j * 6291456, INP(I_NORMG) + (2 * j + 1) * 1024, smem);
    convT_job(INP(I_EWOUT) + (size_t)j * 2048 * 1024, 2048, 1024, WBP + W_EOUT + (size_t)j * 2097152, nullptr, smem);
    convT_job(INP(I_OWOUT) + (size_t)j * 2048 * 1024, 2048, 1024, WBP + W_OOUT + (size_t)j * 2097152, nullptr, smem);
    for (int g = 0; g < 4; ++g)
      convT_job(INP(I_POOLW) + (size_t)(j * 4 + g) * 65536, 256, 256, WBP + W_POOL + (size_t)(j * 4 + g) * 65536, nullptr, smem);
  }
  for (int i = 0; i < 4; ++i) {
    convT_job(INP(I_PGATE) + (size_t)i * 1048576, 1024, 1024, WBP + W_PGATE + (size_t)i * 1048576, INP(I_PLEG) + i * 1024, smem);
    convT_job(INP(I_PUP) + (size_t)i * 262144, 256, 1024, WBP + W_PUP + (size_t)i * 262144, nullptr, smem);
  }
  conv_plain(INP(I_GMWS), WBP + W_GMWS, 262144);
  conv_plain(INP(I_X), HBA, (size_t)TOK * 1024);
  hyena_feats(H3P, smem);
  {
    float2* T = TWP;
    for (int k = blockIdx.x * NT + tid_fresh(); k < 4096; k += gridDim.x * NT) {
      float s, c; sincospif((float)k / 4096.f, &s, &c);
      T[k] = make_float2(c, -s);
    }
  }
  if (gridDim.y == 0x7fffu) grid.sync();
  if (tid_fresh() == 0) {
    unsigned* bar = (unsigned*)WSP(BAR_OFF);
    const unsigned x = xb_xcc_id();
    unsigned nloc = 0u, nx = 0u, sum = 0u, sp = 0u;
    for (;;) {
      sum = 0u; nx = 0u; nloc = 0u;
#pragma unroll
      for (unsigned jx = 0; jx < 16; ++jx) { const unsigned c = xb_ld(&bar[XB_XCNT(jx)]); sum += c; nx += (c > 0u) ? 1u : 0u; nloc = (jx == x) ? c : nloc; }
      if (sum == gridDim.x) break;
      __builtin_amdgcn_s_sleep(1);
      if ((++sp & 255u) == 0u) { if (xb_ld(&bar[XB_TMO])) break; if (sp > XB_SPIN_CAP) { atomicAdd(&bar[XB_TMO], 1u); break; } }
    }
    *(uint2*)(bar + XCD_BAR_WORDS + 2 * blockIdx.x) = make_uint2(nloc > 0u ? nloc : 1u, nx > 0u ? nx : 1u);
  }
  XSYNC();
  filtgen_phase(INP(I_HWOUT), 0, H3P, (float*)SLOT(3), smem);
  XSYNC();

#pragma unroll 1
  for (int layer = 0; layer < 4; ++layer) {
    const int j = layer >> 1;
    if ((layer & 1) == 0) {
      spectrum_phase((const float*)SLOT(3), TWP, SPECP, smem);
      inproj_phase(HBA, WBP + W_EIN + (size_t)j * 7340032, 3, 0, 1024, 2048, 0, SLOT(0), SLOT(1), SLOT(2), nullptr, 0, 0, 0, 0, smem);
      XSYNC();
      z_phase(SLOT(1), SLOT(2), INP(I_CONVW) + (size_t)j * 9216, INP(I_CONVB) + (size_t)j * 3072, (float*)SLOT(3), smem);
      XSYNC();
      fftconv_phase((float*)SLOT(3), SPECP, TWP, INP(I_HD) + j * 1024, smem);
      XSYNC();
      ya_phase(SLOT(0), (const float*)SLOT(3), INP(I_CONVW) + (size_t)j * 9216, INP(I_CONVB) + (size_t)j * 3072, SLOT(1), smem);
      XSYNC();
      inproj_phase(HBA, WBP + W_EIN + (size_t)j * 7340032, 2, 4096, 5120, 0, 0, SLOT(0), SLOT(2), nullptr, nullptr, 0, 3, 0, 0, smem, (float*)WSP(PART_OFF));
      XSYNC();
      gmlp_phase(SLOT(0), SLOT(2), WBP + W_GMWS + (size_t)j * 131072, INP(I_GMG) + j * 1024, INP(I_GMBS) + j * 1024, (const float*)WSP(PART_OFF), smem);
      XSYNC();
      inproj_phase(HBA, WBP + W_EIN + (size_t)j * 7340032, 2, 3072, 6144, 0, 0, SLOT(1), SLOT(0), nullptr, nullptr, 2, 2, 0, 0, smem);
      XSYNC();
      outproj_phase(SLOT(1), SLOT(0), WBP + W_EOUT + (size_t)j * 2097152, (layer == 0) ? INP(I_X) : (const float*)HRES, HRES, SLOT(3), smem);
      XSYNC();
      ple_phase(SLOT(3), INP(I_P) + (size_t)layer * TOK * 256, WBP + W_PGATE + (size_t)layer * 1048576, WBP + W_PUP + (size_t)layer * 262144, HRES, HBA, smem);
      XSYNC();
    } else {
      inproj_phase(HBA, WBP + W_OIN + (size_t)j * 6291456, 4, 0, 2048, 3072, 4096, SLOT(0), SLOT(1), SLOT(2), SLOT(3), 0, 0, 0, 1, smem);
      XSYNC();
      pool_phase(SLOT(0), WBP + W_POOL + (size_t)j * 262144, INP(I_POOLB) + j * 1024, INP(I_POOLS) + j * 1024, SLOT(4), smem);
      na_phase(SLOT(1), SLOT(2), SLOT(3), INP(I_RPB) + (size_t)j * 16 * 15 * 31, smem);
      XSYNC();
      inproj_phase(HBA, WBP + W_OIN + (size_t)j * 6291456, 2, 1024, 5120, 0, 0, SLOT(4), SLOT(1), nullptr, nullptr, 2, 2, 0, 0, smem);
      XSYNC();
      outproj_phase(SLOT(4), SLOT(1), WBP + W_OOUT + (size_t)j * 2097152, HRES, HRES, SLOT(2), smem);
      XSYNC();
      ple_phase(SLOT(2), INP(I_P) + (size_t)layer * TOK * 256, WBP + W_PGATE + (size_t)layer * 1048576, WBP + W_PUP + (size_t)layer * 262144, HRES, HBA, smem);
      if (layer == 1) filtgen_phase(INP(I_HWOUT), 1, H3P, (float*)SLOT(3), smem);
      XSYNC();
    }
  }
  final_norm(HRES, INP(I_FINALG));
}

extern "C" void kernel_launch(void* const* d_in, const int* in_sizes, int n_in, void* d_out, int out_size, void* d_ws, size_t ws_size, hipStream_t stream) {
  static int grid_blocks = 0;
  if (grid_blocks == 0) {
    if (n_in != 29 || out_size != TOK * 1024 || ws_size < WS_END) { fprintf(stderr, "kernel_launch: unexpected shapes (n_in %d out %d ws %zu)\n", n_in, out_size, ws_size); grid_blocks = -1; return; }
    int dev = 0, cus = 0, per_cu = 0;
    if (hipGetDevice(&dev) != hipSuccess || hipDeviceGetAttribute(&cus, hipDeviceAttributeMultiprocessorCount, dev) != hipSuccess) { grid_blocks = -1; return; }
    if (hipOccupancyMaxActiveBlocksPerMultiprocessor(&per_cu, (const void*)mega, NT, LDS_BYTES) != hipSuccess || per_cu < 1) { fprintf(stderr, "occupancy query failed\n"); per_cu = 1; }
    if (per_cu > 2) per_cu = 2;
    grid_blocks = cus * per_cu;
  }
  if (grid_blocks < 0) return;
  Params p{};
  for (int i = 0; i < 29; ++i) p.in[i] = (const float*)d_in[i];
  p.out = (float*)d_out; p.ws = (unsigned char*)d_ws;
  if (hipMemsetAsync((unsigned char*)d_ws + BAR_OFF, 0, XCD_BAR_WORDS * sizeof(unsigned), stream) != hipSuccess) { fprintf(stderr, "memset of barrier words failed\n"); return; }
  void* args[] = {&p};
  hipError_t e = hipLaunchCooperativeKernel((const void*)mega, dim3(grid_blocks), dim3(NT), args, LDS_BYTES, stream);
  if (e != hipSuccess) fprintf(stderr, "cooperative launch failed: %s (grid %d)\n", hipGetErrorString(e), grid_blocks);
}
```

```cpp
#include <hip/hip_runtime.h>
#include <hip/hip_cooperative_groups.h>
#include <cstdio>
namespace cg = cooperative_groups;

typedef unsigned short bf16_t;
typedef short bf16x8 __attribute__((ext_vector_type(8)));
typedef short bf16x4 __attribute__((ext_vector_type(4)));
typedef float f32x4 __attribute__((ext_vector_type(4)));

#define NT 256
constexpr int LDS_BYTES = 0;
constexpr size_t MiB = 1u << 20;
constexpr size_t WB_OFF = 0, HBA_OFF = 80 * MiB, SPEC_OFF = 144 * MiB, H3_OFF = 177 * MiB, TW_OFF = 179 * MiB, R_OFF = 180 * MiB, PART_OFF = 500 * MiB, BAR_OFF = 502 * MiB, WS_END = 503 * MiB;
constexpr int TOK = 32768, SEQ = 4096, DM = 1024;
constexpr size_t W_EIN = 0, W_OIN = 14680064, W_EOUT = 27262976, W_OOUT = 31457280, W_PGATE = 35651584, W_PUP = 39845888, W_POOL = 40894464, W_GMWS = 41418752;
constexpr int SPEC_STRIDE = 4104;

struct Params { const float* in[29]; float* out; unsigned char* ws; };
enum { I_X = 0, I_P, I_NORMG, I_FINALG, I_EWIN, I_CONVW, I_CONVB, I_HW0, I_HB0, I_HW1, I_HB1, I_HW2, I_HB2, I_HWOUT, I_HFREQ, I_HD, I_GMG, I_GMWS, I_GMBS, I_EWOUT, I_OWIN, I_POOLW, I_POOLB, I_POOLS, I_RPB, I_OWOUT, I_PUP, I_PGATE, I_PLEG };

__device__ __forceinline__ unsigned short f2bf(float f) { unsigned u = __float_as_uint(f); u += 0x7fffu + ((u >> 16) & 1u); return (unsigned short)(u >> 16); }
__device__ __forceinline__ float bf2f(unsigned short h) { return __uint_as_float(((unsigned)h) << 16); }
__device__ __forceinline__ unsigned pack2(float lo, float hi) { return (unsigned)f2bf(lo) | ((unsigned)f2bf(hi) << 16); }
__device__ __forceinline__ float lo_f(unsigned u) { return __uint_as_float(u << 16); }
__device__ __forceinline__ float hi_f(unsigned u) { return __uint_as_float(u & 0xffff0000u); }
__device__ __forceinline__ float silu_f(float v) { return v / (1.f + __expf(-v)); }
__device__ __forceinline__ float sigmoid_f(float v) { return 1.f / (1.f + __expf(-v)); }
__device__ __forceinline__ void unpack8(const uint4& u, float* f) { f[0] = lo_f(u.x); f[1] = hi_f(u.x); f[2] = lo_f(u.y); f[3] = hi_f(u.y); f[4] = lo_f(u.z); f[5] = hi_f(u.z); f[6] = lo_f(u.w); f[7] = hi_f(u.w); }

typedef const Params __attribute__((address_space(4)))* KP;
__device__ __forceinline__ KP params_fresh() { KP p = (KP)__builtin_amdgcn_kernarg_segment_ptr(); asm volatile("" : "+s"(p)); return p; }
__device__ __forceinline__ int tid_fresh() { int t = threadIdx.x; asm volatile("" : "+v"(t)); return t; }

__device__ __forceinline__ int swz(int row, int kc) { return row * 128 + ((kc ^ ((row >> 1) & 7)) << 4); }

template <int AM, bool SS>
__device__ __forceinline__ void load_a1(int tid, uint4& out, float& ssq, const void* A0, const void* A1, int lda, int row, int k0, int aux) {
  const int kc = tid & 7;
  if (AM == 0) {
    out = *(const uint4*)((const bf16_t*)A0 + (size_t)row * lda + k0 + kc * 8);
  } else if (AM == 2) {
    const bf16_t* src = (k0 < 1024) ? (const bf16_t*)A0 : (const bf16_t*)A1;
    out = *(const uint4*)(src + (size_t)row * lda + (k0 & 1023) + kc * 8);
  } else if (AM == 1) {
    const float* src = (const float*)A0 + (size_t)row * lda + k0 + kc * 8;
    const float4 a = *(const float4*)src, b = *(const float4*)(src + 4);
    out = make_uint4(pack2(a.x, a.y), pack2(a.z, a.w), pack2(b.x, b.y), pack2(b.z, b.w));
  } else {
    const bf16_t* src = (const bf16_t*)A0 + k0 + kc * 8;
    const int half = 1 << aux;
    const int tb = row & (SEQ - 1), base = row - tb;
    const int lo = max(tb - half, 0), hi = min(tb + half, SEQ);
    float s0 = 0.f, s1 = 0.f, s2 = 0.f, s3 = 0.f, s4 = 0.f, s5 = 0.f, s6 = 0.f, s7 = 0.f;
    const int cnt = hi - lo;
    const bf16_t* wp = src + (size_t)(base + lo) * lda;
#pragma unroll 1
    for (int d0 = 0; d0 < cnt; d0 += 8) {
      uint4 wv[8];
#pragma unroll
      for (int d = 0; d < 8; ++d) wv[d] = (d0 + d < cnt) ? *(const uint4*)(wp + (size_t)(d0 + d) * lda) : make_uint4(0u, 0u, 0u, 0u);
#pragma unroll
      for (int d = 0; d < 8; ++d) {
        s0 += lo_f(wv[d].x); s1 += hi_f(wv[d].x); s2 += lo_f(wv[d].y); s3 += hi_f(wv[d].y); s4 += lo_f(wv[d].z); s5 += hi_f(wv[d].z); s6 += lo_f(wv[d].w); s7 += hi_f(wv[d].w);
      }
    }
    const uint4 u = *(const uint4*)(src + (size_t)row * lda);
    const float inv = 1.f / (float)(hi - lo);
    out = make_uint4(pack2(s0 * inv - lo_f(u.x), s1 * inv - hi_f(u.x)), pack2(s2 * inv - lo_f(u.y), s3 * inv - hi_f(u.y)),
                     pack2(s4 * inv - lo_f(u.z), s5 * inv - hi_f(u.z)), pack2(s6 * inv - lo_f(u.w), s7 * inv - hi_f(u.w)));
  }
}
template <int AM, bool SS>
__device__ __forceinline__ void load_a(int tid, uint4& a0, uint4& a1, uint4& a2, uint4& a3, const void* A0, const void* A1, int lda, int m0, int k0, int aux, float (&ss)[4]) {
  const int row = m0 + (tid >> 3);
  load_a1<AM, SS>(tid, a0, ss[0], A0, A1, lda, row, k0, aux);
  load_a1<AM, SS>(tid, a1, ss[1], A0, A1, lda, row + 32, k0, aux);
  load_a1<AM, SS>(tid, a2, ss[2], A0, A1, lda, row + 64, k0, aux);
  load_a1<AM, SS>(tid, a3, ss[3], A0, A1, lda, row + 96, k0, aux);
}
__device__ __forceinline__ void load_b(int tid, uint4& b0, uint4& b1, uint4& b2, uint4& b3, const bf16_t* Bt, int ldb, int n0, int k0) {
  const bf16_t* p = Bt + (size_t)(n0 + (tid >> 3)) * ldb + k0 + (tid & 7) * 8;
  b0 = *(const uint4*)p; b1 = *(const uint4*)(p + (size_t)32 * ldb); b2 = *(const uint4*)(p + (size_t)64 * ldb); b3 = *(const uint4*)(p + (size_t)96 * ldb);
}
__device__ __forceinline__ void store_tile(int tid, unsigned char* dst, const uint4& r0v, const uint4& r1v, const uint4& r2v, const uint4& r3v) {
  const int r0 = tid >> 3, kc = tid & 7;
  *(uint4*)(dst + swz(r0, kc)) = r0v; *(uint4*)(dst + swz(r0 + 32, kc)) = r1v; *(uint4*)(dst + swz(r0 + 64, kc)) = r2v; *(uint4*)(dst + swz(r0 + 96, kc)) = r3v;
}

__device__ __forceinline__ float ssq8(const uint4& v) {
  const float f0 = lo_f(v.x), f1 = hi_f(v.x), f2 = lo_f(v.y), f3 = hi_f(v.y), f4 = lo_f(v.z), f5 = hi_f(v.z), f6 = lo_f(v.w), f7 = hi_f(v.w);
  return f0 * f0 + f1 * f1 + f2 * f2 + f3 * f3 + f4 * f4 + f5 * f5 + f6 * f6 + f7 * f7;
}
template <bool SS>
__device__ __forceinline__ void store_a(int tid, unsigned char* dst, const uint4& a0, const uint4& a1, const uint4& a2, const uint4& a3, float (&ss)[4]) {
  if (SS) { ss[0] += ssq8(a0); ss[1] += ssq8(a1); ss[2] += ssq8(a2); ss[3] += ssq8(a3); }
  store_tile(tid, dst, a0, a1, a2, a3);
}
template <bool SWAP>
__device__ __forceinline__ void mma_tile(f32x4 (&acc)[4][4], const unsigned char* cur, int wr, int wc, int fr, int fq) {
#pragma unroll
  for (int s = 0; s < 2; ++s) {
    bf16x8 af[4], bfr[4];
#pragma unroll
    for (int m = 0; m < 4; ++m) af[m] = *(const bf16x8*)(cur + swz(wr * 64 + m * 16 + fr, s * 4 + fq));
#pragma unroll
    for (int n = 0; n < 4; ++n) bfr[n] = *(const bf16x8*)(cur + 16384 + swz(wc * 64 + n * 16 + fr, s * 4 + fq));
#pragma unroll
    for (int m = 0; m < 4; ++m)
#pragma unroll
      for (int n = 0; n < 4; ++n)
        acc[m][n] = SWAP ? __builtin_amdgcn_mfma_f32_16x16x32_bf16(bfr[n], af[m], acc[m][n], 0, 0, 0)
                         : __builtin_amdgcn_mfma_f32_16x16x32_bf16(af[m], bfr[n], acc[m][n], 0, 0, 0);
  }
}
template <int AM, bool SS, bool SWAP>
__device__ __forceinline__ void gemm_mainloop(f32x4 (&acc)[4][4], const void* A0, const void* A1, int lda, const bf16_t* Bt, int ldb,
                                              int m0, int n0, int K, int aux, unsigned char* smem, float (&ss)[4], int rot) {
  const int tid = tid_fresh(), wid = tid >> 6, lane = tid & 63, wr = wid >> 1, wc = wid & 1, fr = lane & 15, fq = lane >> 4;
  const int nk = K >> 6, km = nk - 1;
  unsigned char* L0 = smem;
  unsigned char* L1 = smem + 32768;
  uint4 a0, a1, a2, a3, b0, b1, b2, b3;
  __syncthreads();
  if (AM == 0 || AM == 2) {
    uint4 c0, c1, c2, c3, d0, d1, d2, d3;
    load_a<AM, SS>(tid, a0, a1, a2, a3, A0, A1, lda, m0, (rot & km) << 6, aux, ss);
    load_b(tid, b0, b1, b2, b3, Bt, ldb, n0, (rot & km) << 6);
    load_a<AM, SS>(tid, c0, c1, c2, c3, A0, A1, lda, m0, ((1 + rot) & km) << 6, aux, ss);
    load_b(tid, d0, d1, d2, d3, Bt, ldb, n0, ((1 + rot) & km) << 6);
    store_a<SS>(tid, L0, a0, a1, a2, a3, ss); store_tile(tid, L0 + 16384, b0, b1, b2, b3);
    __syncthreads();
#define SGB_PIPE() do { __builtin_amdgcn_sched_group_barrier(0x100, 8, 0); \
      _Pragma("unroll") for (int q_ = 0; q_ < 8; ++q_) { __builtin_amdgcn_sched_group_barrier(0x008, 1, 0); __builtin_amdgcn_sched_group_barrier(0x020, 1, 0); __builtin_amdgcn_sched_group_barrier(0x008, 1, 0); __builtin_amdgcn_sched_group_barrier(0x100, 1, 0); } \
      _Pragma("unroll") for (int q_ = 0; q_ < 8; ++q_) { __builtin_amdgcn_sched_group_barrier(0x008, 1, 0); __builtin_amdgcn_sched_group_barrier(0x200, 1, 0); __builtin_amdgcn_sched_group_barrier(0x008, 1, 0); } } while (0)
    for (int kt = 0; kt < nk; kt += 2) {
      const int k2 = ((min(kt + 2, km) + rot) & km) << 6, k3 = ((min(kt + 3, km) + rot) & km) << 6;
      load_a<AM, SS>(tid, a0, a1, a2, a3, A0, A1, lda, m0, k2, aux, ss); load_b(tid, b0, b1, b2, b3, Bt, ldb, n0, k2);
      mma_tile<SWAP>(acc, L0, wr, wc, fr, fq);
      store_a<SS>(tid, L1, c0, c1, c2, c3, ss); store_tile(tid, L1 + 16384, d0, d1, d2, d3);
      SGB_PIPE();
      __syncthreads();
      load_a<AM, SS>(tid, c0, c1, c2, c3, A0, A1, lda, m0, k3, aux, ss); load_b(tid, d0, d1, d2, d3, Bt, ldb, n0, k3);
      mma_tile<SWAP>(acc, L1, wr, wc, fr, fq);
      if (SS) { if (kt + 2 < nk) { ss[0] += ssq8(a0); ss[1] += ssq8(a1); ss[2] += ssq8(a2); ss[3] += ssq8(a3); } }
      store_tile(tid, L0, a0, a1, a2, a3); store_tile(tid, L0 + 16384, b0, b1, b2, b3);
      SGB_PIPE();
      __syncthreads();
    }
#undef SGB_PIPE
    asm volatile("s_waitcnt vmcnt(0)" ::: "memory");
  } else {
    load_a<AM, SS>(tid, a0, a1, a2, a3, A0, A1, lda, m0, (rot & km) << 6, aux, ss);
    load_b(tid, b0, b1, b2, b3, Bt, ldb, n0, (rot & km) << 6);
    store_a<SS>(tid, L0, a0, a1, a2, a3, ss); store_tile(tid, L0 + 16384, b0, b1, b2, b3);
    __syncthreads();
    for (int kt = 0; kt < nk; ++kt) {
      unsigned char* cur = smem + (kt & 1) * 32768;
      unsigned char* nxt = smem + ((kt + 1) & 1) * 32768;
      const bool more = (kt + 1 < nk);
      if (more) { load_a<AM, SS>(tid, a0, a1, a2, a3, A0, A1, lda, m0, ((kt + 1 + rot) & km) << 6, aux, ss); load_b(tid, b0, b1, b2, b3, Bt, ldb, n0, ((kt + 1 + rot) & km) << 6); }
      mma_tile<SWAP>(acc, cur, wr, wc, fr, fq);
      if (more) { store_a<SS>(tid, nxt, a0, a1, a2, a3, ss); store_tile(tid, nxt + 16384, b0, b1, b2, b3); }
      __syncthreads();
    }
  }
}
__device__ __forceinline__ void finish_rstd(float (&ss)[4], unsigned char* smem) {
  const int tid = tid_fresh(), r0 = tid >> 3, kc = tid & 7;
  float* rs = (float*)smem;
#pragma unroll
  for (int i = 0; i < 4; ++i) {
    float v = ss[i];
    v += __shfl_xor(v, 1); v += __shfl_xor(v, 2); v += __shfl_xor(v, 4);
    if (kc == 0) rs[r0 + 32 * i] = rsqrtf(v * (1.f / 1024.f) + 1e-6f);
  }
  __syncthreads();
}
__device__ __forceinline__ void zero_acc(f32x4 (&acc)[4][4]) {
#pragma unroll
  for (int m = 0; m < 4; ++m)
#pragma unroll
    for (int n = 0; n < 4; ++n) acc[m][n] = (f32x4){0.f, 0.f, 0.f, 0.f};
}

__device__ __forceinline__ bool tile_pick(int i, int nNt, int& mt, int& nt, int& L) {
  const int b = blockIdx.x;
  L = i * (int)gridDim.x + (b & 7) * ((int)gridDim.x >> 3) + (b >> 3);
  if (L >= 256 * nNt) return false;
  const int band = L / (8 * nNt), r = L - band * (8 * nNt), c = r >> 6, w = r & 63;
  mt = band * 8 + (w & 7); nt = c * 8 + (w >> 3);
  return true;
}

__device__ __forceinline__ void inproj_phase(const bf16_t* hb, const bf16_t* W, int ng, int wr0, int wr1, int wr2, int wr3,
                             bf16_t* d0, bf16_t* d1, bf16_t* d2, bf16_t* d3, int md0, int md1, int md2, int md3, unsigned char* smem, float* part = nullptr) {
  const int tid = tid_fresh(), wid = tid >> 6, lane = tid & 63, wr = wid >> 1, wc = wid & 1, fr = lane & 15, fq = lane >> 4;
  for (int i = 0;; ++i) {
    int mt, ntg, t;
    if (!tile_pick(i, ng * 8, mt, ntg, t)) break;
    const int grp = ntg >> 3, nt = ntg & 7;
    const int wrow = grp == 0 ? wr0 : grp == 1 ? wr1 : grp == 2 ? wr2 : wr3;
    bf16_t* dst = grp == 0 ? d0 : grp == 1 ? d1 : grp == 2 ? d2 : d3;
    const int mode = grp == 0 ? md0 : grp == 1 ? md1 : grp == 2 ? md2 : md3;
    const int m0 = mt * 128, n0 = nt * 128;
    f32x4 acc[4][4]; zero_acc(acc);
    float ss[4] = {0.f, 0.f, 0.f, 0.f};
    if (mode == 1) {
      gemm_mainloop<0, true, false>(acc, hb, nullptr, 1024, W + (size_t)wrow * 1024, 1024, m0, n0, 1024, 0, smem, ss, 0);
      finish_rstd(ss, smem);
      const float* rs = (const float*)smem;
#pragma unroll
      for (int m = 0; m < 4; ++m) {
        const int rl = wr * 64 + m * 16 + fq * 4;
        const float r0 = rs[rl], r1 = rs[rl + 1], r2 = rs[rl + 2], r3 = rs[rl + 3];
#pragma unroll
        for (int n = 0; n < 4; ++n) {
          const int col = n0 + wc * 64 + n * 16 + fr;
          uint2 o; o.x = pack2(acc[m][n][0] * r0, acc[m][n][1] * r1); o.y = pack2(acc[m][n][2] * r2, acc[m][n][3] * r3);
          *(uint2*)(dst + (size_t)col * TOK + m0 + rl) = o;
        }
      }
    } else {
      gemm_mainloop<0, true, true>(acc, hb, nullptr, 1024, W + (size_t)wrow * 1024, 1024, m0, n0, 1024, 0, smem, ss, 0);
      finish_rstd(ss, smem);
      const float* rs = (const float*)smem;
      uint2 old[4][4];
      if (mode == 2) {
#pragma unroll
        for (int m = 0; m < 4; ++m)
#pragma unroll
          for (int n = 0; n < 4; ++n) old[m][n] = *(const uint2*)(dst + (size_t)(m0 + wr * 64 + m * 16 + fr) * 1024 + n0 + wc * 64 + n * 16 + fq * 4);
      }
#pragma unroll
      for (int m = 0; m < 4; ++m) {
        const int rl = wr * 64 + m * 16 + fr;
        const float r = rs[rl];
        float psq = 0.f;
#pragma unroll
        for (int n = 0; n < 4; ++n) {
          const int col = n0 + wc * 64 + n * 16 + fq * 4;
          bf16_t* pd = dst + (size_t)(m0 + rl) * 1024 + col;
          float v0 = acc[m][n][0] * r, v1 = acc[m][n][1] * r, v2 = acc[m][n][2] * r, v3 = acc[m][n][3] * r;
          if (mode == 2) {
            v0 = lo_f(old[m][n].x) * silu_f(v0); v1 = hi_f(old[m][n].x) * silu_f(v1); v2 = lo_f(old[m][n].y) * silu_f(v2); v3 = hi_f(old[m][n].y) * silu_f(v3);
          }
          uint2 o; o.x = pack2(v0, v1); o.y = pack2(v2, v3);
          *(uint2*)pd = o;
          if (mode == 3) psq += v0 * v0 + v1 * v1 + v2 * v2 + v3 * v3;
        }
        if (mode == 3) {
          psq += __shfl_xor(psq, 16); psq += __shfl_xor(psq, 32);
          if (fq == 0) part[(size_t)(m0 + rl) * 16 + nt * 2 + wc] = psq;
        }
      }
    }
  }
}

__device__ __forceinline__ void outproj_phase(const bf16_t* MA, const bf16_t* MB, const bf16_t* Wt  , const float* hsrc, float* hres, bf16_t* hbB, unsigned char* smem) {
  const int tid = tid_fresh(), wid = tid >> 6, lane = tid & 63, wr = wid >> 1, wc = wid & 1, fr = lane & 15, fq = lane >> 4;
  for (int i = 0;; ++i) {
    int mt, nt, t;
    if (!tile_pick(i, 8, mt, nt, t)) break;
    const int m0 = mt * 128, n0 = nt * 128;
    f32x4 acc[4][4]; zero_acc(acc);
    float ss[4] = {0.f, 0.f, 0.f, 0.f};
    gemm_mainloop<2, false, true>(acc, MA, MB, 1024, Wt, 2048, m0, n0, 2048, 0, smem, ss, 0);
#pragma unroll
    for (int m = 0; m < 4; ++m) {
      const int row = m0 + wr * 64 + m * 16 + fr;
      const size_t idx = (size_t)row * 1024 + n0 + wc * 64 + fq * 4;
      float4 h[4];
#pragma unroll
      for (int n = 0; n < 4; ++n) h[n] = *(const float4*)(hsrc + idx + n * 16);
#pragma unroll
      for (int n = 0; n < 4; ++n) {
        const float4 o = make_float4(h[n].x + acc[m][n][0], h[n].y + acc[m][n][1], h[n].z + acc[m][n][2], h[n].w + acc[m][n][3]);
        *(float4*)(hres + idx + n * 16) = o;
        uint2 ob; ob.x = pack2(o.x, o.y); ob.y = pack2(o.z, o.w);
        *(uint2*)(hbB + idx + n * 16) = ob;
      }
    }
  }
}

__device__ __forceinline__ void ple_phase(const bf16_t* hbB, const float* pin  , const bf16_t* Wg  , const bf16_t* Wup  ,
                          float* hres, bf16_t* hbA, unsigned char* smem) {
  const int tid = tid_fresh(), wid = tid >> 6, lane = tid & 63, wr = wid >> 1, wc = wid & 1, fr = lane & 15, fq = lane >> 4;
  for (int i = 0;; ++i) {
    int mt, nt, t;
    if (!tile_pick(i, 8, mt, nt, t)) break;
    const int m0 = mt * 128, n0 = nt * 128;
    f32x4 ag[4][4]; zero_acc(ag);
    float ss[4] = {0.f, 0.f, 0.f, 0.f};
    gemm_mainloop<0, true, true>(ag, hbB, nullptr, 1024, Wg, 1024, m0, n0, 1024, 0, smem, ss, 0);
    finish_rstd(ss, smem);
    unsigned gp[4][4][2];
    {
      const float* rs = (const float*)smem;
#pragma unroll
      for (int m = 0; m < 4; ++m) {
        const float r = rs[wr * 64 + m * 16 + fr];
#pragma unroll
        for (int n = 0; n < 4; ++n) {
          gp[m][n][0] = pack2(sigmoid_f(r * ag[m][n][0]), sigmoid_f(r * ag[m][n][1]));
          gp[m][n][1] = pack2(sigmoid_f(r * ag[m][n][2]), sigmoid_f(r * ag[m][n][3]));
        }
      }
    }
    zero_acc(ag);
    float ss2[4] = {0.f, 0.f, 0.f, 0.f};
    gemm_mainloop<1, false, true>(ag, pin, nullptr, 256, Wup, 256, m0, n0, 256, 0, smem, ss2, 0);
#pragma unroll
    for (int m = 0; m < 4; ++m) {
      const int rl = wr * 64 + m * 16 + fr;
      const size_t idx = (size_t)(m0 + rl) * 1024 + n0 + wc * 64 + fq * 4;
      float4 h[4];
#pragma unroll
      for (int n = 0; n < 4; ++n) h[n] = *(const float4*)(hres + idx + n * 16);
#pragma unroll
      for (int n = 0; n < 4; ++n) {
        float4 o;
        o.x = h[n].x + ag[m][n][0] * lo_f(gp[m][n][0]);
        o.y = h[n].y + ag[m][n][1] * hi_f(gp[m][n][0]);
        o.z = h[n].z + ag[m][n][2] * lo_f(gp[m][n][1]);
        o.w = h[n].w + ag[m][n][3] * hi_f(gp[m][n][1]);
        *(float4*)(hres + idx + n * 16) = o;
        uint2 ob; ob.x = pack2(o.x, o.y); ob.y = pack2(o.z, o.w);
        *(uint2*)(hbA + idx + n * 16) = ob;
      }
    }
  }
}

__device__ __forceinline__ void pool_phase(const bf16_t* XC, const bf16_t* Wp  , const float* pb, const float* ps, bf16_t* MC, unsigned char* smem) {
  const int tid = tid_fresh(), wid = tid >> 6, lane = tid & 63, wr = wid >> 1, wc = wid & 1, fr = lane & 15, fq = lane >> 4;
  unsigned char* sA = smem;
  unsigned char* sB = smem + 16384;
  unsigned char* sXs = smem + 32768;
  for (int t = blockIdx.x; t < 2048; t += gridDim.x) {
    const int mt = t >> 3, g = (t >> 1) & 3, nt = t & 1, m0 = mt * 128, n0 = nt * 128;
    const int half = 1 << g;
    const int tb0 = m0 & (SEQ - 1);
    const bf16_t* Bt = Wp + (size_t)g * 65536;
    f32x4 acc[4][4]; zero_acc(acc);
    uint4 xr[5], b0, b1, b2, b3;
#pragma unroll
    for (int i = 0; i < 5; ++i) {
      const int id = tid + 256 * i, row = id >> 3, kc = id & 7, tb = tb0 - 8 + row;
      xr[i] = (id < 1152 && tb >= 0 && tb < SEQ) ? *(const uint4*)(XC + (size_t)(m0 - 8 + row) * 1024 + g * 256 + kc * 8) : make_uint4(0u, 0u, 0u, 0u);
    }
    load_b(tid, b0, b1, b2, b3, Bt, 256, n0, 0);
    __syncthreads();
#pragma unroll 1
    for (int ks = 0; ks < 4; ++ks) {
#pragma unroll
      for (int i = 0; i < 5; ++i) { const int id = tid + 256 * i; if (id < 1152) *(uint4*)(sXs + id * 16) = xr[i]; }
      store_tile(tid, sB, b0, b1, b2, b3);
      __syncthreads();
      if (ks < 3) {
        const int k1 = (ks + 1) * 64;
#pragma unroll
        for (int i = 0; i < 5; ++i) {
          const int id = tid + 256 * i, row = id >> 3, kc = id & 7, tb = tb0 - 8 + row;
          xr[i] = (id < 1152 && tb >= 0 && tb < SEQ) ? *(const uint4*)(XC + (size_t)(m0 - 8 + row) * 1024 + g * 256 + k1 + kc * 8) : make_uint4(0u, 0u, 0u, 0u);
        }
        load_b(tid, b0, b1, b2, b3, Bt, 256, n0, k1);
      }
#pragma unroll
      for (int i = 0; i < 4; ++i) {
        const int row = (tid >> 3) + 32 * i, kc = tid & 7, tb = tb0 + row;
        const int lo = max(tb - half, 0), hi = min(tb + half, SEQ);
        float s0 = 0.f, s1 = 0.f, s2 = 0.f, s3 = 0.f, s4 = 0.f, s5 = 0.f, s6 = 0.f, s7 = 0.f;
        for (int tt = lo; tt < hi; ++tt) {
          const uint4 u = *(const uint4*)(sXs + (tt - tb0 + 8) * 128 + kc * 16);
          s0 += lo_f(u.x); s1 += hi_f(u.x); s2 += lo_f(u.y); s3 += hi_f(u.y); s4 += lo_f(u.z); s5 += hi_f(u.z); s6 += lo_f(u.w); s7 += hi_f(u.w);
        }
        const uint4 u = *(const uint4*)(sXs + (row + 8) * 128 + kc * 16);
        const float inv = 1.f / (float)(hi - lo);
        *(uint4*)(sA + swz(row, kc)) = make_uint4(pack2(s0 * inv - lo_f(u.x), s1 * inv - hi_f(u.x)), pack2(s2 * inv - lo_f(u.y), s3 * inv - hi_f(u.y)),
                                                  pack2(s4 * inv - lo_f(u.z), s5 * inv - hi_f(u.z)), pack2(s6 * inv - lo_f(u.w), s7 * inv - hi_f(u.w)));
      }
      __syncthreads();
      mma_tile<true>(acc, smem, wr, wc, fr, fq);
      __syncthreads();
    }
#pragma unroll
    for (int m = 0; m < 4; ++m) {
      const int row = m0 + wr * 64 + m * 16 + fr;
#pragma unroll
      for (int n = 0; n < 4; ++n) {
        const int col = g * 256 + n0 + wc * 64 + n * 16 + fq * 4;
        const float4 b = *(const float4*)(pb + col), sc = *(const float4*)(ps + col);
        uint2 o; o.x = pack2((acc[m][n][0] + b.x) * sc.x, (acc[m][n][1] + b.y) * sc.y); o.y = pack2((acc[m][n][2] + b.z) * sc.z, (acc[m][n][3] + b.w) * sc.w);
        *(uint2*)(MC + (size_t)row * 1024 + col) = o;
      }
    }
  }
}

__device__ __forceinline__ void gmlp_phase(bf16_t* UB, const bf16_t* VB, const bf16_t* Ws  , const float* gmg, const float* gbs  , const float* part, unsigned char* smem) {
  const int tid = tid_fresh(), wid = tid >> 6, lane = tid & 63, wr = wid >> 1, wc = wid & 1, fr = lane & 15, fq = lane >> 4;
  unsigned char* sW = smem;
  unsigned char* sX = smem + 32768;
  for (int it = blockIdx.x; it < 2048; it += gridDim.x) {
    const int g = it & 7, tok0 = (it >> 3) * 128;
    __syncthreads();
#pragma unroll 2
    for (int i = 0; i < 8; ++i) {
      const int id = tid + 256 * i, row = id >> 4, kc = id & 15;
      *(uint4*)(sW + row * 256 + ((kc ^ (row & 15)) << 4)) = *(const uint4*)(Ws + (size_t)g * 16384 + row * 128 + kc * 8);
    }
    float rq;
    {
      const float4* pp = (const float4*)(part + (size_t)(tok0 + (tid & 127)) * 16);
      const float4 p0 = pp[0], p1 = pp[1], p2 = pp[2], p3 = pp[3];
      const float sq = (p0.x + p0.y + p0.z + p0.w) + (p1.x + p1.y + p1.z + p1.w) + (p2.x + p2.y + p2.z + p2.w) + (p3.x + p3.y + p3.z + p3.w);
      rq = rsqrtf(sq * (1.f / 1024.f) + 1e-6f);
    }
    __syncthreads();
#pragma unroll 2
    for (int i = 0; i < 8; ++i) {
      const int id = tid + 256 * i, q = id & 127, cc = id >> 7;
      float f[8]; unpack8(*(const uint4*)(VB + (size_t)(tok0 + q) * 1024 + g * 128 + cc * 8), f);
#pragma unroll
      for (int e = 0; e < 8; ++e) {
        const int c = cc * 8 + e;
        const float v = f[e] * rq * gmg[g * 128 + c];
        *(bf16_t*)(sX + c * 256 + (((q >> 3) ^ (c & 15)) << 4) + (q & 7) * 2) = f2bf(v);
      }
    }
    __syncthreads();
    f32x4 acc[4][4]; zero_acc(acc);
#pragma unroll
    for (int s = 0; s < 4; ++s) {
      bf16x8 af[4], bfr[4];
#pragma unroll
      for (int m = 0; m < 4; ++m) { const int row = wr * 64 + m * 16 + fr; af[m] = *(const bf16x8*)(sW + row * 256 + (((s * 4 + fq) ^ (row & 15)) << 4)); }
#pragma unroll
      for (int n = 0; n < 4; ++n) { const int row = wc * 64 + n * 16 + fr; bfr[n] = *(const bf16x8*)(sX + row * 256 + (((s * 4 + fq) ^ (row & 15)) << 4)); }
#pragma unroll
      for (int m = 0; m < 4; ++m)
#pragma unroll
        for (int n = 0; n < 4; ++n) acc[m][n] = __builtin_amdgcn_mfma_f32_16x16x32_bf16(bfr[n], af[m], acc[m][n], 0, 0, 0);
    }
    uint2 uo[4][4];
#pragma unroll
    for (int m = 0; m < 4; ++m)
#pragma unroll
      for (int n = 0; n < 4; ++n) uo[m][n] = *(const uint2*)(UB + (size_t)(tok0 + wr * 64 + m * 16 + fr) * 1024 + g * 128 + wc * 64 + n * 16 + fq * 4);
#pragma unroll
    for (int m = 0; m < 4; ++m) {
      const int p = wr * 64 + m * 16 + fr;
      const float bias = gbs[g * 128 + p];
#pragma unroll
      for (int n = 0; n < 4; ++n) {
        const int c = wc * 64 + n * 16 + fq * 4;
        bf16_t* pd = UB + (size_t)(tok0 + p) * 1024 + g * 128 + c;
        const uint2 u = uo[m][n];
        uint2 o; o.x = pack2(lo_f(u.x) * (acc[m][n][0] + bias), hi_f(u.x) * (acc[m][n][1] + bias));
        o.y = pack2(lo_f(u.y) * (acc[m][n][2] + bias), hi_f(u.y) * (acc[m][n][3] + bias));
        *(uint2*)pd = o;
      }
    }
  }
}

__device__ __forceinline__ void na_phase(bf16_t* Q, const bf16_t* Kb, const bf16_t* Vt, const float* rpb, unsigned char* smem) {
  const int tid = tid_fresh(), wq = tid >> 6, lane = tid & 63, fr = lane & 15, fq = lane >> 4;
  for (int it = blockIdx.x; it < 8 * 64 * 16; it += gridDim.x) {
    const int h = it & 15, r = (it >> 4) & 63, b = it >> 10;
    const int rs = min(max(r - 4, 0), 56);
    const int w0 = (wq == 0) ? 0 : (wq == 1) ? 8 : (wq == 2) ? 24 : 32;
    const int qc = wq * 16 + fr;
    const int tokq = b * 4096 + r * 64 + qc;
    const bf16x8 qf0 = *(const bf16x8*)(Q + (size_t)tokq * 1024 + h * 64 + fq * 8);
    const bf16x8 qf1 = *(const bf16x8*)(Q + (size_t)tokq * 1024 + h * 64 + 32 + fq * 8);
    const int cs = min(max(qc - 8, 0), 48);
    const float* rp = rpb + h * (15 * 31);
    const size_t tok0 = (size_t)b * 4096 + rs * 64;
    __syncthreads();
#pragma unroll 1
    for (int i0 = 0; i0 < 16; i0 += 16) {
      uint4 kv[16];
#pragma unroll
      for (int i = 0; i < 16; ++i) {
        const int id = tid + 256 * (i0 + i), key = id >> 3, kc = id & 7;
        kv[i] = *(const uint4*)(Kb + (tok0 + key) * 1024 + h * 64 + kc * 8);
      }
#pragma unroll
      for (int i = 0; i < 16; ++i) {
        const int id = tid + 256 * (i0 + i), key = id >> 3, kc = id & 7;
        *(uint4*)(smem + key * 128 + ((kc ^ ((key >> 1) & 7)) << 4)) = kv[i];
      }
    }
    __syncthreads();
    uint4 vvA[4];
#pragma unroll
    for (int i = 0; i < 4; ++i) {
      const int id = tid + 256 * i, d = id >> 6, c16 = id & 63;
      vvA[i] = *(const uint4*)(Vt + (size_t)(h * 64 + d) * TOK + tok0 + c16 * 8);
    }
    f32x4 sc[8][2];
    float mx = -1e30f;
#pragma unroll
    for (int jr = 0; jr < 8; ++jr) {
#pragma unroll
      for (int hc = 0; hc < 2; ++hc) {
        const int key = jr * 64 + w0 + 8 * (fr >> 2) + 4 * hc + (fr & 3);
        const unsigned char* kp = smem + key * 128;
        const int kx = (key >> 1) & 7;
        const bf16x8 kf0 = *(const bf16x8*)(kp + ((fq ^ kx) << 4));
        const bf16x8 kf1 = *(const bf16x8*)(kp + (((4 + fq) ^ kx) << 4));
        f32x4 a = (f32x4){0.f, 0.f, 0.f, 0.f};
        a = __builtin_amdgcn_mfma_f32_16x16x32_bf16(kf0, qf0, a, 0, 0, 0);
        a = __builtin_amdgcn_mfma_f32_16x16x32_bf16(kf1, qf1, a, 0, 0, 0);
        const int dr = rs + jr - r + 7;
#pragma unroll
        for (int e = 0; e < 4; ++e) {
          const int kcol = w0 + 8 * fq + 4 * hc + e;
          const bool valid = (kcol >= cs) && (kcol < cs + 16);
          const int dc = min(max(kcol - qc + 15, 0), 30);
          const float v = valid ? (a[e] * 0.125f + rp[dr * 31 + dc]) : -1e30f;
          a[e] = v; mx = fmaxf(mx, v);
        }
        sc[jr][hc] = a;
      }
    }
    mx = fmaxf(mx, __shfl_xor(mx, 16)); mx = fmaxf(mx, __shfl_xor(mx, 32));
    float sum = 0.f;
#pragma unroll
    for (int jr = 0; jr < 8; ++jr)
#pragma unroll
      for (int hc = 0; hc < 2; ++hc)
#pragma unroll
        for (int e = 0; e < 4; ++e) { const float pv = (sc[jr][hc][e] > -1e29f) ? __expf(sc[jr][hc][e] - mx) : 0.f; sc[jr][hc][e] = pv; sum += pv; }
    sum += __shfl_xor(sum, 16); sum += __shfl_xor(sum, 32);
    const float inv = 1.f / sum;
    __syncthreads();
    {
#pragma unroll
      for (int i = 0; i < 4; ++i) {
        const int id = tid + 256 * i, d = id >> 6, c16 = id & 63;
        *(uint4*)(smem + d * 1024 + ((c16 ^ (d & 15)) << 4)) = vvA[i];
      }
#pragma unroll 1
      for (int i0 = 4; i0 < 16; i0 += 6) {
        uint4 vvB[6];
#pragma unroll
        for (int i = 0; i < 6; ++i) {
          const int id = tid + 256 * (i0 + i), d = id >> 6, c16 = id & 63;
          vvB[i] = *(const uint4*)(Vt + (size_t)(h * 64 + d) * TOK + tok0 + c16 * 8);
        }
#pragma unroll
        for (int i = 0; i < 6; ++i) {
          const int id = tid + 256 * (i0 + i), d = id >> 6, c16 = id & 63;
          *(uint4*)(smem + d * 1024 + ((c16 ^ (d & 15)) << 4)) = vvB[i];
        }
      }
    }
    __syncthreads();
    f32x4 o[4];
#pragma unroll
    for (int dt = 0; dt < 4; ++dt) o[dt] = (f32x4){0.f, 0.f, 0.f, 0.f};
#pragma unroll
    for (int jr = 0; jr < 8; ++jr) {
      union { bf16x8 v; unsigned u[4]; } pf;
      pf.u[0] = pack2(sc[jr][0][0] * inv, sc[jr][0][1] * inv); pf.u[1] = pack2(sc[jr][0][2] * inv, sc[jr][0][3] * inv);
      pf.u[2] = pack2(sc[jr][1][0] * inv, sc[jr][1][1] * inv); pf.u[3] = pack2(sc[jr][1][2] * inv, sc[jr][1][3] * inv);
      const int c16 = jr * 8 + (w0 >> 3) + fq;
#pragma unroll
      for (int dt = 0; dt < 4; ++dt) {
        const int d = dt * 16 + fr;
        const bf16x8 vf = *(const bf16x8*)(smem + d * 1024 + ((c16 ^ (d & 15)) << 4));
        o[dt] = __builtin_amdgcn_mfma_f32_16x16x32_bf16(vf, pf.v, o[dt], 0, 0, 0);
      }
    }
#pragma unroll
    for (int dt = 0; dt < 4; ++dt) {
      uint2 ob; ob.x = pack2(o[dt][0], o[dt][1]); ob.y = pack2(o[dt][2], o[dt][3]);
      *(uint2*)(Q + (size_t)tokq * 1024 + h * 64 + dt * 16 + fq * 4) = ob;
    }
  }
}

__device__ __forceinline__ float2 cmul(float2 a, float2 b) { return make_float2(a.x * b.x - a.y * b.y, a.x * b.y + a.y * b.x); }
__device__ __forceinline__ float2 cadd(float2 a, float2 b) { return make_float2(a.x + b.x, a.y + b.y); }
__device__ __forceinline__ float2 csub(float2 a, float2 b) { return make_float2(a.x - b.x, a.y - b.y); }

template <bool DIF>
__device__ __forceinline__ void bfly(float2& a, float2& b, float2 w) {
  if (DIF) { const float2 s = cadd(a, b), d = csub(a, b); a = s; b = cmul(d, w); }
  else { const float2 t = cmul(b, w); const float2 s = cadd(a, t), d = csub(a, t); a = s; b = d; }
}
#define PH(i) ((i) ^ (((i) >> 4) & 7))
template <bool DIF, int HALF = 0>
__device__ __forceinline__ void fft_r8(float2* buf, const float2* __restrict__ T, int lq) {
  const int q = 1 << lq, sA = 1024 >> lq;
  for (int g = tid_fresh(); g < 1024; g += NT) {
    const int j0 = g & (q - 1), i0 = ((g >> lq) << (lq + 3)) + j0;
    float2 x[8];
#pragma unroll
    for (int p = 0; p < 8; ++p) x[p] = (HALF == 1 && p >= 4) ? make_float2(0.f, 0.f) : buf[PH(i0 + p * q)];
    const float2 w1 = T[j0 * sA];
    const float2 w2 = cmul(w1, w1), w4 = cmul(w2, w2);
    const float cs8 = 0.70710678118654752f;
    const float2 tA1 = make_float2(cs8 * (w1.x + w1.y), cs8 * (w1.y - w1.x));
    const float2 tA2 = make_float2(w1.y, -w1.x);
    const float2 tA3 = make_float2(cs8 * (w1.y - w1.x), -cs8 * (w1.x + w1.y));
    const float2 tB1 = make_float2(w2.y, -w2.x);
    if (DIF) {
      bfly<true>(x[0], x[4], w1); bfly<true>(x[1], x[5], tA1); bfly<true>(x[2], x[6], tA2); bfly<true>(x[3], x[7], tA3);
      bfly<true>(x[0], x[2], w2); bfly<true>(x[4], x[6], w2); bfly<true>(x[1], x[3], tB1); bfly<true>(x[5], x[7], tB1);
      bfly<true>(x[0], x[1], w4); bfly<true>(x[2], x[3], w4); bfly<true>(x[4], x[5], w4); bfly<true>(x[6], x[7], w4);
    } else {
      bfly<false>(x[0], x[1], w4); bfly<false>(x[2], x[3], w4); bfly<false>(x[4], x[5], w4); bfly<false>(x[6], x[7], w4);
      bfly<false>(x[0], x[2], w2); bfly<false>(x[4], x[6], w2); bfly<false>(x[1], x[3], tB1); bfly<false>(x[5], x[7], tB1);
      bfly<false>(x[0], x[4], w1); bfly<false>(x[1], x[5], tA1); bfly<false>(x[2], x[6], tA2); bfly<false>(x[3], x[7], tA3);
    }
#pragma unroll
    for (int p = 0; p < 8; ++p) if (!(HALF == 2 && p >= 4)) buf[PH(i0 + p * q)] = x[p];
  }
  __syncthreads();
}
__device__ __forceinline__ void fft_r2(float2* buf) {
  for (int g = tid_fresh(); g < 4096; g += NT) {
    const int i0 = PH(2 * g), i1 = PH(2 * g + 1);
    const float2 a = buf[i0], b = buf[i1];
    buf[i0] = make_float2(a.x + b.x, a.y + b.y); buf[i1] = make_float2(a.x - b.x, a.y - b.y);
  }
  __syncthreads();
}
__device__ __forceinline__ void fft_dif(float2* buf, const float2* T) { fft_r8<true>(buf, T, 10); fft_r8<true>(buf, T, 7); fft_r8<true>(buf, T, 4); fft_r8<true>(buf, T, 1); fft_r2(buf); }
__device__ __forceinline__ void fft_dit(float2* buf, const float2* T) { fft_r2(buf); fft_r8<false>(buf, T, 1); fft_r8<false>(buf, T, 4); fft_r8<false>(buf, T, 7); fft_r8<false>(buf, T, 10); }
__device__ __forceinline__ void fft_dif_zp(float2* buf, const float2* T) { fft_r8<true, 1>(buf, T, 10); fft_r8<true>(buf, T, 7); fft_r8<true>(buf, T, 4); fft_r8<true>(buf, T, 1); fft_r2(buf); }
__device__ __forceinline__ void fft_dit_lo(float2* buf, const float2* T) { fft_r2(buf); fft_r8<false>(buf, T, 1); fft_r8<false>(buf, T, 4); fft_r8<false>(buf, T, 7); fft_r8<false, 2>(buf, T, 10); }
__device__ __forceinline__ int brev13(int k) { return (int)(__brev((unsigned)k) >> 19); }

__device__ __forceinline__ void hyena_feats(float* h3, unsigned char* smem) {
  KP PP = params_fresh();
  float* hin = (float*)smem;
  const int tid = tid_fresh(), r = tid >> 6, u = tid & 63;
  for (int it = blockIdx.x; it < 2048; it += gridDim.x) {
    const int j = it >> 10, l = (it & 1023) * 4 + r;
    const float* w0 = PP->in[I_HW0] + j * 33 * 64; const float* b0 = PP->in[I_HB0] + j * 64;
    const float* w1 = PP->in[I_HW1] + j * 4096; const float* b1 = PP->in[I_HB1] + j * 64;
    const float* w2 = PP->in[I_HW2] + j * 4096; const float* b2 = PP->in[I_HB2] + j * 64;
    const float fr = PP->in[I_HFREQ][j * 64 + u];
    __syncthreads();
    {
      const float tt = (float)l / 4095.f;
      const float ang = 6.283185307179586f * (float)l / 4096.f;
      float f = 0.f;
      if (u == 0) f = tt;
      else if (u <= 16) { const float band = 1e-4f + (float)(u - 1) * ((15.f - 1e-4f) / 15.f); f = cosf(band * ang); }
      else if (u <= 32) { const float band = 1e-4f + (float)(u - 17) * ((15.f - 1e-4f) / 15.f); f = -sinf(band * ang); }
      hin[r * 64 + u] = f;
    }
    __syncthreads();
    float a = b0[u];
    for (int k = 0; k < 33; ++k) a += hin[r * 64 + k] * w0[k * 64 + u];
    float v = sinf(fr * a);
    __syncthreads(); hin[r * 64 + u] = v; __syncthreads();
    a = b1[u];
    for (int k = 0; k < 64; ++k) a += hin[r * 64 + k] * w1[k * 64 + u];
    v = sinf(fr * a);
    __syncthreads(); hin[r * 64 + u] = v; __syncthreads();
    a = b2[u];
    for (int k = 0; k < 64; ++k) a += hin[r * 64 + k] * w2[k * 64 + u];
    v = sinf(fr * a);
    h3[((size_t)j * 4096 + l) * 64 + u] = v;
  }
}

__device__ __forceinline__ void filtgen_phase(const float* hwout, int j, const float* h3, float* kT, unsigned char* smem) {
  float* hs = (float*)smem;
  float* wsm = (float*)(smem + 32768);
  const int tid = tid_fresh(), tl = tid & 15, tc = tid >> 4;
  const float* wout = hwout + (size_t)j * 64 * 2048;
  const float mind = logf(0.01f) / 1.5f, maxd = logf(0.01f) / 0.3f;
  for (int it = blockIdx.x; it < 2048; it += gridDim.x) {
    const int l0 = (it & 63) * 64, c0 = (it >> 6) * 64;
    __syncthreads();
#pragma unroll
    for (int i = 0; i < 4; ++i) {
      const int id = tid + 256 * i, r = id >> 4, c4 = id & 15;
      const float4 hv = *(const float4*)(h3 + ((size_t)j * 4096 + l0 + r) * 64 + c4 * 4);
      float* d = hs + r * 65 + c4 * 4; d[0] = hv.x; d[1] = hv.y; d[2] = hv.z; d[3] = hv.w;
      *(float4*)(wsm + r * 64 + c4 * 4) = *(const float4*)(wout + (size_t)r * 2048 + c0 + c4 * 4);
    }
    __syncthreads();
    float acc[4][4];
#pragma unroll
    for (int i = 0; i < 4; ++i)
#pragma unroll
      for (int k = 0; k < 4; ++k) acc[i][k] = 0.f;
#pragma unroll 4
    for (int u = 0; u < 64; ++u) {
      const float4 w = *(const float4*)(wsm + u * 64 + tc * 4);
#pragma unroll
      for (int i = 0; i < 4; ++i) {
        const float hv = hs[(tl * 4 + i) * 65 + u];
        acc[i][0] += hv * w.x; acc[i][1] += hv * w.y; acc[i][2] += hv * w.z; acc[i][3] += hv * w.w;
      }
    }
#pragma unroll
    for (int k = 0; k < 4; ++k) {
      const int col = c0 + tc * 4 + k, c = col & 1023;
      const float dl = fabsf(mind + (float)c * ((maxd - mind) / 1023.f));
      float4 o;
      o.x = acc[0][k] * expf(-((float)(l0 + tl * 4 + 0) / 4095.f) * dl);
      o.y = acc[1][k] * expf(-((float)(l0 + tl * 4 + 1) / 4095.f) * dl);
      o.z = acc[2][k] * expf(-((float)(l0 + tl * 4 + 2) / 4095.f) * dl);
      o.w = acc[3][k] * expf(-((float)(l0 + tl * 4 + 3) / 4095.f) * dl);
      *(float4*)(kT + (size_t)col * 4096 + l0 + tl * 4) = o;
    }
  }
}

__device__ __forceinline__ void spectrum_phase(const float* kT, const float2* T, float4* spec, unsigned char* smem) {
  float2* buf = (float2*)smem;
  float* red = (float*)smem;
  const int tid = tid_fresh(), lane = tid & 63, wid = tid >> 6;
  for (int pi = blockIdx.x; pi < 512; pi += gridDim.x) {
    const int c1 = 2 * pi;
    const float* f0 = kT + (size_t)c1 * 4096;
    const float* b0 = kT + (size_t)(1024 + c1) * 4096;
    __syncthreads();
    float s1 = 0.f, s2 = 0.f;
#pragma unroll 4
    for (int i = 0; i < 16; ++i) {
      const int l = tid + 256 * i;
      const float a00 = f0[l], a01 = f0[4096 + l], a10 = b0[l], a11 = b0[4096 + l];
      s1 += a00 * a00; s2 += a01 * a01;
      if (l != 0) { s1 += a10 * a10; s2 += a11 * a11; }
    }
#pragma unroll
    for (int o = 32; o > 0; o >>= 1) { s1 += __shfl_xor(s1, o); s2 += __shfl_xor(s2, o); }
    if (lane == 0) { red[wid * 2] = s1; red[wid * 2 + 1] = s2; }
    __syncthreads();
    s1 = red[0] + red[2] + red[4] + red[6]; s2 = red[1] + red[3] + red[5] + red[7];
    __syncthreads();
#pragma unroll 4
    for (int i = 0; i < 16; ++i) {
      const int l = tid + 256 * i;
      const float a00 = f0[l], a01 = f0[4096 + l], a10 = b0[l], a11 = b0[4096 + l];
      buf[PH(l)] = make_float2(a00, a01);
      if (l == 0) buf[PH(4096)] = make_float2(0.f, 0.f);
      else buf[PH(8192 - l)] = make_float2(a10, a11);
    }
    __syncthreads();
    const float sc1 = rsqrtf(s1 + 1e-6f) * (1.f / 8192.f);
    const float sc2 = rsqrtf(s2 + 1e-6f) * (1.f / 8192.f);
    fft_dif(buf, T);
    for (int k = tid; k <= 4096; k += NT) {
      const int pk_ = brev13(k), pn_ = brev13((8192 - k) & 8191);
      const float2 Pk = buf[PH(pk_)], Fn = buf[PH(pn_)];
      const float2 Qc = make_float2(Fn.x, -Fn.y);
      const float2 H1 = make_float2(0.5f * (Pk.x + Qc.x) * sc1, 0.5f * (Pk.y + Qc.y) * sc1);
      const float2 H2 = make_float2(0.5f * (Pk.y - Qc.y) * sc2, -0.5f * (Pk.x - Qc.x) * sc2);
      spec[(size_t)pi * SPEC_STRIDE + k] = make_float4(0.5f * (H1.x + H2.x), 0.5f * (H1.y + H2.y), 0.5f * (H1.x - H2.x), 0.5f * (H1.y - H2.y));
    }
  }
}

__device__ __forceinline__ void z_phase(const bf16_t* X1, const bf16_t* V, const float* cw  , const float* cb  , float* zT, unsigned char* smem) {
  float* zs = (float*)smem;
  const int tid = tid_fresh(), c8 = tid & 7, tr = tid >> 3;
  for (int it = blockIdx.x; it < 8192; it += gridDim.x) {
    const int ct = it & 15, tt = it >> 4, c0 = ct * 64, t0 = tt * 64;
    __syncthreads();
    const int c = c0 + c8 * 8;
    float w1[3][8], w2[3][8], bb1[8], bb2[8];
#pragma unroll
    for (int e = 0; e < 8; ++e) {
#pragma unroll
      for (int k = 0; k < 3; ++k) { w1[k][e] = cw[k * 3072 + 1024 + c + e]; w2[k][e] = cw[k * 3072 + 2048 + c + e]; }
      bb1[e] = cb[1024 + c + e]; bb2[e] = cb[2048 + c + e];
    }
#pragma unroll
    for (int i = 0; i < 2; ++i) {
      const int tl = tr + 32 * i, t = t0 + tl, tb = t & (SEQ - 1);
      float a1[8], a2[8];
#pragma unroll
      for (int e = 0; e < 8; ++e) { a1[e] = bb1[e]; a2[e] = bb2[e]; }
#pragma unroll
      for (int k = 0; k < 3; ++k) {
        const int tbk = tb + k - 1;
        if (tbk >= 0 && tbk < SEQ) {
          float f[8], g[8];
          unpack8(*(const uint4*)(X1 + (size_t)(t + k - 1) * 1024 + c), f);
          unpack8(*(const uint4*)(V + (size_t)(t + k - 1) * 1024 + c), g);
#pragma unroll
          for (int e = 0; e < 8; ++e) { a1[e] += w1[k][e] * f[e]; a2[e] += w2[k][e] * g[e]; }
        }
      }
#pragma unroll
      for (int e = 0; e < 8; ++e) zs[(c8 * 8 + e) * 65 + tl] = a1[e] * a2[e];
    }
    __syncthreads();
    {
      const int cl = tid >> 2, tq = tid & 3;
      const int bidx = t0 >> 12, tbase = t0 & (SEQ - 1);
      float* dst = zT + ((size_t)(bidx * 1024 + c0 + cl)) * SEQ + tbase + tq * 16;
#pragma unroll
      for (int v4 = 0; v4 < 4; ++v4) {
        const float* s = zs + cl * 65 + tq * 16 + v4 * 4;
        *(float4*)(dst + v4 * 4) = make_float4(s[0], s[1], s[2], s[3]);
      }
    }
  }
}

__device__ __forceinline__ void fftconv_phase(float* zT, const float4* spec, const float2* T, const float* hd, unsigned char* smem) {
  float2* buf = (float2*)smem;
  const int tid = tid_fresh();
  for (int it = blockIdx.x; it < 4096; it += gridDim.x) {
    const int b = (it >> 3) & 7, pi = (it & 7) + 8 * (it >> 6), c1 = 2 * pi;
    float* z1 = zT + ((size_t)(b * 1024 + c1)) * SEQ;
    float* z2 = z1 + SEQ;
    __syncthreads();
    for (int t = tid; t < 4096; t += NT) buf[PH(t)] = make_float2(z1[t], z2[t]);
    __syncthreads();
    fft_r8<true, 1>(buf, T, 10); fft_r8<true>(buf, T, 7); fft_r8<true>(buf, T, 4); fft_r8<true>(buf, T, 1);
    const float4* sp = spec + (size_t)pi * SPEC_STRIDE;
    for (int f = tid; f <= 2048; f += NT) {
      const int p0 = brev13(f);
      const float2 a0 = buf[PH(p0)], b0 = buf[PH(p0 + 1)];
      const float2 Xf = cadd(a0, b0), Xf4 = csub(a0, b0);
      const float4 s1 = sp[f];
      const float2 S1 = make_float2(s1.x, s1.y), D1 = make_float2(s1.z, s1.w);
      if (f == 0 || f == 2048) {
        float2 W0, W1;
        if (f == 0) {
          const float4 s2 = sp[4096];
          W0 = cadd(cmul(Xf, S1), cmul(make_float2(Xf.x, -Xf.y), D1));
          W1 = cadd(cmul(Xf4, make_float2(s2.x, s2.y)), cmul(make_float2(Xf4.x, -Xf4.y), make_float2(s2.z, s2.w)));
        } else {
          W0 = cadd(cmul(Xf, S1), cmul(make_float2(Xf4.x, -Xf4.y), D1));
          W1 = cadd(cmul(Xf4, make_float2(S1.x, -S1.y)), cmul(make_float2(Xf.x, -Xf.y), make_float2(D1.x, -D1.y)));
        }
        const float2 c0 = make_float2(W0.x, -W0.y), c1 = make_float2(W1.x, -W1.y);
        buf[PH(p0)] = cadd(c0, c1); buf[PH(p0 + 1)] = csub(c0, c1);
      } else {
        const int fp = 4096 - f, p1 = brev13(fp);
        const float2 a1 = buf[PH(p1)], b1 = buf[PH(p1 + 1)];
        const float2 Xg = cadd(a1, b1), Xg4 = csub(a1, b1);
        const float4 s2 = sp[fp];
        const float2 S2 = make_float2(s2.x, s2.y), D2 = make_float2(s2.z, s2.w);
        const float2 Wf  = cadd(cmul(Xf, S1), cmul(make_float2(Xg4.x, -Xg4.y), D1));
        const float2 Wg4 = cadd(cmul(Xg4, make_float2(S1.x, -S1.y)), cmul(make_float2(Xf.x, -Xf.y), make_float2(D1.x, -D1.y)));
        const float2 Wg  = cadd(cmul(Xg, S2), cmul(make_float2(Xf4.x, -Xf4.y), D2));
        const float2 Wf4 = cadd(cmul(Xf4, make_float2(S2.x, -S2.y)), cmul(make_float2(Xg.x, -Xg.y), make_float2(D2.x, -D2.y)));
        float2 c0 = make_float2(Wf.x, -Wf.y), c1 = make_float2(Wf4.x, -Wf4.y);
        buf[PH(p0)] = cadd(c0, c1); buf[PH(p0 + 1)] = csub(c0, c1);
        c0 = make_float2(Wg.x, -Wg.y); c1 = make_float2(Wg4.x, -Wg4.y);
        buf[PH(p1)] = cadd(c0, c1); buf[PH(p1 + 1)] = csub(c0, c1);
      }
    }
    __syncthreads();
    fft_r8<false>(buf, T, 1); fft_r8<false>(buf, T, 4); fft_r8<false>(buf, T, 7); fft_r8<false, 2>(buf, T, 10);
    const float d1 = hd[c1], d2 = hd[c1 + 1];
    for (int t = tid; t < 4096; t += NT) {
      const float2 y = buf[PH(t)];
      z1[t] = y.x + d1 * z1[t];
      z2[t] = -y.y + d2 * z2[t];
    }
  }
}

__device__ __forceinline__ void ya_phase(const bf16_t* X0, const float* yT, const float* cw, const float* cb, bf16_t* MA, unsigned char* smem) {
  float* ys = (float*)smem;
  const int tid = tid_fresh(), c8 = tid & 7, tr = tid >> 3;
  for (int it = blockIdx.x; it < 8192; it += gridDim.x) {
    const int ct = it & 15, tt = it >> 4, c0 = ct * 64, t0 = tt * 64;
    __syncthreads();
    {
      const int cl = tid >> 2, tq = tid & 3;
      const int bidx = t0 >> 12, tbase = t0 & (SEQ - 1);
      const float* src = yT + ((size_t)(bidx * 1024 + c0 + cl)) * SEQ + tbase + tq * 16;
#pragma unroll
      for (int v4 = 0; v4 < 4; ++v4) {
        const float4 v = *(const float4*)(src + v4 * 4);
        float* s = ys + cl * 65 + tq * 16 + v4 * 4;
        s[0] = v.x; s[1] = v.y; s[2] = v.z; s[3] = v.w;
      }
    }
    __syncthreads();
    const int c = c0 + c8 * 8;
    float w0[3][8], bb[8];
#pragma unroll
    for (int e = 0; e < 8; ++e) {
#pragma unroll
      for (int k = 0; k < 3; ++k) w0[k][e] = cw[k * 3072 + c + e];
      bb[e] = cb[c + e];
    }
#pragma unroll
    for (int i = 0; i < 2; ++i) {
      const int tl = tr + 32 * i, t = t0 + tl, tb = t & (SEQ - 1);
      float a[8];
#pragma unroll
      for (int e = 0; e < 8; ++e) a[e] = bb[e];
#pragma unroll
      for (int k = 0; k < 3; ++k) {
        const int tbk = tb + k - 1;
        if (tbk >= 0 && tbk < SEQ) {
          float f[8];
          unpack8(*(const uint4*)(X0 + (size_t)(t + k - 1) * 1024 + c), f);
#pragma unroll
          for (int e = 0; e < 8; ++e) a[e] += w0[k][e] * f[e];
        }
      }
#pragma unroll
      for (int e = 0; e < 8; ++e) a[e] *= ys[(c8 * 8 + e) * 65 + tl];
      *(uint4*)(MA + (size_t)t * 1024 + c) = make_uint4(pack2(a[0], a[1]), pack2(a[2], a[3]), pack2(a[4], a[5]), pack2(a[6], a[7]));
    }
  }
}

__device__ __forceinline__ void convT_job(const float* src, int K, int N, bf16_t* dst, const float* scale, unsigned char* smem) {
  float* ts = (float*)smem;
  const int tid = tid_fresh();
  const int tn = N >> 6, ntile = (K >> 6) * tn;
  for (int it = blockIdx.x; it < ntile; it += gridDim.x) {
    const int k0 = (it / tn) * 64, n0 = (it % tn) * 64;
    __syncthreads();
#pragma unroll
    for (int i = 0; i < 4; ++i) {
      const int r = (tid >> 4) + 16 * i, c4 = tid & 15;
      float4 v = *(const float4*)(src + (size_t)(k0 + r) * N + n0 + c4 * 4);
      const float s = scale ? scale[k0 + r] : 1.f;
      float* d = ts + r * 65 + c4 * 4;
      d[0] = v.x * s; d[1] = v.y * s; d[2] = v.z * s; d[3] = v.w * s;
    }
    __syncthreads();
#pragma unroll
    for (int i = 0; i < 2; ++i) {
      const int id = tid + 256 * i, nn = id >> 3, kc = id & 7;
      float f[8];
#pragma unroll
      for (int e = 0; e < 8; ++e) f[e] = ts[(kc * 8 + e) * 65 + nn];
      *(uint4*)(dst + (size_t)(n0 + nn) * K + k0 + kc * 8) = make_uint4(pack2(f[0], f[1]), pack2(f[2], f[3]), pack2(f[4], f[5]), pack2(f[6], f[7]));
    }
  }
}
__device__ __forceinline__ void conv_plain(const float* src, bf16_t* dst, size_t n) {
  const size_t stride = (size_t)gridDim.x * NT * 8;
  for (size_t i = ((size_t)blockIdx.x * NT + tid_fresh()) * 8; i < n; i += stride) {
    const float4 a = *(const float4*)(src + i), b = *(const float4*)(src + i + 4);
    *(uint4*)(dst + i) = make_uint4(pack2(a.x, a.y), pack2(a.z, a.w), pack2(b.x, b.y), pack2(b.z, b.w));
  }
}

__device__ __forceinline__ void final_norm(float* h, const float* g) {
  const int tid = tid_fresh(), wave = tid >> 6, lane = tid & 63;
  for (int row = blockIdx.x * 4 + wave; row < TOK; row += gridDim.x * 4) {
    float* p = h + (size_t)row * 1024;
    float4 v[4]; float s = 0.f;
#pragma unroll
    for (int i = 0; i < 4; ++i) { v[i] = *(const float4*)(p + i * 256 + lane * 4); s += v[i].x * v[i].x + v[i].y * v[i].y + v[i].z * v[i].z + v[i].w * v[i].w; }
#pragma unroll
    for (int o = 32; o > 0; o >>= 1) s += __shfl_xor(s, o);
    const float r = rsqrtf(s * (1.f / 1024.f) + 1e-6f);
#pragma unroll
    for (int i = 0; i < 4; ++i) {
      const float4 gg = *(const float4*)(g + i * 256 + lane * 4);
      *(float4*)(p + i * 256 + lane * 4) = make_float4(v[i].x * r * gg.x, v[i].y * r * gg.y, v[i].z * r * gg.z, v[i].w * r * gg.w);
    }
  }
}


#define XB_TMO      128
#define XB_XCNT(j)  (256  + 64 * (j))
#define XB_XSUB(j)  (1280 + 64 * (j))
#define XB_XGEN(j)  (2304 + 64 * (j))
#define XB_TOP      3328
#define XB_TOPGEN   3392
#define XCD_BAR_WORDS 3456
#define XB_SPIN_CAP (1u << 18)
__device__ __forceinline__ unsigned xb_ld(unsigned* p)              { return __hip_atomic_load(p, __ATOMIC_RELAXED, __HIP_MEMORY_SCOPE_AGENT); }
__device__ __forceinline__ unsigned xb_add(unsigned* p, unsigned v) { return __hip_atomic_fetch_add(p, v, __ATOMIC_RELAXED, __HIP_MEMORY_SCOPE_AGENT); }
__device__ __forceinline__ unsigned xb_xcc_id() { unsigned v; asm volatile("s_getreg_b32 %0, hwreg(HW_REG_XCC_ID, 0, 4)" : "=s"(v)); return v & 0xFu; }
#define XB_SPIN(cond, bar) do { unsigned _sp = 0; while (cond) { __builtin_amdgcn_s_sleep(1); \
    if ((++_sp & 255u) == 0u) { if (xb_ld(&(bar)[XB_TMO])) break; if (_sp > XB_SPIN_CAP) { atomicAdd(&(bar)[XB_TMO], 1u); break; } } } } while (0)
__device__ __forceinline__ void xcd_barrier(unsigned* bar) {
  asm volatile("s_waitcnt vmcnt(0) lgkmcnt(0)" ::: "memory");
  __syncthreads();
  if (tid_fresh() == 0) {
    __builtin_amdgcn_s_waitcnt(0);
    const unsigned x = xb_xcc_id();
    int bi = blockIdx.x; asm volatile("" : "+s"(bi));
    const uint2 census = *(const uint2*)(bar + XCD_BAR_WORDS + 2 * bi);
    const unsigned nloc = census.x, nx = census.y;
    const unsigned old = xb_add(&bar[XB_XSUB(x)], 1u);
    const unsigned gen = old / nloc;
    if (old + 1u == (gen + 1u) * nloc) {
      __builtin_amdgcn_fence(__ATOMIC_RELEASE, "agent");
      asm volatile("s_waitcnt vmcnt(0)" ::: "memory");
      const unsigned og = xb_add(&bar[XB_TOP], 1u);
      const unsigned tg = og / nx;
      if (og + 1u == (tg + 1u) * nx) xb_add(&bar[XB_TOPGEN], 1u);
      else XB_SPIN(xb_ld(&bar[XB_TOPGEN]) == tg, bar);
      __builtin_amdgcn_fence(__ATOMIC_ACQUIRE, "agent");
      xb_add(&bar[XB_XGEN(x)], 1u);
      asm volatile("s_waitcnt vmcnt(0)" ::: "memory");
    } else {
      XB_SPIN(xb_ld(&bar[XB_XGEN(x)]) == gen, bar);
      __builtin_amdgcn_fence(__ATOMIC_ACQUIRE, "agent");
      asm volatile("s_waitcnt vmcnt(0)" ::: "memory");
    }
  }
  __syncthreads();
}

#define GSYNC() do { asm volatile("s_waitcnt vmcnt(0) lgkmcnt(0)" ::: "memory"); grid.sync(); \
    if (tid_fresh() < 64) { __builtin_amdgcn_fence(__ATOMIC_ACQUIRE, "agent"); asm volatile("s_waitcnt vmcnt(0)" ::: "memory"); } \
    __syncthreads(); } while (0)
#define XSYNC() xcd_barrier((unsigned*)WSP(BAR_OFF))
#define WSP(off) (params_fresh()->ws + (off))
#define INP(i) (params_fresh()->in[i])
#define WBP ((bf16_t*)WSP(WB_OFF))
#define HBA ((bf16_t*)WSP(HBA_OFF))
#define SPECP ((float4*)WSP(SPEC_OFF))
#define H3P ((float*)WSP(H3_OFF))
#define TWP ((float2*)WSP(TW_OFF))
#define SLOT(i) ((bf16_t*)WSP(R_OFF + (size_t)(i) * 64 * MiB))
#define HRES (params_fresh()->out)

__global__ void __launch_bounds__(NT, 2) mega(Params Pdummy) {
  __shared__ __attribute__((aligned(16))) unsigned char smem[65536];
  cg::grid_group grid = cg::this_grid();
  if (tid_fresh() == 0) (void)xb_add(&((unsigned*)WSP(BAR_OFF))[XB_XCNT(xb_xcc_id())], 1u);

  for (int j = 0; j < 2; ++j) {
    convT_job(INP(I_EWIN) + (size_t)j * 1024 * 7168, 1024, 7168, WBP + W_EIN + (size_t)j * 7340032, INP(I_NORMG) + (2 * j) * 1024, smem);
    convT_job(INP(I_OWIN) + (size_t)j * 1024 * 6144, 1024, 6144, WBP + W_OIN + (size_t)j * 6291456, INP(I_NORMG) + (2 * j + 1) * 1024, smem);
    convT_job(INP(I_EWOUT) + (size_t)j * 2048 * 1024, 2048, 1024, WBP + W_EOUT + (size_t)j * 2097152, nullptr, smem);
    convT_job(INP(I_OWOUT) + (size_t)j * 2048 * 1024, 2048, 1024, WBP + W_OOUT + (size_t)j * 2097152, nullptr, smem);
    for (int g = 0; g < 4; ++g)
      convT_job(INP(I_POOLW) + (size_t)(j * 4 + g) * 65536, 256, 256, WBP + W_POOL + (size_t)(j * 4 + g) * 65536, nullptr, smem);
  }
  for (int i = 0; i < 4; ++i) {
    convT_job(INP(I_PGATE) + (size_t)i * 1048576, 1024, 1024, WBP + W_PGATE + (size_t)i * 1048576, INP(I_PLEG) + i * 1024, smem);
    convT_job(INP(I_PUP) + (size_t)i * 262144, 256, 1024, WBP + W_PUP + (size_t)i * 262144, nullptr, smem);
  }
  conv_plain(INP(I_GMWS), WBP + W_GMWS, 262144);
  conv_plain(INP(I_X), HBA, (size_t)TOK * 1024);
  hyena_feats(H3P, smem);
  {
    float2* T = TWP;
    for (int k = blockIdx.x * NT + tid_fresh(); k < 4096; k += gridDim.x * NT) {
      float s, c; sincospif((float)k / 4096.f, &s, &c);
      T[k] = make_float2(c, -s);
    }
  }
  if (gridDim.y == 0x7fffu) grid.sync();
  if (tid_fresh() == 0) {
    unsigned* bar = (unsigned*)WSP(BAR_OFF);
    const unsigned x = xb_xcc_id();
    unsigned nloc = 0u, nx = 0u, sum = 0u, sp = 0u;
    for (;;) {
      sum = 0u; nx = 0u; nloc = 0u;
#pragma unroll
      for (unsigned jx = 0; jx < 16; ++jx) { const unsigned c = xb_ld(&bar[XB_XCNT(jx)]); sum += c; nx += (c > 0u) ? 1u : 0u; nloc = (jx == x) ? c : nloc; }
      if (sum == gridDim.x) break;
      __builtin_amdgcn_s_sleep(1);
      if ((++sp & 255u) == 0u) { if (xb_ld(&bar[XB_TMO])) break; if (sp > XB_SPIN_CAP) { atomicAdd(&bar[XB_TMO], 1u); break; } }
    }
    *(uint2*)(bar + XCD_BAR_WORDS + 2 * blockIdx.x) = make_uint2(nloc > 0u ? nloc : 1u, nx > 0u ? nx : 1u);
  }
  XSYNC();
  filtgen_phase(INP(I_HWOUT), 0, H3P, (float*)SLOT(3), smem);
  XSYNC();

#pragma unroll 1
  for (int layer = 0; layer < 4; ++layer) {
    const int j = layer >> 1;
    if ((layer & 1) == 0) {
      spectrum_phase((const float*)SLOT(3), TWP, SPECP, smem);
      inproj_phase(HBA, WBP + W_EIN + (size_t)j * 7340032, 3, 0, 1024, 2048, 0, SLOT(0), SLOT(1), SLOT(2), nullptr, 0, 0, 0, 0, smem);
      XSYNC();
      z_phase(SLOT(1), SLOT(2), INP(I_CONVW) + (size_t)j * 9216, INP(I_CONVB) + (size_t)j * 3072, (float*)SLOT(3), smem);
      XSYNC();
      fftconv_phase((float*)SLOT(3), SPECP, TWP, INP(I_HD) + j * 1024, smem);
      XSYNC();
      ya_phase(SLOT(0), (const float*)SLOT(3), INP(I_CONVW) + (size_t)j * 9216, INP(I_CONVB) + (size_t)j * 3072, SLOT(1), smem);
      XSYNC();
      inproj_phase(HBA, WBP + W_EIN + (size_t)j * 7340032, 2, 4096, 5120, 0, 0, SLOT(0), SLOT(2), nullptr, nullptr, 0, 3, 0, 0, smem, (float*)WSP(PART_OFF));
      XSYNC();
      gmlp_phase(SLOT(0), SLOT(2), WBP + W_GMWS + (size_t)j * 131072, INP(I_GMG) + j * 1024, INP(I_GMBS) + j * 1024, (const float*)WSP(PART_OFF), smem);
      XSYNC();
      inproj_phase(HBA, WBP + W_EIN + (size_t)j * 7340032, 2, 3072, 6144, 0, 0, SLOT(1), SLOT(0), nullptr, nullptr, 2, 2, 0, 0, smem);
      XSYNC();
      outproj_phase(SLOT(1), SLOT(0), WBP + W_EOUT + (size_t)j * 2097152, (layer == 0) ? INP(I_X) : (const float*)HRES, HRES, SLOT(3), smem);
      XSYNC();
      ple_phase(SLOT(3), INP(I_P) + (size_t)layer * TOK * 256, WBP + W_PGATE + (size_t)layer * 1048576, WBP + W_PUP + (size_t)layer * 262144, HRES, HBA, smem);
      XSYNC();
    } else {
      inproj_phase(HBA, WBP + W_OIN + (size_t)j * 6291456, 4, 0, 2048, 3072, 4096, SLOT(0), SLOT(1), SLOT(2), SLOT(3), 0, 0, 0, 1, smem);
      XSYNC();
      pool_phase(SLOT(0), WBP + W_POOL + (size_t)j * 262144, INP(I_POOLB) + j * 1024, INP(I_POOLS) + j * 1024, SLOT(4), smem);
      na_phase(SLOT(1), SLOT(2), SLOT(3), INP(I_RPB) + (size_t)j * 16 * 15 * 31, smem);
      XSYNC();
      inproj_phase(HBA, WBP + W_OIN + (size_t)j * 6291456, 2, 1024, 5120, 0, 0, SLOT(4), SLOT(1), nullptr, nullptr, 2, 2, 0, 0, smem);
      XSYNC();
      outproj_phase(SLOT(4), SLOT(1), WBP + W_OOUT + (size_t)j * 2097152, HRES, HRES, SLOT(2), smem);
      XSYNC();
      ple_phase(SLOT(2), INP(I_P) + (size_t)layer * TOK * 256, WBP + W_PGATE + (size_t)layer * 1048576, WBP + W_PUP + (size_t)layer * 262144, HRES, HBA, smem);
      if (layer == 1) filtgen_phase(INP(I_HWOUT), 1, H3P, (float*)SLOT(3), smem);
      XSYNC();
    }
  }
  final_norm(HRES, INP(I_FINALG));
}

extern "C" void kernel_launch(void* const* d_in, const int* in_sizes, int n_in, void* d_out, int out_size, void* d_ws, size_t ws_size, hipStream_t stream) {
  static int grid_blocks = 0;
  if (grid_blocks == 0) {
    if (n_in != 29 || out_size != TOK * 1024 || ws_size < WS_END) { fprintf(stderr, "kernel_launch: unexpected shapes (n_in %d out %d ws %zu)\n", n_in, out_size, ws_size); grid_blocks = -1; return; }
    int dev = 0, cus = 0, per_cu = 0;
    if (hipGetDevice(&dev) != hipSuccess || hipDeviceGetAttribute(&cus, hipDeviceAttributeMultiprocessorCount, dev) != hipSuccess) { grid_blocks = -1; return; }
    if (hipOccupancyMaxActiveBlocksPerMultiprocessor(&per_cu, (const void*)mega, NT, LDS_BYTES) != hipSuccess || per_cu < 1) { fprintf(stderr, "occupancy query failed\n"); per_cu = 1; }
    if (per_cu > 2) per_cu = 2;
    grid_blocks = cus * per_cu;
  }
  if (grid_blocks < 0) return;
  Params p{};
  for (int i = 0; i < 29; ++i) p.in[i] = (const float*)d_in[i];
  p.out = (float*)d_out; p.ws = (unsigned char*)d_ws;
  if (hipMemsetAsync((unsigned char*)d_ws + BAR_OFF, 0, XCD_BAR_WORDS * sizeof(unsigned), stream) != hipSuccess) { fprintf(stderr, "memset of barrier words failed\n"); return; }
  void* args[] = {&p};
  hipError_t e = hipLaunchCooperativeKernel((const void*)mega, dim3(grid_blocks), dim3(NT), args, LDS_BYTES, stream);
  if (e != hipSuccess) fprintf(stderr, "cooperative launch failed: %s (grid %d)\n", hipGetErrorString(e), grid_blocks);
}
```

```cpp
#include <hip/hip_runtime.h>
#include <hip/hip_cooperative_groups.h>
#include <cstdio>
namespace cg = cooperative_groups;

typedef unsigned short bf16_t;
typedef short bf16x8 __attribute__((ext_vector_type(8)));
typedef short bf16x4 __attribute__((ext_vector_type(4)));
typedef float f32x4 __attribute__((ext_vector_type(4)));

#define NT 256
constexpr int LDS_BYTES = 0;
constexpr size_t MiB = 1u << 20;
constexpr size_t WB_OFF = 0, HBA_OFF = 80 * MiB, SPEC_OFF = 144 * MiB, H3_OFF = 177 * MiB, TW_OFF = 179 * MiB, R_OFF = 180 * MiB, PART_OFF = 500 * MiB, BAR_OFF = 502 * MiB, WS_END = 503 * MiB;
constexpr int TOK = 32768, SEQ = 4096, DM = 1024;
constexpr size_t W_EIN = 0, W_OIN = 14680064, W_EOUT = 27262976, W_OOUT = 31457280, W_PGATE = 35651584, W_PUP = 39845888, W_POOL = 40894464, W_GMWS = 41418752;
constexpr int SPEC_STRIDE = 4104;

struct Params { const float* in[29]; float* out; unsigned char* ws; };
enum { I_X = 0, I_P, I_NORMG, I_FINALG, I_EWIN, I_CONVW, I_CONVB, I_HW0, I_HB0, I_HW1, I_HB1, I_HW2, I_HB2, I_HWOUT, I_HFREQ, I_HD, I_GMG, I_GMWS, I_GMBS, I_EWOUT, I_OWIN, I_POOLW, I_POOLB, I_POOLS, I_RPB, I_OWOUT, I_PUP, I_PGATE, I_PLEG };

__device__ __forceinline__ unsigned short f2bf(float f) { unsigned u = __float_as_uint(f); u += 0x7fffu + ((u >> 16) & 1u); return (unsigned short)(u >> 16); }
__device__ __forceinline__ float bf2f(unsigned short h) { return __uint_as_float(((unsigned)h) << 16); }
__device__ __forceinline__ unsigned pack2(float lo, float hi) { return (unsigned)f2bf(lo) | ((unsigned)f2bf(hi) << 16); }
__device__ __forceinline__ float lo_f(unsigned u) { return __uint_as_float(u << 16); }
__device__ __forceinline__ float hi_f(unsigned u) { return __uint_as_float(u & 0xffff0000u); }
__device__ __forceinline__ float silu_f(float v) { return v / (1.f + __expf(-v)); }
__device__ __forceinline__ float sigmoid_f(float v) { return 1.f / (1.f + __expf(-v)); }
__device__ __forceinline__ void unpack8(const uint4& u, float* f) { f[0] = lo_f(u.x); f[1] = hi_f(u.x); f[2] = lo_f(u.y); f[3] = hi_f(u.y); f[4] = lo_f(u.z); f[5] = hi_f(u.z); f[6] = lo_f(u.w); f[7] = hi_f(u.w); }

typedef const Params __attribute__((address_space(4)))* KP;
__device__ __forceinline__ KP params_fresh() { KP p = (KP)__builtin_amdgcn_kernarg_segment_ptr(); asm volatile("" : "+s"(p)); return p; }
__device__ __forceinline__ int tid_fresh() { int t = threadIdx.x; asm volatile("" : "+v"(t)); return t; }

__device__ __forceinline__ int swz(int row, int kc) { return row * 128 + ((kc ^ ((row >> 1) & 7)) << 4); }

template <int AM, bool SS>
__device__ __forceinline__ void load_a1(int tid, uint4& out, float& ssq, const void* A0, const void* A1, int lda, int row, int k0, int aux) {
  const int kc = tid & 7;
  if (AM == 0) {
    out = *(const uint4*)((const bf16_t*)A0 + (size_t)row * lda + k0 + kc * 8);
  } else if (AM == 2) {
    const bf16_t* src = (k0 < 1024) ? (const bf16_t*)A0 : (const bf16_t*)A1;
    out = *(const uint4*)(src + (size_t)row * lda + (k0 & 1023) + kc * 8);
  } else if (AM == 1) {
    const float* src = (const float*)A0 + (size_t)row * lda + k0 + kc * 8;
    const float4 a = *(const float4*)src, b = *(const float4*)(src + 4);
    out = make_uint4(pack2(a.x, a.y), pack2(a.z, a.w), pack2(b.x, b.y), pack2(b.z, b.w));
  } else {
    const bf16_t* src = (const bf16_t*)A0 + k0 + kc * 8;
    const int half = 1 << aux;
    const int tb = row & (SEQ - 1), base = row - tb;
    const int lo = max(tb - half, 0), hi = min(tb + half, SEQ);
    float s0 = 0.f, s1 = 0.f, s2 = 0.f, s3 = 0.f, s4 = 0.f, s5 = 0.f, s6 = 0.f, s7 = 0.f;
    const int cnt = hi - lo;
    const bf16_t* wp = src + (size_t)(base + lo) * lda;
#pragma unroll 1
    for (int d0 = 0; d0 < cnt; d0 += 8) {
      uint4 wv[8];
#pragma unroll
      for (int d = 0; d < 8; ++d) wv[d] = (d0 + d < cnt) ? *(const uint4*)(wp + (size_t)(d0 + d) * lda) : make_uint4(0u, 0u, 0u, 0u);
#pragma unroll
      for (int d = 0; d < 8; ++d) {
        s0 += lo_f(wv[d].x); s1 += hi_f(wv[d].x); s2 += lo_f(wv[d].y); s3 += hi_f(wv[d].y); s4 += lo_f(wv[d].z); s5 += hi_f(wv[d].z); s6 += lo_f(wv[d].w); s7 += hi_f(wv[d].w);
      }
    }
    const uint4 u = *(const uint4*)(src + (size_t)row * lda);
    const float inv = 1.f / (float)(hi - lo);
    out = make_uint4(pack2(s0 * inv - lo_f(u.x), s1 * inv - hi_f(u.x)), pack2(s2 * inv - lo_f(u.y), s3 * inv - hi_f(u.y)),
                     pack2(s4 * inv - lo_f(u.z), s5 * inv - hi_f(u.z)), pack2(s6 * inv - lo_f(u.w), s7 * inv - hi_f(u.w)));
  }
}
template <int AM, bool SS>
__device__ __forceinline__ void load_a(int tid, uint4& a0, uint4& a1, uint4& a2, uint4& a3, const void* A0, const void* A1, int lda, int m0, int k0, int aux, float (&ss)[4]) {
  const int row = m0 + (tid >> 3);
  load_a1<AM, SS>(tid, a0, ss[0], A0, A1, lda, row, k0, aux);
  load_a1<AM, SS>(tid, a1, ss[1], A0, A1, lda, row + 32, k0, aux);
  load_a1<AM, SS>(tid, a2, ss[2], A0, A1, lda, row + 64, k0, aux);
  load_a1<AM, SS>(tid, a3, ss[3], A0, A1, lda, row + 96, k0, aux);
}
__device__ __forceinline__ void load_b(int tid, uint4& b0, uint4& b1, uint4& b2, uint4& b3, const bf16_t* Bt, int ldb, int n0, int k0) {
  const bf16_t* p = Bt + (size_t)(n0 + (tid >> 3)) * ldb + k0 + (tid & 7) * 8;
  b0 = *(const uint4*)p; b1 = *(const uint4*)(p + (size_t)32 * ldb); b2 = *(const uint4*)(p + (size_t)64 * ldb); b3 = *(const uint4*)(p + (size_t)96 * ldb);
}
__device__ __forceinline__ void store_tile(int tid, unsigned char* dst, const uint4& r0v, const uint4& r1v, const uint4& r2v, const uint4& r3v) {
  const int r0 = tid >> 3, kc = tid & 7;
  *(uint4*)(dst + swz(r0, kc)) = r0v; *(uint4*)(dst + swz(r0 + 32, kc)) = r1v; *(uint4*)(dst + swz(r0 + 64, kc)) = r2v; *(uint4*)(dst + swz(r0 + 96, kc)) = r3v;
}

__device__ __forceinline__ float ssq8(const uint4& v) {
  const float f0 = lo_f(v.x), f1 = hi_f(v.x), f2 = lo_f(v.y), f3 = hi_f(v.y), f4 = lo_f(v.z), f5 = hi_f(v.z), f6 = lo_f(v.w), f7 = hi_f(v.w);
  return f0 * f0 + f1 * f1 + f2 * f2 + f3 * f3 + f4 * f4 + f5 * f5 + f6 * f6 + f7 * f7;
}
template <bool SS>
__device__ __forceinline__ void store_a(int tid, unsigned char* dst, const uint4& a0, const uint4& a1, const uint4& a2, const uint4& a3, float (&ss)[4]) {
  if (SS) { ss[0] += ssq8(a0); ss[1] += ssq8(a1); ss[2] += ssq8(a2); ss[3] += ssq8(a3); }
  store_tile(tid, dst, a0, a1, a2, a3);
}
template <bool SWAP>
__device__ __forceinline__ void mma_tile(f32x4 (&acc)[4][4], const unsigned char* cur, int wr, int wc, int fr, int fq) {
#pragma unroll
  for (int s = 0; s < 2; ++s) {
    bf16x8 af[4], bfr[4];
#pragma unroll
    for (int m = 0; m < 4; ++m) af[m] = *(const bf16x8*)(cur + swz(wr * 64 + m * 16 + fr, s * 4 + fq));
#pragma unroll
    for (int n = 0; n < 4; ++n) bfr[n] = *(const bf16x8*)(cur + 16384 + swz(wc * 64 + n * 16 + fr, s * 4 + fq));
#pragma unroll
    for (int m = 0; m < 4; ++m)
#pragma unroll
      for (int n = 0; n < 4; ++n)
        acc[m][n] = SWAP ? __builtin_amdgcn_mfma_f32_16x16x32_bf16(bfr[n], af[m], acc[m][n], 0, 0, 0)
                         : __builtin_amdgcn_mfma_f32_16x16x32_bf16(af[m], bfr[n], acc[m][n], 0, 0, 0);
  }
}
template <int AM, bool SS, bool SWAP>
__device__ __forceinline__ void gemm_mainloop(f32x4 (&acc)[4][4], const void* A0, const void* A1, int lda, const bf16_t* Bt, int ldb,
                                              int m0, int n0, int K, int aux, unsigned char* smem, float (&ss)[4], int rot) {
  const int tid = tid_fresh(), wid = tid >> 6, lane = tid & 63, wr = wid >> 1, wc = wid & 1, fr = lane & 15, fq = lane >> 4;
  const int nk = K >> 6, km = nk - 1;
  unsigned char* L0 = smem;
  unsigned char* L1 = smem + 32768;
  uint4 a0, a1, a2, a3, b0, b1, b2, b3;
  __syncthreads();
  if (AM == 0 || AM == 2) {
    uint4 c0, c1, c2, c3, d0, d1, d2, d3;
    load_a<AM, SS>(tid, a0, a1, a2, a3, A0, A1, lda, m0, (rot & km) << 6, aux, ss);
    load_b(tid, b0, b1, b2, b3, Bt, ldb, n0, (rot & km) << 6);
    load_a<AM, SS>(tid, c0, c1, c2, c3, A0, A1, lda, m0, ((1 + rot) & km) << 6, aux, ss);
    load_b(tid, d0, d1, d2, d3, Bt, ldb, n0, ((1 + rot) & km) << 6);
    store_a<SS>(tid, L0, a0, a1, a2, a3, ss); store_tile(tid, L0 + 16384, b0, b1, b2, b3);
    __syncthreads();
#define SGB_PIPE() do { __builtin_amdgcn_sched_group_barrier(0x100, 8, 0); \
      _Pragma("unroll") for (int q_ = 0; q_ < 8; ++q_) { __builtin_amdgcn_sched_group_barrier(0x008, 1, 0); __builtin_amdgcn_sched_group_barrier(0x020, 1, 0); __builtin_amdgcn_sched_group_barrier(0x008, 1, 0); __builtin_amdgcn_sched_group_barrier(0x100, 1, 0); } \
      _Pragma("unroll") for (int q_ = 0; q_ < 8; ++q_) { __builtin_amdgcn_sched_group_barrier(0x008, 1, 0); __builtin_amdgcn_sched_group_barrier(0x200, 1, 0); __builtin_amdgcn_sched_group_barrier(0x008, 1, 0); } } while (0)
    for (int kt = 0; kt < nk; kt += 2) {
      const int k2 = ((min(kt + 2, km) + rot) & km) << 6, k3 = ((min(kt + 3, km) + rot) & km) << 6;
      load_a<AM, SS>(tid, a0, a1, a2, a3, A0, A1, lda, m0, k2, aux, ss); load_b(tid, b0, b1, b2, b3, Bt, ldb, n0, k2);
      mma_tile<SWAP>(acc, L0, wr, wc, fr, fq);
      store_a<SS>(tid, L1, c0, c1, c2, c3, ss); store_tile(tid, L1 + 16384, d0, d1, d2, d3);
      SGB_PIPE();
      __syncthreads();
      load_a<AM, SS>(tid, c0, c1, c2, c3, A0, A1, lda, m0, k3, aux, ss); load_b(tid, d0, d1, d2, d3, Bt, ldb, n0, k3);
      mma_tile<SWAP>(acc, L1, wr, wc, fr, fq);
      if (SS) { if (kt + 2 < nk) { ss[0] += ssq8(a0); ss[1] += ssq8(a1); ss[2] += ssq8(a2); ss[3] += ssq8(a3); } }
      store_tile(tid, L0, a0, a1, a2, a3); store_tile(tid, L0 + 16384, b0, b1, b2, b3);
      SGB_PIPE();
      __syncthreads();
    }
#undef SGB_PIPE
    asm volatile("s_waitcnt vmcnt(0)" ::: "memory");
  } else {
    load_a<AM, SS>(tid, a0, a1, a2, a3, A0, A1, lda, m0, (rot & km) << 6, aux, ss);
    load_b(tid, b0, b1, b2, b3, Bt, ldb, n0, (rot & km) << 6);
    store_a<SS>(tid, L0, a0, a1, a2, a3, ss); store_tile(tid, L0 + 16384, b0, b1, b2, b3);
    __syncthreads();
    for (int kt = 0; kt < nk; ++kt) {
      unsigned char* cur = smem + (kt & 1) * 32768;
      unsigned char* nxt = smem + ((kt + 1) & 1) * 32768;
      const bool more = (kt + 1 < nk);
      if (more) { load_a<AM, SS>(tid, a0, a1, a2, a3, A0, A1, lda, m0, ((kt + 1 + rot) & km) << 6, aux, ss); load_b(tid, b0, b1, b2, b3, Bt, ldb, n0, ((kt + 1 + rot) & km) << 6); }
      mma_tile<SWAP>(acc, cur, wr, wc, fr, fq);
      if (more) { store_a<SS>(tid, nxt, a0, a1, a2, a3, ss); store_tile(tid, nxt + 16384, b0, b1, b2, b3); }
      __syncthreads();
    }
  }
}
__device__ __forceinline__ void finish_rstd(float (&ss)[4], unsigned char* smem) {
  const int tid = tid_fresh(), r0 = tid >> 3, kc = tid & 7;
  float* rs = (float*)smem;
#pragma unroll
  for (int i = 0; i < 4; ++i) {
    float v = ss[i];
    v += __shfl_xor(v, 1); v += __shfl_xor(v, 2); v += __shfl_xor(v, 4);
    if (kc == 0) rs[r0 + 32 * i] = rsqrtf(v * (1.f / 1024.f) + 1e-6f);
  }
  __syncthreads();
}
__device__ __forceinline__ void zero_acc(f32x4 (&acc)[4][4]) {
#pragma unroll
  for (int m = 0; m < 4; ++m)
#pragma unroll
    for (int n = 0; n < 4; ++n) acc[m][n] = (f32x4){0.f, 0.f, 0.f, 0.f};
}

__device__ __forceinline__ bool tile_pick(int i, int nNt, int& mt, int& nt, int& L) {
  const int b = blockIdx.x;
  L = i * (int)gridDim.x + (b & 7) * ((int)gridDim.x >> 3) + (b >> 3);
  if (L >= 256 * nNt) return false;
  const int band = L / (8 * nNt), r = L - band * (8 * nNt), c = r >> 6, w = r & 63;
  mt = band * 8 + (w & 7); nt = c * 8 + (w >> 3);
  return true;
}

__device__ __forceinline__ void inproj_phase(const bf16_t* hb, const bf16_t* W, int ng, int wr0, int wr1, int wr2, int wr3,
                             bf16_t* d0, bf16_t* d1, bf16_t* d2, bf16_t* d3, int md0, int md1, int md2, int md3, unsigned char* smem, float* part = nullptr) {
  const int tid = tid_fresh(), wid = tid >> 6, lane = tid & 63, wr = wid >> 1, wc = wid & 1, fr = lane & 15, fq = lane >> 4;
  for (int i = 0;; ++i) {
    int mt, ntg, t;
    if (!tile_pick(i, ng * 8, mt, ntg, t)) break;
    const int grp = ntg >> 3, nt = ntg & 7;
    const int wrow = grp == 0 ? wr0 : grp == 1 ? wr1 : grp == 2 ? wr2 : wr3;
    bf16_t* dst = grp == 0 ? d0 : grp == 1 ? d1 : grp == 2 ? d2 : d3;
    const int mode = grp == 0 ? md0 : grp == 1 ? md1 : grp == 2 ? md2 : md3;
    const int m0 = mt * 128, n0 = nt * 128;
    f32x4 acc[4][4]; zero_acc(acc);
    float ss[4] = {0.f, 0.f, 0.f, 0.f};
    if (mode == 1) {
      gemm_mainloop<0, true, false>(acc, hb, nullptr, 1024, W + (size_t)wrow * 1024, 1024, m0, n0, 1024, 0, smem, ss, 0);
      finish_rstd(ss, smem);
      const float* rs = (const float*)smem;
#pragma unroll
      for (int m = 0; m < 4; ++m) {
        const int rl = wr * 64 + m * 16 + fq * 4;
        const float r0 = rs[rl], r1 = rs[rl + 1], r2 = rs[rl + 2], r3 = rs[rl + 3];
#pragma unroll
        for (int n = 0; n < 4; ++n) {
          const int col = n0 + wc * 64 + n * 16 + fr;
          uint2 o; o.x = pack2(acc[m][n][0] * r0, acc[m][n][1] * r1); o.y = pack2(acc[m][n][2] * r2, acc[m][n][3] * r3);
          *(uint2*)(dst + (size_t)col * TOK + m0 + rl) = o;
        }
      }
    } else {
      gemm_mainloop<0, true, true>(acc, hb, nullptr, 1024, W + (size_t)wrow * 1024, 1024, m0, n0, 1024, 0, smem, ss, 0);
      finish_rstd(ss, smem);
      const float* rs = (const float*)smem;
      uint2 old[4][4];
      if (mode == 2) {
#pragma unroll
        for (int m = 0; m < 4; ++m)
#pragma unroll
          for (int n = 0; n < 4; ++n) old[m][n] = *(const uint2*)(dst + (size_t)(m0 + wr * 64 + m * 16 + fr) * 1024 + n0 + wc * 64 + n * 16 + fq * 4);
      }
#pragma unroll
      for (int m = 0; m < 4; ++m) {
        const int rl = wr * 64 + m * 16 + fr;
        const float r = rs[rl];
        float psq = 0.f;
#pragma unroll
        for (int n = 0; n < 4; ++n) {
          const int col = n0 + wc * 64 + n * 16 + fq * 4;
          bf16_t* pd = dst + (size_t)(m0 + rl) * 1024 + col;
          float v0 = acc[m][n][0] * r, v1 = acc[m][n][1] * r, v2 = acc[m][n][2] * r, v3 = acc[m][n][3] * r;
          if (mode == 2) {
            v0 = lo_f(old[m][n].x) * silu_f(v0); v1 = hi_f(old[m][n].x) * silu_f(v1); v2 = lo_f(old[m][n].y) * silu_f(v2); v3 = hi_f(old[m][n].y) * silu_f(v3);
          }
          uint2 o; o.x = pack2(v0, v1); o.y = pack2(v2, v3);
          *(uint2*)pd = o;
          if (mode == 3) psq += v0 * v0 + v1 * v1 + v2 * v2 + v3 * v3;
        }
        if (mode == 3) {
          psq += __shfl_xor(psq, 16); psq += __shfl_xor(psq, 32);
          if (fq == 0) part[(size_t)(m0 + rl) * 16 + nt * 2 + wc] = psq;
        }
      }
    }
  }
}

__device__ __forceinline__ void outproj_phase(const bf16_t* MA, const bf16_t* MB, const bf16_t* Wt  , const float* hsrc, float* hres, bf16_t* hbB, unsigned char* smem) {
  const int tid = tid_fresh(), wid = tid >> 6, lane = tid & 63, wr = wid >> 1, wc = wid & 1, fr = lane & 15, fq = lane >> 4;
  for (int i = 0;; ++i) {
    int mt, nt, t;
    if (!tile_pick(i, 8, mt, nt, t)) break;
    const int m0 = mt * 128, n0 = nt * 128;
    f32x4 acc[4][4]; zero_acc(acc);
    float ss[4] = {0.f, 0.f, 0.f, 0.f};
    gemm_mainloop<2, false, true>(acc, MA, MB, 1024, Wt, 2048, m0, n0, 2048, 0, smem, ss, 0);
#pragma unroll
    for (int m = 0; m < 4; ++m) {
      const int row = m0 + wr * 64 + m * 16 + fr;
      const size_t idx = (size_t)row * 1024 + n0 + wc * 64 + fq * 4;
      float4 h[4];
#pragma unroll
      for (int n = 0; n < 4; ++n) h[n] = *(const float4*)(hsrc + idx + n * 16);
#pragma unroll
      for (int n = 0; n < 4; ++n) {
        const float4 o = make_float4(h[n].x + acc[m][n][0], h[n].y + acc[m][n][1], h[n].z + acc[m][n][2], h[n].w + acc[m][n][3]);
        *(float4*)(hres + idx + n * 16) = o;
        uint2 ob; ob.x = pack2(o.x, o.y); ob.y = pack2(o.z, o.w);
        *(uint2*)(hbB + idx + n * 16) = ob;
      }
    }
  }
}

__device__ __forceinline__ void ple_phase(const bf16_t* hbB, const float* pin  , const bf16_t* Wg  , const bf16_t* Wup  ,
                          float* hres, bf16_t* hbA, unsigned char* smem) {
  const int tid = tid_fresh(), wid = tid >> 6, lane = tid & 63, wr = wid >> 1, wc = wid & 1, fr = lane & 15, fq = lane >> 4;
  for (int i = 0;; ++i) {
    int mt, nt, t;
    if (!tile_pick(i, 8, mt, nt, t)) break;
    const int m0 = mt * 128, n0 = nt * 128;
    f32x4 ag[4][4]; zero_acc(ag);
    float ss[4] = {0.f, 0.f, 0.f, 0.f};
    gemm_mainloop<0, true, true>(ag, hbB, nullptr, 1024, Wg, 1024, m0, n0, 1024, 0, smem, ss, 0);
    finish_rstd(ss, smem);
    unsigned gp[4][4][2];
    {
      const float* rs = (const float*)smem;
#pragma unroll
      for (int m = 0; m < 4; ++m) {
        const float r = rs[wr * 64 + m * 16 + fr];
#pragma unroll
        for (int n = 0; n < 4; ++n) {
          gp[m][n][0] = pack2(sigmoid_f(r * ag[m][n][0]), sigmoid_f(r * ag[m][n][1]));
          gp[m][n][1] = pack2(sigmoid_f(r * ag[m][n][2]), sigmoid_f(r * ag[m][n][3]));
        }
      }
    }
    zero_acc(ag);
    float ss2[4] = {0.f, 0.f, 0.f, 0.f};
    gemm_mainloop<1, false, true>(ag, pin, nullptr, 256, Wup, 256, m0, n0, 256, 0, smem, ss2, 0);
#pragma unroll
    for (int m = 0; m < 4; ++m) {
      const int rl = wr * 64 + m * 16 + fr;
      const size_t idx = (size_t)(m0 + rl) * 1024 + n0 + wc * 64 + fq * 4;
      float4 h[4];
#pragma unroll
      for (int n = 0; n < 4; ++n) h[n] = *(const float4*)(hres + idx + n * 16);
#pragma unroll
      for (int n = 0; n < 4; ++n) {
        float4 o;
        o.x = h[n].x + ag[m][n][0] * lo_f(gp[m][n][0]);
        o.y = h[n].y + ag[m][n][1] * hi_f(gp[m][n][0]);
        o.z = h[n].z + ag[m][n][2] * lo_f(gp[m][n][1]);
        o.w = h[n].w + ag[m][n][3] * hi_f(gp[m][n][1]);
        *(float4*)(hres + idx + n * 16) = o;
        uint2 ob; ob.x = pack2(o.x, o.y); ob.y = pack2(o.z, o.w);
        *(uint2*)(hbA + idx + n * 16) = ob;
      }
    }
  }
}

__device__ __forceinline__ void pool_phase(const bf16_t* XC, const bf16_t* Wp  , const float* pb, const float* ps, bf16_t* MC, unsigned char* smem) {
  const int tid = tid_fresh(), wid = tid >> 6, lane = tid & 63, wr = wid >> 1, wc = wid & 1, fr = lane & 15, fq = lane >> 4;
  unsigned char* sA = smem;
  unsigned char* sB = smem + 16384;
  unsigned char* sXs = smem + 32768;
  for (int t = blockIdx.x; t < 2048; t += gridDim.x) {
    const int mt = t >> 3, g = (t >> 1) & 3, nt = t & 1, m0 = mt * 128, n0 = nt * 128;
    const int half = 1 << g;
    const int tb0 = m0 & (SEQ - 1);
    const bf16_t* Bt = Wp + (size_t)g * 65536;
    f32x4 acc[4][4]; zero_acc(acc);
    uint4 xr[5], b0, b1, b2, b3;
#pragma unroll
    for (int i = 0; i < 5; ++i) {
      const int id = tid + 256 * i, row = id >> 3, kc = id & 7, tb = tb0 - 8 + row;
      xr[i] = (id < 1152 && tb >= 0 && tb < SEQ) ? *(const uint4*)(XC + (size_t)(m0 - 8 + row) * 1024 + g * 256 + kc * 8) : make_uint4(0u, 0u, 0u, 0u);
    }
    load_b(tid, b0, b1, b2, b3, Bt, 256, n0, 0);
    __syncthreads();
#pragma unroll 1
    for (int ks = 0; ks < 4; ++ks) {
#pragma unroll
      for (int i = 0; i < 5; ++i) { const int id = tid + 256 * i; if (id < 1152) *(uint4*)(sXs + id * 16) = xr[i]; }
      store_tile(tid, sB, b0, b1, b2, b3);
      __syncthreads();
      if (ks < 3) {
        const int k1 = (ks + 1) * 64;
#pragma unroll
        for (int i = 0; i < 5; ++i) {
          const int id = tid + 256 * i, row = id >> 3, kc = id & 7, tb = tb0 - 8 + row;
          xr[i] = (id < 1152 && tb >= 0 && tb < SEQ) ? *(const uint4*)(XC + (size_t)(m0 - 8 + row) * 1024 + g * 256 + k1 + kc * 8) : make_uint4(0u, 0u, 0u, 0u);
        }
        load_b(tid, b0, b1, b2, b3, Bt, 256, n0, k1);
      }
#pragma unroll
      for (int i = 0; i < 4; ++i) {
        const int row = (tid >> 3) + 32 * i, kc = tid & 7, tb = tb0 + row;
        const int lo = max(tb - half, 0), hi = min(tb + half, SEQ);
        float s0 = 0.f, s1 = 0.f, s2 = 0.f, s3 = 0.f, s4 = 0.f, s5 = 0.f, s6 = 0.f, s7 = 0.f;
        for (int tt = lo; tt < hi; ++tt) {
          const uint4 u = *(const uint4*)(sXs + (tt - tb0 + 8) * 128 + kc * 16);
          s0 += lo_f(u.x); s1 += hi_f(u.x); s2 += lo_f(u.y); s3 += hi_f(u.y); s4 += lo_f(u.z); s5 += hi_f(u.z); s6 += lo_f(u.w); s7 += hi_f(u.w);
        }
        const uint4 u = *(const uint4*)(sXs + (row + 8) * 128 + kc * 16);
        const float inv = 1.f / (float)(hi - lo);
        *(uint4*)(sA + swz(row, kc)) = make_uint4(pack2(s0 * inv - lo_f(u.x), s1 * inv - hi_f(u.x)), pack2(s2 * inv - lo_f(u.y), s3 * inv - hi_f(u.y)),
                                                  pack2(s4 * inv - lo_f(u.z), s5 * inv - hi_f(u.z)), pack2(s6 * inv - lo_f(u.w), s7 * inv - hi_f(u.w)));
      }
      __syncthreads();
      mma_tile<true>(acc, smem, wr, wc, fr, fq);
      __syncthreads();
    }
#pragma unroll
    for (int m = 0; m < 4; ++m) {
      const int row = m0 + wr * 64 + m * 16 + fr;
#pragma unroll
      for (int n = 0; n < 4; ++n) {
        const int col = g * 256 + n0 + wc * 64 + n * 16 + fq * 4;
        const float4 b = *(const float4*)(pb + col), sc = *(const float4*)(ps + col);
        uint2 o; o.x = pack2((acc[m][n][0] + b.x) * sc.x, (acc[m][n][1] + b.y) * sc.y); o.y = pack2((acc[m][n][2] + b.z) * sc.z, (acc[m][n][3] + b.w) * sc.w);
        *(uint2*)(MC + (size_t)row * 1024 + col) = o;
      }
    }
  }
}

__device__ __forceinline__ void gmlp_phase(bf16_t* UB, const bf16_t* VB, const bf16_t* Ws  , const float* gmg, const float* gbs  , const float* part, unsigned char* smem) {
  const int tid = tid_fresh(), wid = tid >> 6, lane = tid & 63, wr = wid >> 1, wc = wid & 1, fr = lane & 15, fq = lane >> 4;
  unsigned char* sW = smem;
  unsigned char* sX = smem + 32768;
  for (int it = blockIdx.x; it < 2048; it += gridDim.x) {
    const int g = it & 7, tok0 = (it >> 3) * 128;
    __syncthreads();
#pragma unroll 2
    for (int i = 0; i < 8; ++i) {
      const int id = tid + 256 * i, row = id >> 4, kc = id & 15;
      *(uint4*)(sW + row * 256 + ((kc ^ (row & 15)) << 4)) = *(const uint4*)(Ws + (size_t)g * 16384 + row * 128 + kc * 8);
    }
    float rq;
    {
      const float4* pp = (const float4*)(part + (size_t)(tok0 + (tid & 127)) * 16);
      const float4 p0 = pp[0], p1 = pp[1], p2 = pp[2], p3 = pp[3];
      const float sq = (p0.x + p0.y + p0.z + p0.w) + (p1.x + p1.y + p1.z + p1.w) + (p2.x + p2.y + p2.z + p2.w) + (p3.x + p3.y + p3.z + p3.w);
      rq = rsqrtf(sq * (1.f / 1024.f) + 1e-6f);
    }
    __syncthreads();
#pragma unroll 2
    for (int i = 0; i < 8; ++i) {
      const int id = tid + 256 * i, q = id & 127, cc = id >> 7;
      float f[8]; unpack8(*(const uint4*)(VB + (size_t)(tok0 + q) * 1024 + g * 128 + cc * 8), f);
#pragma unroll
      for (int e = 0; e < 8; ++e) {
        const int c = cc * 8 + e;
        const float v = f[e] * rq * gmg[g * 128 + c];
        *(bf16_t*)(sX + c * 256 + (((q >> 3) ^ (c & 15)) << 4) + (q & 7) * 2) = f2bf(v);
      }
    }
    __syncthreads();
    f32x4 acc[4][4]; zero_acc(acc);
#pragma unroll
    for (int s = 0; s < 4; ++s) {
      bf16x8 af[4], bfr[4];
#pragma unroll
      for (int m = 0; m < 4; ++m) { const int row = wr * 64 + m * 16 + fr; af[m] = *(const bf16x8*)(sW + row * 256 + (((s * 4 + fq) ^ (row & 15)) << 4)); }
#pragma unroll
      for (int n = 0; n < 4; ++n) { const int row = wc * 64 + n * 16 + fr; bfr[n] = *(const bf16x8*)(sX + row * 256 + (((s * 4 + fq) ^ (row & 15)) << 4)); }
#pragma unroll
      for (int m = 0; m < 4; ++m)
#pragma unroll
        for (int n = 0; n < 4; ++n) acc[m][n] = __builtin_amdgcn_mfma_f32_16x16x32_bf16(bfr[n], af[m], acc[m][n], 0, 0, 0);
    }
    uint2 uo[4][4];
#pragma unroll
    for (int m = 0; m < 4; ++m)
#pragma unroll
      for (int n = 0; n < 4; ++n) uo[m][n] = *(const uint2*)(UB + (size_t)(tok0 + wr * 64 + m * 16 + fr) * 1024 + g * 128 + wc * 64 + n * 16 + fq * 4);
#pragma unroll
    for (int m = 0; m < 4; ++m) {
      const int p = wr * 64 + m * 16 + fr;
      const float bias = gbs[g * 128 + p];
#pragma unroll
      for (int n = 0; n < 4; ++n) {
        const int c = wc * 64 + n * 16 + fq * 4;
        bf16_t* pd = UB + (size_t)(tok0 + p) * 1024 + g * 128 + c;
        const uint2 u = uo[m][n];
        uint2 o; o.x = pack2(lo_f(u.x) * (acc[m][n][0] + bias), hi_f(u.x) * (acc[m][n][1] + bias));
        o.y = pack2(lo_f(u.y) * (acc[m][n][2] + bias), hi_f(u.y) * (acc[m][n][3] + bias));
        *(uint2*)pd = o;
      }
    }
  }
}

__device__ __forceinline__ void na_phase(bf16_t* Q, const bf16_t* Kb, const bf16_t* Vt, const float* rpb, unsigned char* smem) {
  const int tid = tid_fresh(), wq = tid >> 6, lane = tid & 63, fr = lane & 15, fq = lane >> 4;
  for (int it = blockIdx.x; it < 8 * 64 * 16; it += gridDim.x) {
    const int h = it & 15, r = (it >> 4) & 63, b = it >> 10;
    const int rs = min(max(r - 4, 0), 56);
    const int w0 = (wq == 0) ? 0 : (wq == 1) ? 8 : (wq == 2) ? 24 : 32;
    const int qc = wq * 16 + fr;
    const int tokq = b * 4096 + r * 64 + qc;
    const bf16x8 qf0 = *(const bf16x8*)(Q + (size_t)tokq * 1024 + h * 64 + fq * 8);
    const bf16x8 qf1 = *(const bf16x8*)(Q + (size_t)tokq * 1024 + h * 64 + 32 + fq * 8);
    const int cs = min(max(qc - 8, 0), 48);
    const float* rp = rpb + h * (15 * 31);
    const size_t tok0 = (size_t)b * 4096 + rs * 64;
    __syncthreads();
#pragma unroll 1
    for (int i0 = 0; i0 < 16; i0 += 16) {
      uint4 kv[16];
#pragma unroll
      for (int i = 0; i < 16; ++i) {
        const int id = tid + 256 * (i0 + i), key = id >> 3, kc = id & 7;
        kv[i] = *(const uint4*)(Kb + (tok0 + key) * 1024 + h * 64 + kc * 8);
      }
#pragma unroll
      for (int i = 0; i < 16; ++i) {
        const int id = tid + 256 * (i0 + i), key = id >> 3, kc = id & 7;
        *(uint4*)(smem + key * 128 + ((kc ^ ((key >> 1) & 7)) << 4)) = kv[i];
      }
    }
    __syncthreads();
    uint4 vvA[4];
#pragma unroll
    for (int i = 0; i < 4; ++i) {
      const int id = tid + 256 * i, d = id >> 6, c16 = id & 63;
      vvA[i] = *(const uint4*)(Vt + (size_t)(h * 64 + d) * TOK + tok0 + c16 * 8);
    }
    f32x4 sc[8][2];
    float mx = -1e30f;
#pragma unroll
    for (int jr = 0; jr < 8; ++jr) {
#pragma unroll
      for (int hc = 0; hc < 2; ++hc) {
        const int key = jr * 64 + w0 + 8 * (fr >> 2) + 4 * hc + (fr & 3);
        const unsigned char* kp = smem + key * 128;
        const int kx = (key >> 1) & 7;
        const bf16x8 kf0 = *(const bf16x8*)(kp + ((fq ^ kx) << 4));
        const bf16x8 kf1 = *(const bf16x8*)(kp + (((4 + fq) ^ kx) << 4));
        f32x4 a = (f32x4){0.f, 0.f, 0.f, 0.f};
        a = __builtin_amdgcn_mfma_f32_16x16x32_bf16(kf0, qf0, a, 0, 0, 0);
        a = __builtin_amdgcn_mfma_f32_16x16x32_bf16(kf1, qf1, a, 0, 0, 0);
        const int dr = rs + jr - r + 7;
#pragma unroll
        for (int e = 0; e < 4; ++e) {
          const int kcol = w0 + 8 * fq + 4 * hc + e;
          const bool valid = (kcol >= cs) && (kcol < cs + 16);
          const int dc = min(max(kcol - qc + 15, 0), 30);
          const float v = valid ? (a[e] * 0.125f + rp[dr * 31 + dc]) : -1e30f;
          a[e] = v; mx = fmaxf(mx, v);
        }
        sc[jr][hc] = a;
      }
    }
    mx = fmaxf(mx, __shfl_xor(mx, 16)); mx = fmaxf(mx, __shfl_xor(mx, 32));
    float sum = 0.f;
#pragma unroll
    for (int jr = 0; jr < 8; ++jr)
#pragma unroll
      for (int hc = 0; hc < 2; ++hc)
#pragma unroll
        for (int e = 0; e < 4; ++e) { const float pv = (sc[jr][hc][e] > -1e29f) ? __expf(sc[jr][hc][e] - mx) : 0.f; sc[jr][hc][e] = pv; sum += pv; }
    sum += __shfl_xor(sum, 16); sum += __shfl_xor(sum, 32);
    const float inv = 1.f / sum;
    __syncthreads();
    {
#pragma unroll
      for (int i = 0; i < 4; ++i) {
        const int id = tid + 256 * i, d = id >> 6, c16 = id & 63;
        *(uint4*)(smem + d * 1024 + ((c16 ^ (d & 15)) << 4)) = vvA[i];
      }
#pragma unroll 1
      for (int i0 = 4; i0 < 16; i0 += 6) {
        uint4 vvB[6];
#pragma unroll
        for (int i = 0; i < 6; ++i) {
          const int id = tid + 256 * (i0 + i), d = id >> 6, c16 = id & 63;
          vvB[i] = *(const uint4*)(Vt + (size_t)(h * 64 + d) * TOK + tok0 + c16 * 8);
        }
#pragma unroll
        for (int i = 0; i < 6; ++i) {
          const int id = tid + 256 * (i0 + i), d = id >> 6, c16 = id & 63;
          *(uint4*)(smem + d * 1024 + ((c16 ^ (d & 15)) << 4)) = vvB[i];
        }
      }
    }
    __syncthreads();
    f32x4 o[4];
#pragma unroll
    for (int dt = 0; dt < 4; ++dt) o[dt] = (f32x4){0.f, 0.f, 0.f, 0.f};
#pragma unroll
    for (int jr = 0; jr < 8; ++jr) {
      union { bf16x8 v; unsigned u[4]; } pf;
      pf.u[0] = pack2(sc[jr][0][0] * inv, sc[jr][0][1] * inv); pf.u[1] = pack2(sc[jr][0][2] * inv, sc[jr][0][3] * inv);
      pf.u[2] = pack2(sc[jr][1][0] * inv, sc[jr][1][1] * inv); pf.u[3] = pack2(sc[jr][1][2] * inv, sc[jr][1][3] * inv);
      const int c16 = jr * 8 + (w0 >> 3) + fq;
#pragma unroll
      for (int dt = 0; dt < 4; ++dt) {
        const int d = dt * 16 + fr;
        const bf16x8 vf = *(const bf16x8*)(smem + d * 1024 + ((c16 ^ (d & 15)) << 4));
        o[dt] = __builtin_amdgcn_mfma_f32_16x16x32_bf16(vf, pf.v, o[dt], 0, 0, 0);
      }
    }
#pragma unroll
    for (int dt = 0; dt < 4; ++dt) {
      uint2 ob; ob.x = pack2(o[dt][0], o[dt][1]); ob.y = pack2(o[dt][2], o[dt][3]);
      *(uint2*)(Q + (size_t)tokq * 1024 + h * 64 + dt * 16 + fq * 4) = ob;
    }
  }
}

__device__ __forceinline__ float2 cmul(float2 a, float2 b) { return make_float2(a.x * b.x - a.y * b.y, a.x * b.y + a.y * b.x); }
__device__ __forceinline__ float2 cadd(float2 a, float2 b) { return make_float2(a.x + b.x, a.y + b.y); }
__device__ __forceinline__ float2 csub(float2 a, float2 b) { return make_float2(a.x - b.x, a.y - b.y); }

template <bool DIF>
__device__ __forceinline__ void bfly(float2& a, float2& b, float2 w) {
  if (DIF) { const float2 s = cadd(a, b), d = csub(a, b); a = s; b = cmul(d, w); }
  else { const float2 t = cmul(b, w); const float2 s = cadd(a, t), d = csub(a, t); a = s; b = d; }
}
#define PH(i) ((i) ^ (((i) >> 4) & 7))
template <bool DIF, int HALF = 0>
__device__ __forceinline__ void fft_r8(float2* buf, const float2* __restrict__ T, int lq) {
  const int q = 1 << lq, sA = 1024 >> lq;
  for (int g = tid_fresh(); g < 1024; g += NT) {
    const int j0 = g & (q - 1), i0 = ((g >> lq) << (lq + 3)) + j0;
    float2 x[8];
#pragma unroll
    for (int p = 0; p < 8; ++p) x[p] = (HALF == 1 && p >= 4) ? make_float2(0.f, 0.f) : buf[PH(i0 + p * q)];
    const float2 w1 = T[j0 * sA];
    const float2 w2 = cmul(w1, w1), w4 = cmul(w2, w2);
    const float cs8 = 0.70710678118654752f;
    const float2 tA1 = make_float2(cs8 * (w1.x + w1.y), cs8 * (w1.y - w1.x));
    const float2 tA2 = make_float2(w1.y, -w1.x);
    const float2 tA3 = make_float2(cs8 * (w1.y - w1.x), -cs8 * (w1.x + w1.y));
    const float2 tB1 = make_float2(w2.y, -w2.x);
    if (DIF) {
      bfly<true>(x[0], x[4], w1); bfly<true>(x[1], x[5], tA1); bfly<true>(x[2], x[6], tA2); bfly<true>(x[3], x[7], tA3);
      bfly<true>(x[0], x[2], w2); bfly<true>(x[4], x[6], w2); bfly<true>(x[1], x[3], tB1); bfly<true>(x[5], x[7], tB1);
      bfly<true>(x[0], x[1], w4); bfly<true>(x[2], x[3], w4); bfly<true>(x[4], x[5], w4); bfly<true>(x[6], x[7], w4);
    } else {
      bfly<false>(x[0], x[1], w4); bfly<false>(x[2], x[3], w4); bfly<false>(x[4], x[5], w4); bfly<false>(x[6], x[7], w4);
      bfly<false>(x[0], x[2], w2); bfly<false>(x[4], x[6], w2); bfly<false>(x[1], x[3], tB1); bfly<false>(x[5], x[7], tB1);
      bfly<false>(x[0], x[4], w1); bfly<false>(x[1], x[5], tA1); bfly<false>(x[2], x[6], tA2); bfly<false>(x[3], x[7], tA3);
    }
#pragma unroll
    for (int p = 0; p < 8; ++p) if (!(HALF == 2 && p >= 4)) buf[PH(i0 + p * q)] = x[p];
  }
  __syncthreads();
}
__device__ __forceinline__ void fft_r2(float2* buf) {
  for (int g = tid_fresh(); g < 4096; g += NT) {
    const int i0 = PH(2 * g), i1 = PH(2 * g + 1);
    const float2 a = buf[i0], b = buf[i1];
    buf[i0] = make_float2(a.x + b.x, a.y + b.y); buf[i1] = make_float2(a.x - b.x, a.y - b.y);
  }
  __syncthreads();
}
__device__ __forceinline__ void fft_dif(float2* buf, const float2* T) { fft_r8<true>(buf, T, 10); fft_r8<true>(buf, T, 7); fft_r8<true>(buf, T, 4); fft_r8<true>(buf, T, 1); fft_r2(buf); }
__device__ __forceinline__ void fft_dit(float2* buf, const float2* T) { fft_r2(buf); fft_r8<false>(buf, T, 1); fft_r8<false>(buf, T, 4); fft_r8<false>(buf, T, 7); fft_r8<false>(buf, T, 10); }
__device__ __forceinline__ void fft_dif_zp(float2* buf, const float2* T) { fft_r8<true, 1>(buf, T, 10); fft_r8<true>(buf, T, 7); fft_r8<true>(buf, T, 4); fft_r8<true>(buf, T, 1); fft_r2(buf); }
__device__ __forceinline__ void fft_dit_lo(float2* buf, const float2* T) { fft_r2(buf); fft_r8<false>(buf, T, 1); fft_r8<false>(buf, T, 4); fft_r8<false>(buf, T, 7); fft_r8<false, 2>(buf, T, 10); }
__device__ __forceinline__ int brev13(int k) { return (int)(__brev((unsigned)k) >> 19); }

__device__ __forceinline__ void hyena_feats(float* h3, unsigned char* smem) {
  KP PP = params_fresh();
  float* hin = (float*)smem;
  const int tid = tid_fresh(), r = tid >> 6, u = tid & 63;
  for (int it = blockIdx.x; it < 2048; it += gridDim.x) {
    const int j = it >> 10, l = (it & 1023) * 4 + r;
    const float* w0 = PP->in[I_HW0] + j * 33 * 64; const float* b0 = PP->in[I_HB0] + j * 64;
    const float* w1 = PP->in[I_HW1] + j * 4096; const float* b1 = PP->in[I_HB1] + j * 64;
    const float* w2 = PP->in[I_HW2] + j * 4096; const float* b2 = PP->in[I_HB2] + j * 64;
    const float fr = PP->in[I_HFREQ][j * 64 + u];
    __syncthreads();
    {
      const float tt = (float)l / 4095.f;
      const float ang = 6.283185307179586f * (float)l / 4096.f;
      float f = 0.f;
      if (u == 0) f = tt;
      else if (u <= 16) { const float band = 1e-4f + (float)(u - 1) * ((15.f - 1e-4f) / 15.f); f = cosf(band * ang); }
      else if (u <= 32) { const float band = 1e-4f + (float)(u - 17) * ((15.f - 1e-4f) / 15.f); f = -sinf(band * ang); }
      hin[r * 64 + u] = f;
    }
    __syncthreads();
    float a = b0[u];
    for (int k = 0; k < 33; ++k) a += hin[r * 64 + k] * w0[k * 64 + u];
    float v = sinf(fr * a);
    __syncthreads(); hin[r * 64 + u] = v; __syncthreads();
    a = b1[u];
    for (int k = 0; k < 64; ++k) a += hin[r * 64 + k] * w1[k * 64 + u];
    v = sinf(fr * a);
    __syncthreads(); hin[r * 64 + u] = v; __syncthreads();
    a = b2[u];
    for (int k = 0; k < 64; ++k) a += hin[r * 64 + k] * w2[k * 64 + u];
    v = sinf(fr * a);
    h3[((size_t)j * 4096 + l) * 64 + u] = v;
  }
}

__device__ __forceinline__ void filtgen_phase(const float* hwout, int j, const float* h3, float* kT, unsigned char* smem) {
  float* hs = (float*)smem;
  float* wsm = (float*)(smem + 32768);
  const int tid = tid_fresh(), tl = tid & 15, tc = tid >> 4;
  const float* wout = hwout + (size_t)j * 64 * 2048;
  const float mind = logf(0.01f) / 1.5f, maxd = logf(0.01f) / 0.3f;
  for (int it = blockIdx.x; it < 2048; it += gridDim.x) {
    const int l0 = (it & 63) * 64, c0 = (it >> 6) * 64;
    __syncthreads();
#pragma unroll
    for (int i = 0; i < 4; ++i) {
      const int id = tid + 256 * i, r = id >> 4, c4 = id & 15;
      const float4 hv = *(const float4*)(h3 + ((size_t)j * 4096 + l0 + r) * 64 + c4 * 4);
      float* d = hs + r * 65 + c4 * 4; d[0] = hv.x; d[1] = hv.y; d[2] = hv.z; d[3] = hv.w;
      *(float4*)(wsm + r * 64 + c4 * 4) = *(const float4*)(wout + (size_t)r * 2048 + c0 + c4 * 4);
    }
    __syncthreads();
    float acc[4][4];
#pragma unroll
    for (int i = 0; i < 4; ++i)
#pragma unroll
      for (int k = 0; k < 4; ++k) acc[i][k] = 0.f;
#pragma unroll 4
    for (int u = 0; u < 64; ++u) {
      const float4 w = *(const float4*)(wsm + u * 64 + tc * 4);
#pragma unroll
      for (int i = 0; i < 4; ++i) {
        const float hv = hs[(tl * 4 + i) * 65 + u];
        acc[i][0] += hv * w.x; acc[i][1] += hv * w.y; acc[i][2] += hv * w.z; acc[i][3] += hv * w.w;
      }
    }
#pragma unroll
    for (int k = 0; k < 4; ++k) {
      const int col = c0 + tc * 4 + k, c = col & 1023;
      const float dl = fabsf(mind + (float)c * ((maxd - mind) / 1023.f));
      float4 o;
      o.x = acc[0][k] * expf(-((float)(l0 + tl * 4 + 0) / 4095.f) * dl);
      o.y = acc[1][k] * expf(-((float)(l0 + tl * 4 + 1) / 4095.f) * dl);
      o.z = acc[2][k] * expf(-((float)(l0 + tl * 4 + 2) / 4095.f) * dl);
      o.w = acc[3][k] * expf(-((float)(l0 + tl * 4 + 3) / 4095.f) * dl);
      *(float4*)(kT + (size_t)col * 4096 + l0 + tl * 4) = o;
    }
  }
}

__device__ __forceinline__ void spectrum_phase(const float* kT, const float2* T, float4* spec, unsigned char* smem) {
  float2* buf = (float2*)smem;
  float* red = (float*)smem;
  const int tid = tid_fresh(), lane = tid & 63, wid = tid >> 6;
  for (int pi = blockIdx.x; pi < 512; pi += gridDim.x) {
    const int c1 = 2 * pi;
    const float* f0 = kT + (size_t)c1 * 4096;
    const float* b0 = kT + (size_t)(1024 + c1) * 4096;
    __syncthreads();
    float s1 = 0.f, s2 = 0.f;
#pragma unroll 4
    for (int i = 0; i < 16; ++i) {
      const int l = tid + 256 * i;
      const float a00 = f0[l], a01 = f0[4096 + l], a10 = b0[l], a11 = b0[4096 + l];
      s1 += a00 * a00; s2 += a01 * a01;
      if (l != 0) { s1 += a10 * a10; s2 += a11 * a11; }
    }
#pragma unroll
    for (int o = 32; o > 0; o >>= 1) { s1 += __shfl_xor(s1, o); s2 += __shfl_xor(s2, o); }
    if (lane == 0) { red[wid * 2] = s1; red[wid * 2 + 1] = s2; }
    __syncthreads();
    s1 = red[0] + red[2] + red[4] + red[6]; s2 = red[1] + red[3] + red[5] + red[7];
    __syncthreads();
#pragma unroll 4
    for (int i = 0; i < 16; ++i) {
      const int l = tid + 256 * i;
      const float a00 = f0[l], a01 = f0[4096 + l], a10 = b0[l], a11 = b0[4096 + l];
      buf[PH(l)] = make_float2(a00, a01);
      if (l == 0) buf[PH(4096)] = make_float2(0.f, 0.f);
      else buf[PH(8192 - l)] = make_float2(a10, a11);
    }
    __syncthreads();
    const float sc1 = rsqrtf(s1 + 1e-6f) * (1.f / 8192.f);
    const float sc2 = rsqrtf(s2 + 1e-6f) * (1.f / 8192.f);
    fft_dif(buf, T);
    for (int k = tid; k <= 4096; k += NT) {
      const int pk_ = brev13(k), pn_ = brev13((8192 - k) & 8191);
      const float2 Pk = buf[PH(pk_)], Fn = buf[PH(pn_)];
      const float2 Qc = make_float2(Fn.x, -Fn.y);
      const float2 H1 = make_float2(0.5f * (Pk.x + Qc.x) * sc1, 0.5f * (Pk.y + Qc.y) * sc1);
      const float2 H2 = make_float2(0.5f * (Pk.y - Qc.y) * sc2, -0.5f * (Pk.x - Qc.x) * sc2);
      spec[(size_t)pi * SPEC_STRIDE + k] = make_float4(0.5f * (H1.x + H2.x), 0.5f * (H1.y + H2.y), 0.5f * (H1.x - H2.x), 0.5f * (H1.y - H2.y));
    }
  }
}

__device__ __forceinline__ void z_phase(const bf16_t* X1, const bf16_t* V, const float* cw  , const float* cb  , bf16_t* zT, unsigned char* smem) {
  float* zs = (float*)smem;
  const int tid = tid_fresh(), c8 = tid & 7, tr = tid >> 3;
  for (int it = blockIdx.x; it < 8192; it += gridDim.x) {
    const int ct = it & 15, tt = it >> 4, c0 = ct * 64, t0 = tt * 64;
    __syncthreads();
    const int c = c0 + c8 * 8;
    float w1[3][8], w2[3][8], bb1[8], bb2[8];
#pragma unroll
    for (int e = 0; e < 8; ++e) {
#pragma unroll
      for (int k = 0; k < 3; ++k) { w1[k][e] = cw[k * 3072 + 1024 + c + e]; w2[k][e] = cw[k * 3072 + 2048 + c + e]; }
      bb1[e] = cb[1024 + c + e]; bb2[e] = cb[2048 + c + e];
    }
#pragma unroll
    for (int i = 0; i < 2; ++i) {
      const int tl = tr + 32 * i, t = t0 + tl, tb = t & (SEQ - 1);
      float a1[8], a2[8];
#pragma unroll
      for (int e = 0; e < 8; ++e) { a1[e] = bb1[e]; a2[e] = bb2[e]; }
#pragma unroll
      for (int k = 0; k < 3; ++k) {
        const int tbk = tb + k - 1;
        if (tbk >= 0 && tbk < SEQ) {
          float f[8], g[8];
          unpack8(*(const uint4*)(X1 + (size_t)(t + k - 1) * 1024 + c), f);
          unpack8(*(const uint4*)(V + (size_t)(t + k - 1) * 1024 + c), g);
#pragma unroll
          for (int e = 0; e < 8; ++e) { a1[e] += w1[k][e] * f[e]; a2[e] += w2[k][e] * g[e]; }
        }
      }
#pragma unroll
      for (int e = 0; e < 8; ++e) zs[(c8 * 8 + e) * 65 + tl] = a1[e] * a2[e];
    }
    __syncthreads();
    {
      const int cl = tid >> 2, tq = tid & 3;
      const int bidx = t0 >> 12, tbase = t0 & (SEQ - 1);
      bf16_t* dst = zT + ((size_t)(bidx * 1024 + c0 + cl)) * SEQ + tbase + tq * 16;
      const float* sr = zs + cl * 65 + tq * 16;
      *(uint4*)dst = make_uint4(pack2(sr[0], sr[1]), pack2(sr[2], sr[3]), pack2(sr[4], sr[5]), pack2(sr[6], sr[7]));
      *(uint4*)(dst + 8) = make_uint4(pack2(sr[8], sr[9]), pack2(sr[10], sr[11]), pack2(sr[12], sr[13]), pack2(sr[14], sr[15]));
    }
  }
}

__device__ __forceinline__ void fftconv_phase(bf16_t* zT, const float4* spec, const float2* T, const float* hd, unsigned char* smem) {
  float2* buf = (float2*)smem;
  const int tid = tid_fresh();
  for (int it = blockIdx.x; it < 4096; it += gridDim.x) {
    const int b = (it >> 3) & 7, pi = (it & 7) + 8 * (it >> 6), c1 = 2 * pi;
    bf16_t* z1 = zT + ((size_t)(b * 1024 + c1)) * SEQ;
    bf16_t* z2 = z1 + SEQ;
    __syncthreads();
    for (int t = tid; t < 4096; t += NT) buf[PH(t)] = make_float2(bf2f(z1[t]), bf2f(z2[t]));
    __syncthreads();
    fft_r8<true, 1>(buf, T, 10); fft_r8<true>(buf, T, 7); fft_r8<true>(buf, T, 4); fft_r8<true>(buf, T, 1);
    const float4* sp = spec + (size_t)pi * SPEC_STRIDE;
    for (int f = tid; f <= 2048; f += NT) {
      const int p0 = brev13(f);
      const float2 a0 = buf[PH(p0)], b0 = buf[PH(p0 + 1)];
      const float2 Xf = cadd(a0, b0), Xf4 = csub(a0, b0);
      const float4 s1 = sp[f];
      const float2 S1 = make_float2(s1.x, s1.y), D1 = make_float2(s1.z, s1.w);
      if (f == 0 || f == 2048) {
        float2 W0, W1;
        if (f == 0) {
          const float4 s2 = sp[4096];
          W0 = cadd(cmul(Xf, S1), cmul(make_float2(Xf.x, -Xf.y), D1));
          W1 = cadd(cmul(Xf4, make_float2(s2.x, s2.y)), cmul(make_float2(Xf4.x, -Xf4.y), make_float2(s2.z, s2.w)));
        } else {
          W0 = cadd(cmul(Xf, S1), cmul(make_float2(Xf4.x, -Xf4.y), D1));
          W1 = cadd(cmul(Xf4, make_float2(S1.x, -S1.y)), cmul(make_float2(Xf.x, -Xf.y), make_float2(D1.x, -D1.y)));
        }
        const float2 c0 = make_float2(W0.x, -W0.y), c1 = make_float2(W1.x, -W1.y);
        buf[PH(p0)] = cadd(c0, c1); buf[PH(p0 + 1)] = csub(c0, c1);
      } else {
        const int fp = 4096 - f, p1 = brev13(fp);
        const float2 a1 = buf[PH(p1)], b1 = buf[PH(p1 + 1)];
        const float2 Xg = cadd(a1, b1), Xg4 = csub(a1, b1);
        const float4 s2 = sp[fp];
        const float2 S2 = make_float2(s2.x, s2.y), D2 = make_float2(s2.z, s2.w);
        const float2 Wf  = cadd(cmul(Xf, S1), cmul(make_float2(Xg4.x, -Xg4.y), D1));
        const float2 Wg4 = cadd(cmul(Xg4, make_float2(S1.x, -S1.y)), cmul(make_float2(Xf.x, -Xf.y), make_float2(D1.x, -D1.y)));
        const float2 Wg  = cadd(cmul(Xg, S2), cmul(make_float2(Xf4.x, -Xf4.y), D2));
        const float2 Wf4 = cadd(cmul(Xf4, make_float2(S2.x, -S2.y)), cmul(make_float2(Xg.x, -Xg.y), make_float2(D2.x, -D2.y)));
        float2 c0 = make_float2(Wf.x, -Wf.y), c1 = make_float2(Wf4.x, -Wf4.y);
        buf[PH(p0)] = cadd(c0, c1); buf[PH(p0 + 1)] = csub(c0, c1);
        c0 = make_float2(Wg.x, -Wg.y); c1 = make_float2(Wg4.x, -Wg4.y);
        buf[PH(p1)] = cadd(c0, c1); buf[PH(p1 + 1)] = csub(c0, c1);
      }
    }
    __syncthreads();
    fft_r8<false>(buf, T, 1); fft_r8<false>(buf, T, 4); fft_r8<false>(buf, T, 7); fft_r8<false, 2>(buf, T, 10);
    const float d1 = hd[c1], d2 = hd[c1 + 1];
    for (int t = tid; t < 4096; t += NT) {
      const float2 y = buf[PH(t)];
      z1[t] = f2bf(y.x + d1 * bf2f(z1[t]));
      z2[t] = f2bf(-y.y + d2 * bf2f(z2[t]));
    }
  }
}

__device__ __forceinline__ void ya_phase(const bf16_t* X0, const bf16_t* yT, const float* cw, const float* cb, bf16_t* MA, unsigned char* smem) {
  float* ys = (float*)smem;
  const int tid = tid_fresh(), c8 = tid & 7, tr = tid >> 3;
  for (int it = blockIdx.x; it < 8192; it += gridDim.x) {
    const int ct = it & 15, tt = it >> 4, c0 = ct * 64, t0 = tt * 64;
    __syncthreads();
    {
      const int cl = tid >> 2, tq = tid & 3;
      const int bidx = t0 >> 12, tbase = t0 & (SEQ - 1);
      const bf16_t* src = yT + ((size_t)(bidx * 1024 + c0 + cl)) * SEQ + tbase + tq * 16;
      float f[8];
      float* sw = ys + cl * 65 + tq * 16;
      unpack8(*(const uint4*)src, f);
#pragma unroll
      for (int e = 0; e < 8; ++e) sw[e] = f[e];
      unpack8(*(const uint4*)(src + 8), f);
#pragma unroll
      for (int e = 0; e < 8; ++e) sw[8 + e] = f[e];
    }
    __syncthreads();
    const int c = c0 + c8 * 8;
    float w0[3][8], bb[8];
#pragma unroll
    for (int e = 0; e < 8; ++e) {
#pragma unroll
      for (int k = 0; k < 3; ++k) w0[k][e] = cw[k * 3072 + c + e];
      bb[e] = cb[c + e];
    }
#pragma unroll
    for (int i = 0; i < 2; ++i) {
      const int tl = tr + 32 * i, t = t0 + tl, tb = t & (SEQ - 1);
      float a[8];
#pragma unroll
      for (int e = 0; e < 8; ++e) a[e] = bb[e];
#pragma unroll
      for (int k = 0; k < 3; ++k) {
        const int tbk = tb + k - 1;
        if (tbk >= 0 && tbk < SEQ) {
          float f[8];
          unpack8(*(const uint4*)(X0 + (size_t)(t + k - 1) * 1024 + c), f);
#pragma unroll
          for (int e = 0; e < 8; ++e) a[e] += w0[k][e] * f[e];
        }
      }
#pragma unroll
      for (int e = 0; e < 8; ++e) a[e] *= ys[(c8 * 8 + e) * 65 + tl];
      *(uint4*)(MA + (size_t)t * 1024 + c) = make_uint4(pack2(a[0], a[1]), pack2(a[2], a[3]), pack2(a[4], a[5]), pack2(a[6], a[7]));
    }
  }
}

__device__ __forceinline__ void convT_job(const float* src, int K, int N, bf16_t* dst, const float* scale, unsigned char* smem) {
  float* ts = (float*)smem;
  const int tid = tid_fresh();
  const int tn = N >> 6, ntile = (K >> 6) * tn;
  for (int it = blockIdx.x; it < ntile; it += gridDim.x) {
    const int k0 = (it / tn) * 64, n0 = (it % tn) * 64;
    __syncthreads();
#pragma unroll
    for (int i = 0; i < 4; ++i) {
      const int r = (tid >> 4) + 16 * i, c4 = tid & 15;
      float4 v = *(const float4*)(src + (size_t)(k0 + r) * N + n0 + c4 * 4);
      const float s = scale ? scale[k0 + r] : 1.f;
      float* d = ts + r * 65 + c4 * 4;
      d[0] = v.x * s; d[1] = v.y * s; d[2] = v.z * s; d[3] = v.w * s;
    }
    __syncthreads();
#pragma unroll
    for (int i = 0; i < 2; ++i) {
      const int id = tid + 256 * i, nn = id >> 3, kc = id & 7;
      float f[8];
#pragma unroll
      for (int e = 0; e < 8; ++e) f[e] = ts[(kc * 8 + e) * 65 + nn];
      *(uint4*)(dst + (size_t)(n0 + nn) * K + k0 + kc * 8) = make_uint4(pack2(f[0], f[1]), pack2(f[2], f[3]), pack2(f[4], f[5]), pack2(f[6], f[7]));
    }
  }
}
__device__ __forceinline__ void conv_plain(const float* src, bf16_t* dst, size_t n) {
  const size_t stride = (size_t)gridDim.x * NT * 8;
  for (size_t i = ((size_t)blockIdx.x * NT + tid_fresh()) * 8; i < n; i += stride) {
    const float4 a = *(const float4*)(src + i), b = *(const float4*)(src + i + 4);
    *(uint4*)(dst + i) = make_uint4(pack2(a.x, a.y), pack2(a.z, a.w), pack2(b.x, b.y), pack2(b.z, b.w));
  }
}

__device__ __forceinline__ void final_norm(float* h, const float* g) {
  const int tid = tid_fresh(), wave = tid >> 6, lane = tid & 63;
  for (int row = blockIdx.x * 4 + wave; row < TOK; row += gridDim.x * 4) {
    float* p = h + (size_t)row * 1024;
    float4 v[4]; float s = 0.f;
#pragma unroll
    for (int i = 0; i < 4; ++i) { v[i] = *(const float4*)(p + i * 256 + lane * 4); s += v[i].x * v[i].x + v[i].y * v[i].y + v[i].z * v[i].z + v[i].w * v[i].w; }
#pragma unroll
    for (int o = 32; o > 0; o >>= 1) s += __shfl_xor(s, o);
    const float r = rsqrtf(s * (1.f / 1024.f) + 1e-6f);
#pragma unroll
    for (int i = 0; i < 4; ++i) {
      const float4 gg = *(const float4*)(g + i * 256 + lane * 4);
      *(float4*)(p + i * 256 + lane * 4) = make_float4(v[i].x * r * gg.x, v[i].y * r * gg.y, v[i].z * r * gg.z, v[i].w * r * gg.w);
    }
  }
}


#define XB_TMO      128
#define XB_XCNT(j)  (256  + 64 * (j))
#define XB_XSUB(j)  (1280 + 64 * (j))
#define XB_XGEN(j)  (2304 + 64 * (j))
#define XB_TOP      3328
#define XB_TOPGEN   3392
#define XCD_BAR_WORDS 3456
#define XB_SPIN_CAP (1u << 18)
__device__ __forceinline__ unsigned xb_ld(unsigned* p)              { return __hip_atomic_load(p, __ATOMIC_RELAXED, __HIP_MEMORY_SCOPE_AGENT); }
__device__ __forceinline__ unsigned xb_add(unsigned* p, unsigned v) { return __hip_atomic_fetch_add(p, v, __ATOMIC_RELAXED, __HIP_MEMORY_SCOPE_AGENT); }
__device__ __forceinline__ unsigned xb_xcc_id() { unsigned v; asm volatile("s_getreg_b32 %0, hwreg(HW_REG_XCC_ID, 0, 4)" : "=s"(v)); return v & 0xFu; }
#define XB_SPIN(cond, bar) do { unsigned _sp = 0; while (cond) { __builtin_amdgcn_s_sleep(1); \
    if ((++_sp & 255u) == 0u) { if (xb_ld(&(bar)[XB_TMO])) break; if (_sp > XB_SPIN_CAP) { atomicAdd(&(bar)[XB_TMO], 1u); break; } } } } while (0)
__device__ __forceinline__ void xcd_barrier(unsigned* bar) {
  asm volatile("s_waitcnt vmcnt(0) lgkmcnt(0)" ::: "memory");
  __syncthreads();
  if (tid_fresh() == 0) {
    __builtin_amdgcn_s_waitcnt(0);
    const unsigned x = xb_xcc_id();
    int bi = blockIdx.x; asm volatile("" : "+s"(bi));
    const uint2 census = *(const uint2*)(bar + XCD_BAR_WORDS + 2 * bi);
    const unsigned nloc = census.x, nx = census.y;
    const unsigned old = xb_add(&bar[XB_XSUB(x)], 1u);
    const unsigned gen = old / nloc;
    if (old + 1u == (gen + 1u) * nloc) {
      __builtin_amdgcn_fence(__ATOMIC_RELEASE, "agent");
      asm volatile("s_waitcnt vmcnt(0)" ::: "memory");
      const unsigned og = xb_add(&bar[XB_TOP], 1u);
      const unsigned tg = og / nx;
      if (og + 1u == (tg + 1u) * nx) xb_add(&bar[XB_TOPGEN], 1u);
      else XB_SPIN(xb_ld(&bar[XB_TOPGEN]) == tg, bar);
      __builtin_amdgcn_fence(__ATOMIC_ACQUIRE, "agent");
      xb_add(&bar[XB_XGEN(x)], 1u);
      asm volatile("s_waitcnt vmcnt(0)" ::: "memory");
    } else {
      XB_SPIN(xb_ld(&bar[XB_XGEN(x)]) == gen, bar);
      __builtin_amdgcn_fence(__ATOMIC_ACQUIRE, "agent");
      asm volatile("s_waitcnt vmcnt(0)" ::: "memory");
    }
  }
  __syncthreads();
}

#define GSYNC() do { asm volatile("s_waitcnt vmcnt(0) lgkmcnt(0)" ::: "memory"); grid.sync(); \
    if (tid_fresh() < 64) { __builtin_amdgcn_fence(__ATOMIC_ACQUIRE, "agent"); asm volatile("s_waitcnt vmcnt(0)" ::: "memory"); } \
    __syncthreads(); } while (0)
#define XSYNC() xcd_barrier((unsigned*)WSP(BAR_OFF))
#define WSP(off) (params_fresh()->ws + (off))
#define INP(i) (params_fresh()->in[i])
#define WBP ((bf16_t*)WSP(WB_OFF))
#define HBA ((bf16_t*)WSP(HBA_OFF))
#define SPECP ((float4*)WSP(SPEC_OFF))
#define H3P ((float*)WSP(H3_OFF))
#define TWP ((float2*)WSP(TW_OFF))
#define SLOT(i) ((bf16_t*)WSP(R_OFF + (size_t)(i) * 64 * MiB))
#define HRES (params_fresh()->out)

__global__ void __launch_bounds__(NT, 2) mega(Params Pdummy) {
  __shared__ __attribute__((aligned(16))) unsigned char smem[65536];
  cg::grid_group grid = cg::this_grid();
  if (tid_fresh() == 0) (void)xb_add(&((unsigned*)WSP(BAR_OFF))[XB_XCNT(xb_xcc_id())], 1u);

  for (int j = 0; j < 2; ++j) {
    convT_job(INP(I_EWIN) + (size_t)j * 1024 * 7168, 1024, 7168, WBP + W_EIN + (size_t)j * 7340032, INP(I_NORMG) + (2 * j) * 1024, smem);
    convT_job(INP(I_OWIN) + (size_t)j * 1024 * 6144, 1024, 6144, WBP + W_OIN + (size_t)j * 6291456, INP(I_NORMG) + (2 * j + 1) * 1024, smem);
    convT_job(INP(I_EWOUT) + (size_t)j * 2048 * 1024, 2048, 1024, WBP + W_EOUT + (size_t)j * 2097152, nullptr, smem);
    convT_job(INP(I_OWOUT) + (size_t)j * 2048 * 1024, 2048, 1024, WBP + W_OOUT + (size_t)j * 2097152, nullptr, smem);
    for (int g = 0; g < 4; ++g)
      convT_job(INP(I_POOLW) + (size_t)(j * 4 + g) * 65536, 256, 256, WBP + W_POOL + (size_t)(j * 4 + g) * 65536, nullptr, smem);
  }
  for (int i = 0; i < 4; ++i) {
    convT_job(INP(I_PGATE) + (size_t)i * 1048576, 1024, 1024, WBP + W_PGATE + (size_t)i * 1048576, INP(I_PLEG) + i * 1024, smem);
    convT_job(INP(I_PUP) + (size_t)i * 262144, 256, 1024, WBP + W_PUP + (size_t)i * 262144, nullptr, smem);
  }
  conv_plain(INP(I_GMWS), WBP + W_GMWS, 262144);
  conv_plain(INP(I_X), HBA, (size_t)TOK * 1024);
  hyena_feats(H3P, smem);
  {
    float2* T = TWP;
    for (int k = blockIdx.x * NT + tid_fresh(); k < 4096; k += gridDim.x * NT) {
      float s, c; sincospif((float)k / 4096.f, &s, &c);
      T[k] = make_float2(c, -s);
    }
  }
  if (gridDim.y == 0x7fffu) grid.sync();
  if (tid_fresh() == 0) {
    unsigned* bar = (unsigned*)WSP(BAR_OFF);
    const unsigned x = xb_xcc_id();
    unsigned nloc = 0u, nx = 0u, sum = 0u, sp = 0u;
    for (;;) {
      sum = 0u; nx = 0u; nloc = 0u;
#pragma unroll
      for (unsigned jx = 0; jx < 16; ++jx) { const unsigned c = xb_ld(&bar[XB_XCNT(jx)]); sum += c; nx += (c > 0u) ? 1u : 0u; nloc = (jx == x) ? c : nloc; }
      if (sum == gridDim.x) break;
      __builtin_amdgcn_s_sleep(1);
      if ((++sp & 255u) == 0u) { if (xb_ld(&bar[XB_TMO])) break; if (sp > XB_SPIN_CAP) { atomicAdd(&bar[XB_TMO], 1u); break; } }
    }
    *(uint2*)(bar + XCD_BAR_WORDS + 2 * blockIdx.x) = make_uint2(nloc > 0u ? nloc : 1u, nx > 0u ? nx : 1u);
  }
  XSYNC();
  filtgen_phase(INP(I_HWOUT), 0, H3P, (float*)SLOT(3), smem);
  XSYNC();

#pragma unroll 1
  for (int layer = 0; layer < 4; ++layer) {
    const int j = layer >> 1;
    if ((layer & 1) == 0) {
      spectrum_phase((const float*)SLOT(3), TWP, SPECP, smem);
      inproj_phase(HBA, WBP + W_EIN + (size_t)j * 7340032, 3, 0, 1024, 2048, 0, SLOT(0), SLOT(1), SLOT(2), nullptr, 0, 0, 0, 0, smem);
      XSYNC();
      z_phase(SLOT(1), SLOT(2), INP(I_CONVW) + (size_t)j * 9216, INP(I_CONVB) + (size_t)j * 3072, SLOT(3), smem);
      XSYNC();
      fftconv_phase(SLOT(3), SPECP, TWP, INP(I_HD) + j * 1024, smem);
      XSYNC();
      ya_phase(SLOT(0), SLOT(3), INP(I_CONVW) + (size_t)j * 9216, INP(I_CONVB) + (size_t)j * 3072, SLOT(1), smem);
      inproj_phase(HBA, WBP + W_EIN + (size_t)j * 7340032, 2, 4096, 5120, 0, 0, SLOT(4), SLOT(2), nullptr, nullptr, 0, 3, 0, 0, smem, (float*)WSP(PART_OFF));
      XSYNC();
      gmlp_phase(SLOT(4), SLOT(2), WBP + W_GMWS + (size_t)j * 131072, INP(I_GMG) + j * 1024, INP(I_GMBS) + j * 1024, (const float*)WSP(PART_OFF), smem);
      XSYNC();
      inproj_phase(HBA, WBP + W_EIN + (size_t)j * 7340032, 2, 3072, 6144, 0, 0, SLOT(1), SLOT(4), nullptr, nullptr, 2, 2, 0, 0, smem);
      XSYNC();
      outproj_phase(SLOT(1), SLOT(4), WBP + W_EOUT + (size_t)j * 2097152, (layer == 0) ? INP(I_X) : (const float*)HRES, HRES, SLOT(3), smem);
      XSYNC();
      ple_phase(SLOT(3), INP(I_P) + (size_t)layer * TOK * 256, WBP + W_PGATE + (size_t)layer * 1048576, WBP + W_PUP + (size_t)layer * 262144, HRES, HBA, smem);
      XSYNC();
    } else {
      inproj_phase(HBA, WBP + W_OIN + (size_t)j * 6291456, 4, 0, 2048, 3072, 4096, SLOT(0), SLOT(1), SLOT(2), SLOT(3), 0, 0, 0, 1, smem);
      XSYNC();
      pool_phase(SLOT(0), WBP + W_POOL + (size_t)j * 262144, INP(I_POOLB) + j * 1024, INP(I_POOLS) + j * 1024, SLOT(4), smem);
      na_phase(SLOT(1), SLOT(2), SLOT(3), INP(I_RPB) + (size_t)j * 16 * 15 * 31, smem);
      XSYNC();
      inproj_phase(HBA, WBP + W_OIN + (size_t)j * 6291456, 2, 1024, 5120, 0, 0, SLOT(4), SLOT(1), nullptr, nullptr, 2, 2, 0, 0, smem);
      XSYNC();
      outproj_phase(SLOT(4), SLOT(1), WBP + W_OOUT + (size_t)j * 2097152, HRES, HRES, SLOT(2), smem);
      XSYNC();
      ple_phase(SLOT(2), INP(I_P) + (size_t)layer * TOK * 256, WBP + W_PGATE + (size_t)layer * 1048576, WBP + W_PUP + (size_t)layer * 262144, HRES, HBA, smem);
      if (layer == 1) filtgen_phase(INP(I_HWOUT), 1, H3P, (float*)SLOT(3), smem);
      XSYNC();
    }
  }
  final_norm(HRES, INP(I_FINALG));
}

extern "C" void kernel_launch(void* const* d_in, const int* in_sizes, int n_in, void* d_out, int out_size, void* d_ws, size_t ws_size, hipStream_t stream) {
  static int grid_blocks = 0;
  if (grid_blocks == 0) {
    if (n_in != 29 || out_size != TOK * 1024 || ws_size < WS_END) { fprintf(stderr, "kernel_launch: unexpected shapes (n_in %d out %d ws %zu)\n", n_in, out_size, ws_size); grid_blocks = -1; return; }
    int dev = 0, cus = 0, per_cu = 0;
    if (hipGetDevice(&dev) != hipSuccess || hipDeviceGetAttribute(&cus, hipDeviceAttributeMultiprocessorCount, dev) != hipSuccess) { grid_blocks = -1; return; }
    if (hipOccupancyMaxActiveBlocksPerMultiprocessor(&per_cu, (const void*)mega, NT, LDS_BYTES) != hipSuccess || per_cu < 1) { fprintf(stderr, "occupancy query failed\n"); per_cu = 1; }
    if (per_cu > 2) per_cu = 2;
    grid_blocks = cus * per_cu;
  }
  if (grid_blocks < 0) return;
  Params p{};
  for (int i = 0; i < 29; ++i) p.in[i] = (const float*)d_in[i];
  p.out = (float*)d_out; p.ws = (unsigned char*)d_ws;
  if (hipMemsetAsync((unsigned char*)d_ws + BAR_OFF, 0, XCD_BAR_WORDS * sizeof(unsigned), stream) != hipSuccess) { fprintf(stderr, "memset of barrier words failed\n"); return; }
  void* args[] = {&p};
  hipError_t e = hipLaunchCooperativeKernel((const void*)mega, dim3(grid_blocks), dim3(NT), args, LDS_BYTES, stream);
  if (e != hipSuccess) fprintf(stderr, "cooperative launch failed: %s (grid %d)\n", hipGetErrorString(e), grid_blocks);
}
```

```cpp
#include <hip/hip_runtime.h>
#include <hip/hip_cooperative_groups.h>
#include <cstdio>
namespace cg = cooperative_groups;

typedef unsigned short bf16_t;
typedef short bf16x8 __attribute__((ext_vector_type(8)));
typedef short bf16x4 __attribute__((ext_vector_type(4)));
typedef float f32x4 __attribute__((ext_vector_type(4)));

#define NT 256
constexpr int LDS_BYTES = 0;
constexpr size_t MiB = 1u << 20;
constexpr size_t WB_OFF = 0, HBA_OFF = 80 * MiB, SPEC_OFF = 144 * MiB, H3_OFF = 177 * MiB, TW_OFF = 179 * MiB, R_OFF = 180 * MiB, PART_OFF = 500 * MiB, BAR_OFF = 502 * MiB, RSTD_OFF = 503 * MiB, PA_OFF = 504 * MiB, PB_OFF = 506 * MiB, WS_END = 508 * MiB;
constexpr int TOK = 32768, SEQ = 4096, DM = 1024;
constexpr size_t W_EIN = 0, W_OIN = 14680064, W_EOUT = 27262976, W_OOUT = 31457280, W_PGATE = 35651584, W_PUP = 39845888, W_POOL = 40894464, W_GMWS = 41418752;
constexpr int SPEC_STRIDE = 4104;

struct Params { const float* in[29]; float* out; unsigned char* ws; };
enum { I_X = 0, I_P, I_NORMG, I_FINALG, I_EWIN, I_CONVW, I_CONVB, I_HW0, I_HB0, I_HW1, I_HB1, I_HW2, I_HB2, I_HWOUT, I_HFREQ, I_HD, I_GMG, I_GMWS, I_GMBS, I_EWOUT, I_OWIN, I_POOLW, I_POOLB, I_POOLS, I_RPB, I_OWOUT, I_PUP, I_PGATE, I_PLEG };

__device__ __forceinline__ unsigned short f2bf(float f) { unsigned u = __float_as_uint(f); u += 0x7fffu + ((u >> 16) & 1u); return (unsigned short)(u >> 16); }
__device__ __forceinline__ float bf2f(unsigned short h) { return __uint_as_float(((unsigned)h) << 16); }
__device__ __forceinline__ unsigned pack2(float lo, float hi) { return (unsigned)f2bf(lo) | ((unsigned)f2bf(hi) << 16); }
__device__ __forceinline__ float lo_f(unsigned u) { return __uint_as_float(u << 16); }
__device__ __forceinline__ float hi_f(unsigned u) { return __uint_as_float(u & 0xffff0000u); }
__device__ __forceinline__ float silu_f(float v) { return v / (1.f + __expf(-v)); }
__device__ __forceinline__ float sigmoid_f(float v) { return 1.f / (1.f + __expf(-v)); }
__device__ __forceinline__ void unpack8(const uint4& u, float* f) { f[0] = lo_f(u.x); f[1] = hi_f(u.x); f[2] = lo_f(u.y); f[3] = hi_f(u.y); f[4] = lo_f(u.z); f[5] = hi_f(u.z); f[6] = lo_f(u.w); f[7] = hi_f(u.w); }

typedef const Params __attribute__((address_space(4)))* KP;
__device__ __forceinline__ KP params_fresh() { KP p = (KP)__builtin_amdgcn_kernarg_segment_ptr(); asm volatile("" : "+s"(p)); return p; }
#define WSP(off) (params_fresh()->ws + (off))
__device__ __forceinline__ int tid_fresh() { int t = threadIdx.x; asm volatile("" : "+v"(t)); return t; }

__device__ __forceinline__ int swz(int row, int kc) { return row * 128 + ((kc ^ ((row >> 1) & 7)) << 4); }

template <int AM, bool SS>
__device__ __forceinline__ void load_a1(int tid, uint4& out, float& ssq, const void* A0, const void* A1, int lda, int row, int k0, int aux) {
  const int kc = tid & 7;
  if (AM == 0) {
    out = *(const uint4*)((const bf16_t*)A0 + (size_t)row * lda + k0 + kc * 8);
  } else if (AM == 2) {
    const bf16_t* src = (k0 < 1024) ? (const bf16_t*)A0 : (const bf16_t*)A1;
    out = *(const uint4*)(src + (size_t)row * lda + (k0 & 1023) + kc * 8);
  } else if (AM == 1) {
    const float* src = (const float*)A0 + (size_t)row * lda + k0 + kc * 8;
    const float4 a = *(const float4*)src, b = *(const float4*)(src + 4);
    out = make_uint4(pack2(a.x, a.y), pack2(a.z, a.w), pack2(b.x, b.y), pack2(b.z, b.w));
  } else {
    const bf16_t* src = (const bf16_t*)A0 + k0 + kc * 8;
    const int half = 1 << aux;
    const int tb = row & (SEQ - 1), base = row - tb;
    const int lo = max(tb - half, 0), hi = min(tb + half, SEQ);
    float s0 = 0.f, s1 = 0.f, s2 = 0.f, s3 = 0.f, s4 = 0.f, s5 = 0.f, s6 = 0.f, s7 = 0.f;
    const int cnt = hi - lo;
    const bf16_t* wp = src + (size_t)(base + lo) * lda;
#pragma unroll 1
    for (int d0 = 0; d0 < cnt; d0 += 8) {
      uint4 wv[8];
#pragma unroll
      for (int d = 0; d < 8; ++d) wv[d] = (d0 + d < cnt) ? *(const uint4*)(wp + (size_t)(d0 + d) * lda) : make_uint4(0u, 0u, 0u, 0u);
#pragma unroll
      for (int d = 0; d < 8; ++d) {
        s0 += lo_f(wv[d].x); s1 += hi_f(wv[d].x); s2 += lo_f(wv[d].y); s3 += hi_f(wv[d].y); s4 += lo_f(wv[d].z); s5 += hi_f(wv[d].z); s6 += lo_f(wv[d].w); s7 += hi_f(wv[d].w);
      }
    }
    const uint4 u = *(const uint4*)(src + (size_t)row * lda);
    const float inv = 1.f / (float)(hi - lo);
    out = make_uint4(pack2(s0 * inv - lo_f(u.x), s1 * inv - hi_f(u.x)), pack2(s2 * inv - lo_f(u.y), s3 * inv - hi_f(u.y)),
                     pack2(s4 * inv - lo_f(u.z), s5 * inv - hi_f(u.z)), pack2(s6 * inv - lo_f(u.w), s7 * inv - hi_f(u.w)));
  }
}
template <int AM, bool SS>
__device__ __forceinline__ void load_a(int tid, uint4& a0, uint4& a1, uint4& a2, uint4& a3, const void* A0, const void* A1, int lda, int m0, int k0, int aux, float (&ss)[4]) {
  const int row = m0 + (tid >> 3);
  load_a1<AM, SS>(tid, a0, ss[0], A0, A1, lda, row, k0, aux);
  load_a1<AM, SS>(tid, a1, ss[1], A0, A1, lda, row + 32, k0, aux);
  load_a1<AM, SS>(tid, a2, ss[2], A0, A1, lda, row + 64, k0, aux);
  load_a1<AM, SS>(tid, a3, ss[3], A0, A1, lda, row + 96, k0, aux);
}
__device__ __forceinline__ void load_b(int tid, uint4& b0, uint4& b1, uint4& b2, uint4& b3, const bf16_t* Bt, int ldb, int n0, int k0) {
  const bf16_t* p = Bt + (size_t)(n0 + (tid >> 3)) * ldb + k0 + (tid & 7) * 8;
  b0 = *(const uint4*)p; b1 = *(const uint4*)(p + (size_t)32 * ldb); b2 = *(const uint4*)(p + (size_t)64 * ldb); b3 = *(const uint4*)(p + (size_t)96 * ldb);
}
__device__ __forceinline__ void store_tile(int tid, unsigned char* dst, const uint4& r0v, const uint4& r1v, const uint4& r2v, const uint4& r3v) {
  const int r0 = tid >> 3, kc = tid & 7;
  *(uint4*)(dst + swz(r0, kc)) = r0v; *(uint4*)(dst + swz(r0 + 32, kc)) = r1v; *(uint4*)(dst + swz(r0 + 64, kc)) = r2v; *(uint4*)(dst + swz(r0 + 96, kc)) = r3v;
}

__device__ __forceinline__ float ssq8(const uint4& v) {
  const float f0 = lo_f(v.x), f1 = hi_f(v.x), f2 = lo_f(v.y), f3 = hi_f(v.y), f4 = lo_f(v.z), f5 = hi_f(v.z), f6 = lo_f(v.w), f7 = hi_f(v.w);
  return f0 * f0 + f1 * f1 + f2 * f2 + f3 * f3 + f4 * f4 + f5 * f5 + f6 * f6 + f7 * f7;
}
template <bool SS>
__device__ __forceinline__ void store_a(int tid, unsigned char* dst, const uint4& a0, const uint4& a1, const uint4& a2, const uint4& a3, float (&ss)[4]) {
  if (SS) { ss[0] += ssq8(a0); ss[1] += ssq8(a1); ss[2] += ssq8(a2); ss[3] += ssq8(a3); }
  store_tile(tid, dst, a0, a1, a2, a3);
}
template <bool SWAP>
__device__ __forceinline__ void mma_tile(f32x4 (&acc)[4][4], const unsigned char* cur, int wr, int wc, int fr, int fq) {
#pragma unroll
  for (int s = 0; s < 2; ++s) {
    bf16x8 af[4], bfr[4];
#pragma unroll
    for (int m = 0; m < 4; ++m) af[m] = *(const bf16x8*)(cur + swz(wr * 64 + m * 16 + fr, s * 4 + fq));
#pragma unroll
    for (int n = 0; n < 4; ++n) bfr[n] = *(const bf16x8*)(cur + 16384 + swz(wc * 64 + n * 16 + fr, s * 4 + fq));
#pragma unroll
    for (int m = 0; m < 4; ++m)
#pragma unroll
      for (int n = 0; n < 4; ++n)
        acc[m][n] = SWAP ? __builtin_amdgcn_mfma_f32_16x16x32_bf16(bfr[n], af[m], acc[m][n], 0, 0, 0)
                         : __builtin_amdgcn_mfma_f32_16x16x32_bf16(af[m], bfr[n], acc[m][n], 0, 0, 0);
  }
}
template <int AM, bool SS, bool SWAP>
__device__ __forceinline__ void gemm_mainloop(f32x4 (&acc)[4][4], const void* A0, const void* A1, int lda, const bf16_t* Bt, int ldb,
                                              int m0, int n0, int K, int aux, unsigned char* smem, float (&ss)[4], int rot) {
  const int tid = tid_fresh(), wid = tid >> 6, lane = tid & 63, wr = wid >> 1, wc = wid & 1, fr = lane & 15, fq = lane >> 4;
  const int nk = K >> 6, km = nk - 1;
  unsigned char* L0 = smem;
  unsigned char* L1 = smem + 32768;
  uint4 a0, a1, a2, a3, b0, b1, b2, b3;
  __syncthreads();
  if (AM == 0 || AM == 2) {
    uint4 c0, c1, c2, c3, d0, d1, d2, d3;
    load_a<AM, SS>(tid, a0, a1, a2, a3, A0, A1, lda, m0, (rot & km) << 6, aux, ss);
    load_b(tid, b0, b1, b2, b3, Bt, ldb, n0, (rot & km) << 6);
    load_a<AM, SS>(tid, c0, c1, c2, c3, A0, A1, lda, m0, ((1 + rot) & km) << 6, aux, ss);
    load_b(tid, d0, d1, d2, d3, Bt, ldb, n0, ((1 + rot) & km) << 6);
    store_a<SS>(tid, L0, a0, a1, a2, a3, ss); store_tile(tid, L0 + 16384, b0, b1, b2, b3);
    __syncthreads();
#define SGB_PIPE() do { __builtin_amdgcn_sched_group_barrier(0x100, 8, 0); \
      _Pragma("unroll") for (int q_ = 0; q_ < 8; ++q_) { __builtin_amdgcn_sched_group_barrier(0x008, 1, 0); __builtin_amdgcn_sched_group_barrier(0x020, 1, 0); __builtin_amdgcn_sched_group_barrier(0x008, 1, 0); __builtin_amdgcn_sched_group_barrier(0x100, 1, 0); } \
      _Pragma("unroll") for (int q_ = 0; q_ < 8; ++q_) { __builtin_amdgcn_sched_group_barrier(0x008, 1, 0); __builtin_amdgcn_sched_group_barrier(0x200, 1, 0); __builtin_amdgcn_sched_group_barrier(0x008, 1, 0); } } while (0)
    for (int kt = 0; kt < nk; kt += 2) {
      const int k2 = ((min(kt + 2, km) + rot) & km) << 6, k3 = ((min(kt + 3, km) + rot) & km) << 6;
      load_a<AM, SS>(tid, a0, a1, a2, a3, A0, A1, lda, m0, k2, aux, ss); load_b(tid, b0, b1, b2, b3, Bt, ldb, n0, k2);
      mma_tile<SWAP>(acc, L0, wr, wc, fr, fq);
      store_a<SS>(tid, L1, c0, c1, c2, c3, ss); store_tile(tid, L1 + 16384, d0, d1, d2, d3);
      SGB_PIPE();
      __syncthreads();
      load_a<AM, SS>(tid, c0, c1, c2, c3, A0, A1, lda, m0, k3, aux, ss); load_b(tid, d0, d1, d2, d3, Bt, ldb, n0, k3);
      mma_tile<SWAP>(acc, L1, wr, wc, fr, fq);
      if (SS) { if (kt + 2 < nk) { ss[0] += ssq8(a0); ss[1] += ssq8(a1); ss[2] += ssq8(a2); ss[3] += ssq8(a3); } }
      store_tile(tid, L0, a0, a1, a2, a3); store_tile(tid, L0 + 16384, b0, b1, b2, b3);
      SGB_PIPE();
      __syncthreads();
    }
#undef SGB_PIPE
    asm volatile("s_waitcnt vmcnt(0)" ::: "memory");
  } else {
    load_a<AM, SS>(tid, a0, a1, a2, a3, A0, A1, lda, m0, (rot & km) << 6, aux, ss);
    load_b(tid, b0, b1, b2, b3, Bt, ldb, n0, (rot & km) << 6);
    store_a<SS>(tid, L0, a0, a1, a2, a3, ss); store_tile(tid, L0 + 16384, b0, b1, b2, b3);
    __syncthreads();
    for (int kt = 0; kt < nk; ++kt) {
      unsigned char* cur = smem + (kt & 1) * 32768;
      unsigned char* nxt = smem + ((kt + 1) & 1) * 32768;
      const bool more = (kt + 1 < nk);
      if (more) { load_a<AM, SS>(tid, a0, a1, a2, a3, A0, A1, lda, m0, ((kt + 1 + rot) & km) << 6, aux, ss); load_b(tid, b0, b1, b2, b3, Bt, ldb, n0, ((kt + 1 + rot) & km) << 6); }
      mma_tile<SWAP>(acc, cur, wr, wc, fr, fq);
      if (more) { store_a<SS>(tid, nxt, a0, a1, a2, a3, ss); store_tile(tid, nxt + 16384, b0, b1, b2, b3); }
      __syncthreads();
    }
  }
}
__device__ __forceinline__ void finish_rstd(float (&ss)[4], unsigned char* smem) {
  const int tid = tid_fresh(), r0 = tid >> 3, kc = tid & 7;
  float* rs = (float*)smem;
#pragma unroll
  for (int i = 0; i < 4; ++i) {
    float v = ss[i];
    v += __shfl_xor(v, 1); v += __shfl_xor(v, 2); v += __shfl_xor(v, 4);
    if (kc == 0) rs[r0 + 32 * i] = rsqrtf(v * (1.f / 1024.f) + 1e-6f);
  }
  __syncthreads();
}
__device__ __forceinline__ void rstd_from_partials(size_t ws_off, int m0, unsigned char* smem) {
  const int tid = tid_fresh();
  if (tid < 128) {
    const float4* q = (const float4*)((const float*)WSP(ws_off) + (size_t)(m0 + tid) * 16);
    const float4 p0 = q[0], p1 = q[1], p2 = q[2], p3 = q[3];
    const float sq = (p0.x + p0.y + p0.z + p0.w) + (p1.x + p1.y + p1.z + p1.w) + (p2.x + p2.y + p2.z + p2.w) + (p3.x + p3.y + p3.z + p3.w);
    ((float*)smem)[tid] = rsqrtf(sq * (1.f / 1024.f) + 1e-6f);
  }
  __syncthreads();
}
__device__ __forceinline__ void zero_acc(f32x4 (&acc)[4][4]) {
#pragma unroll
  for (int m = 0; m < 4; ++m)
#pragma unroll
    for (int n = 0; n < 4; ++n) acc[m][n] = (f32x4){0.f, 0.f, 0.f, 0.f};
}

__device__ __forceinline__ bool tile_pick(int i, int nNt, int& mt, int& nt, int& L) {
  const int b = blockIdx.x;
  L = i * (int)gridDim.x + (b & 7) * ((int)gridDim.x >> 3) + (b >> 3);
  if (L >= 256 * nNt) return false;
  const int band = L / (8 * nNt), r = L - band * (8 * nNt), c = r >> 6, w = r & 63;
  mt = band * 8 + (w & 7); nt = c * 8 + (w >> 3);
  return true;
}

__device__ __forceinline__ void inproj_phase(const bf16_t* hb, const bf16_t* W, int ng, int wr0, int wr1, int wr2, int wr3,
                             bf16_t* d0, bf16_t* d1, bf16_t* d2, bf16_t* d3, int md0, int md1, int md2, int md3, unsigned char* smem) {
  const int tid = tid_fresh(), wid = tid >> 6, lane = tid & 63, wr = wid >> 1, wc = wid & 1, fr = lane & 15, fq = lane >> 4;
  for (int i = 0;; ++i) {
    int mt, ntg, t;
    if (!tile_pick(i, ng * 8, mt, ntg, t)) break;
    const int grp = ntg >> 3, nt = ntg & 7;
    const int wrow = grp == 0 ? wr0 : grp == 1 ? wr1 : grp == 2 ? wr2 : wr3;
    bf16_t* dst = grp == 0 ? d0 : grp == 1 ? d1 : grp == 2 ? d2 : d3;
    const int mode = grp == 0 ? md0 : grp == 1 ? md1 : grp == 2 ? md2 : md3;
    const int m0 = mt * 128, n0 = nt * 128;
    f32x4 acc[4][4]; zero_acc(acc);
    float ss[4] = {0.f, 0.f, 0.f, 0.f};
    if (mode == 1) {
      gemm_mainloop<0, false, false>(acc, hb, nullptr, 1024, W + (size_t)wrow * 1024, 1024, m0, n0, 1024, 0, smem, ss, 0);
      rstd_from_partials(PA_OFF, m0, smem);
      const float* rs = (const float*)smem;
#pragma unroll
      for (int m = 0; m < 4; ++m) {
        const int rl = wr * 64 + m * 16 + fq * 4;
        const float r0 = rs[rl], r1 = rs[rl + 1], r2 = rs[rl + 2], r3 = rs[rl + 3];
#pragma unroll
        for (int n = 0; n < 4; ++n) {
          const int col = n0 + wc * 64 + n * 16 + fr;
          uint2 o; o.x = pack2(acc[m][n][0] * r0, acc[m][n][1] * r1); o.y = pack2(acc[m][n][2] * r2, acc[m][n][3] * r3);
          *(uint2*)(dst + (size_t)col * TOK + m0 + rl) = o;
        }
      }
    } else {
      gemm_mainloop<0, false, true>(acc, hb, nullptr, 1024, W + (size_t)wrow * 1024, 1024, m0, n0, 1024, 0, smem, ss, 0);
      rstd_from_partials(PA_OFF, m0, smem);
      const float* rs = (const float*)smem;
      uint2 old[4][4];
      if (mode == 2) {
#pragma unroll
        for (int m = 0; m < 4; ++m)
#pragma unroll
          for (int n = 0; n < 4; ++n) old[m][n] = *(const uint2*)(dst + (size_t)(m0 + wr * 64 + m * 16 + fr) * 1024 + n0 + wc * 64 + n * 16 + fq * 4);
      }
#pragma unroll
      for (int m = 0; m < 4; ++m) {
        const int rl = wr * 64 + m * 16 + fr;
        const float r = rs[rl];
        float psq = 0.f;
#pragma unroll
        for (int n = 0; n < 4; ++n) {
          const int col = n0 + wc * 64 + n * 16 + fq * 4;
          bf16_t* pd = dst + (size_t)(m0 + rl) * 1024 + col;
          float v0 = acc[m][n][0] * r, v1 = acc[m][n][1] * r, v2 = acc[m][n][2] * r, v3 = acc[m][n][3] * r;
          if (mode == 2) {
            v0 = lo_f(old[m][n].x) * silu_f(v0); v1 = hi_f(old[m][n].x) * silu_f(v1); v2 = lo_f(old[m][n].y) * silu_f(v2); v3 = hi_f(old[m][n].y) * silu_f(v3);
          }
          uint2 o; o.x = pack2(v0, v1); o.y = pack2(v2, v3);
          *(uint2*)pd = o;
          if (mode == 3) psq += v0 * v0 + v1 * v1 + v2 * v2 + v3 * v3;
        }
        if (mode == 3) {
          psq += __shfl_xor(psq, 16); psq += __shfl_xor(psq, 32);
          if (fq == 0) ((float*)WSP(PART_OFF))[(size_t)(m0 + rl) * 16 + nt * 2 + wc] = psq;
        }
      }
    }
  }
}

__device__ __forceinline__ void outproj_phase(const bf16_t* MA, const bf16_t* MB, const bf16_t* Wt  , const float* hsrc, float* hres, bf16_t* hbB, unsigned char* smem) {
  const int tid = tid_fresh(), wid = tid >> 6, lane = tid & 63, wr = wid >> 1, wc = wid & 1, fr = lane & 15, fq = lane >> 4;
  for (int i = 0;; ++i) {
    int mt, nt, t;
    if (!tile_pick(i, 8, mt, nt, t)) break;
    const int m0 = mt * 128, n0 = nt * 128;
    f32x4 acc[4][4]; zero_acc(acc);
    float ss[4] = {0.f, 0.f, 0.f, 0.f};
    gemm_mainloop<2, false, true>(acc, MA, MB, 1024, Wt, 2048, m0, n0, 2048, 0, smem, ss, 0);
#pragma unroll
    for (int m = 0; m < 4; ++m) {
      const int row = m0 + wr * 64 + m * 16 + fr;
      const size_t idx = (size_t)row * 1024 + n0 + wc * 64 + fq * 4;
      float4 h[4];
#pragma unroll
      for (int n = 0; n < 4; ++n) h[n] = *(const float4*)(hsrc + idx + n * 16);
      float psq = 0.f;
#pragma unroll
      for (int n = 0; n < 4; ++n) {
        const float4 o = make_float4(h[n].x + acc[m][n][0], h[n].y + acc[m][n][1], h[n].z + acc[m][n][2], h[n].w + acc[m][n][3]);
        *(float4*)(hres + idx + n * 16) = o;
        uint2 ob; ob.x = pack2(o.x, o.y); ob.y = pack2(o.z, o.w);
        *(uint2*)(hbB + idx + n * 16) = ob;
        psq += o.x * o.x + o.y * o.y + o.z * o.z + o.w * o.w;
      }
      psq += __shfl_xor(psq, 16); psq += __shfl_xor(psq, 32);
      if (fq == 0) ((float*)WSP(PB_OFF))[(size_t)row * 16 + nt * 2 + wc] = psq;
    }
  }
}

__device__ __forceinline__ void ple_phase(const bf16_t* hbB, const float* pin  , const bf16_t* Wg  , const bf16_t* Wup  ,
                          float* hres, bf16_t* hbA, unsigned char* smem) {
  const int tid = tid_fresh(), wid = tid >> 6, lane = tid & 63, wr = wid >> 1, wc = wid & 1, fr = lane & 15, fq = lane >> 4;
  for (int i = 0;; ++i) {
    int mt, nt, t;
    if (!tile_pick(i, 8, mt, nt, t)) break;
    const int m0 = mt * 128, n0 = nt * 128;
    f32x4 ag[4][4]; zero_acc(ag);
    float ss[4] = {0.f, 0.f, 0.f, 0.f};
    gemm_mainloop<0, false, true>(ag, hbB, nullptr, 1024, Wg, 1024, m0, n0, 1024, 0, smem, ss, 0);
    rstd_from_partials(PB_OFF, m0, smem);
    unsigned gp[4][4][2];
    {
      const float* rs = (const float*)smem;
#pragma unroll
      for (int m = 0; m < 4; ++m) {
        const float r = rs[wr * 64 + m * 16 + fr];
#pragma unroll
        for (int n = 0; n < 4; ++n) {
          gp[m][n][0] = pack2(sigmoid_f(r * ag[m][n][0]), sigmoid_f(r * ag[m][n][1]));
          gp[m][n][1] = pack2(sigmoid_f(r * ag[m][n][2]), sigmoid_f(r * ag[m][n][3]));
        }
      }
    }
    zero_acc(ag);
    float ss2[4] = {0.f, 0.f, 0.f, 0.f};
    gemm_mainloop<1, false, true>(ag, pin, nullptr, 256, Wup, 256, m0, n0, 256, 0, smem, ss2, 0);
#pragma unroll
    for (int m = 0; m < 4; ++m) {
      const int rl = wr * 64 + m * 16 + fr;
      const size_t idx = (size_t)(m0 + rl) * 1024 + n0 + wc * 64 + fq * 4;
      float4 h[4];
#pragma unroll
      for (int n = 0; n < 4; ++n) h[n] = *(const float4*)(hres + idx + n * 16);
      float psq = 0.f;
#pragma unroll
      for (int n = 0; n < 4; ++n) {
        float4 o;
        o.x = h[n].x + ag[m][n][0] * lo_f(gp[m][n][0]);
        o.y = h[n].y + ag[m][n][1] * hi_f(gp[m][n][0]);
        o.z = h[n].z + ag[m][n][2] * lo_f(gp[m][n][1]);
        o.w = h[n].w + ag[m][n][3] * hi_f(gp[m][n][1]);
        *(float4*)(hres + idx + n * 16) = o;
        uint2 ob; ob.x = pack2(o.x, o.y); ob.y = pack2(o.z, o.w);
        *(uint2*)(hbA + idx + n * 16) = ob;
        psq += o.x * o.x + o.y * o.y + o.z * o.z + o.w * o.w;
      }
      psq += __shfl_xor(psq, 16); psq += __shfl_xor(psq, 32);
      if (fq == 0) ((float*)WSP(PA_OFF))[(size_t)(m0 + rl) * 16 + nt * 2 + wc] = psq;
    }
  }
}

__device__ __forceinline__ void pool_phase(const bf16_t* XC, const bf16_t* Wp  , const float* pb, const float* ps, bf16_t* MC, unsigned char* smem) {
  const int tid = tid_fresh(), wid = tid >> 6, lane = tid & 63, wr = wid >> 1, wc = wid & 1, fr = lane & 15, fq = lane >> 4;
  unsigned char* sA = smem;
  unsigned char* sB = smem + 16384;
  unsigned char* sXs = smem + 32768;
  for (int t = blockIdx.x; t < 2048; t += gridDim.x) {
    const int mt = t >> 3, g = (t >> 1) & 3, nt = t & 1, m0 = mt * 128, n0 = nt * 128;
    const int half = 1 << g;
    const int tb0 = m0 & (SEQ - 1);
    const bf16_t* Bt = Wp + (size_t)g * 65536;
    f32x4 acc[4][4]; zero_acc(acc);
    uint4 xr[5], b0, b1, b2, b3;
#pragma unroll
    for (int i = 0; i < 5; ++i) {
      const int id = tid + 256 * i, row = id >> 3, kc = id & 7, tb = tb0 - 8 + row;
      xr[i] = (id < 1152 && tb >= 0 && tb < SEQ) ? *(const uint4*)(XC + (size_t)(m0 - 8 + row) * 1024 + g * 256 + kc * 8) : make_uint4(0u, 0u, 0u, 0u);
    }
    load_b(tid, b0, b1, b2, b3, Bt, 256, n0, 0);
    __syncthreads();
#pragma unroll 1
    for (int ks = 0; ks < 4; ++ks) {
#pragma unroll
      for (int i = 0; i < 5; ++i) { const int id = tid + 256 * i; if (id < 1152) *(uint4*)(sXs + id * 16) = xr[i]; }
      store_tile(tid, sB, b0, b1, b2, b3);
      __syncthreads();
      if (ks < 3) {
        const int k1 = (ks + 1) * 64;
#pragma unroll
        for (int i = 0; i < 5; ++i) {
          const int id = tid + 256 * i, row = id >> 3, kc = id & 7, tb = tb0 - 8 + row;
          xr[i] = (id < 1152 && tb >= 0 && tb < SEQ) ? *(const uint4*)(XC + (size_t)(m0 - 8 + row) * 1024 + g * 256 + k1 + kc * 8) : make_uint4(0u, 0u, 0u, 0u);
        }
        load_b(tid, b0, b1, b2, b3, Bt, 256, n0, k1);
      }
#pragma unroll
      for (int i = 0; i < 4; ++i) {
        const int row = (tid >> 3) + 32 * i, kc = tid & 7, tb = tb0 + row;
        const int lo = max(tb - half, 0), hi = min(tb + half, SEQ);
        float s0 = 0.f, s1 = 0.f, s2 = 0.f, s3 = 0.f, s4 = 0.f, s5 = 0.f, s6 = 0.f, s7 = 0.f;
        for (int tt = lo; tt < hi; ++tt) {
          const uint4 u = *(const uint4*)(sXs + (tt - tb0 + 8) * 128 + kc * 16);
          s0 += lo_f(u.x); s1 += hi_f(u.x); s2 += lo_f(u.y); s3 += hi_f(u.y); s4 += lo_f(u.z); s5 += hi_f(u.z); s6 += lo_f(u.w); s7 += hi_f(u.w);
        }
        const uint4 u = *(const uint4*)(sXs + (row + 8) * 128 + kc * 16);
        const float inv = 1.f / (float)(hi - lo);
        *(uint4*)(sA + swz(row, kc)) = make_uint4(pack2(s0 * inv - lo_f(u.x), s1 * inv - hi_f(u.x)), pack2(s2 * inv - lo_f(u.y), s3 * inv - hi_f(u.y)),
                                                  pack2(s4 * inv - lo_f(u.z), s5 * inv - hi_f(u.z)), pack2(s6 * inv - lo_f(u.w), s7 * inv - hi_f(u.w)));
      }
      __syncthreads();
      mma_tile<true>(acc, smem, wr, wc, fr, fq);
      __syncthreads();
    }
#pragma unroll
    for (int m = 0; m < 4; ++m) {
      const int row = m0 + wr * 64 + m * 16 + fr;
#pragma unroll
      for (int n = 0; n < 4; ++n) {
        const int col = g * 256 + n0 + wc * 64 + n * 16 + fq * 4;
        const float4 b = *(const float4*)(pb + col), sc = *(const float4*)(ps + col);
        uint2 o; o.x = pack2((acc[m][n][0] + b.x) * sc.x, (acc[m][n][1] + b.y) * sc.y); o.y = pack2((acc[m][n][2] + b.z) * sc.z, (acc[m][n][3] + b.w) * sc.w);
        *(uint2*)(MC + (size_t)row * 1024 + col) = o;
      }
    }
  }
}

__device__ __forceinline__ void gmlp_phase(bf16_t* UB, const bf16_t* VB, const bf16_t* Ws  , const float* gmg, const float* gbs  , unsigned char* smem) {
  const int tid = tid_fresh(), wid = tid >> 6, lane = tid & 63, wr = wid >> 1, wc = wid & 1, fr = lane & 15, fq = lane >> 4;
  unsigned char* sW = smem;
  unsigned char* sX = smem + 32768;
  for (int it = blockIdx.x; it < 2048; it += gridDim.x) {
    const int g = it & 7, tok0 = (it >> 3) * 128;
    __syncthreads();
#pragma unroll 2
    for (int i = 0; i < 8; ++i) {
      const int id = tid + 256 * i, row = id >> 4, kc = id & 15;
      *(uint4*)(sW + row * 256 + ((kc ^ (row & 15)) << 4)) = *(const uint4*)(Ws + (size_t)g * 16384 + row * 128 + kc * 8);
    }
    float rq;
    {
      const float4* pp = (const float4*)((const float*)WSP(PART_OFF) + (size_t)(tok0 + (tid & 127)) * 16);
      const float4 p0 = pp[0], p1 = pp[1], p2 = pp[2], p3 = pp[3];
      const float sq = (p0.x + p0.y + p0.z + p0.w) + (p1.x + p1.y + p1.z + p1.w) + (p2.x + p2.y + p2.z + p2.w) + (p3.x + p3.y + p3.z + p3.w);
      rq = rsqrtf(sq * (1.f / 1024.f) + 1e-6f);
    }
    __syncthreads();
#pragma unroll 2
    for (int i = 0; i < 8; ++i) {
      const int id = tid + 256 * i, q = id & 127, cc = id >> 7;
      float f[8]; unpack8(*(const uint4*)(VB + (size_t)(tok0 + q) * 1024 + g * 128 + cc * 8), f);
#pragma unroll
      for (int e = 0; e < 8; ++e) {
        const int c = cc * 8 + e;
        const float v = f[e] * rq * gmg[g * 128 + c];
        *(bf16_t*)(sX + c * 256 + (((q >> 3) ^ (c & 15)) << 4) + (q & 7) * 2) = f2bf(v);
      }
    }
    __syncthreads();
    f32x4 acc[4][4]; zero_acc(acc);
#pragma unroll
    for (int s = 0; s < 4; ++s) {
      bf16x8 af[4], bfr[4];
#pragma unroll
      for (int m = 0; m < 4; ++m) { const int row = wr * 64 + m * 16 + fr; af[m] = *(const bf16x8*)(sW + row * 256 + (((s * 4 + fq) ^ (row & 15)) << 4)); }
#pragma unroll
      for (int n = 0; n < 4; ++n) { const int row = wc * 64 + n * 16 + fr; bfr[n] = *(const bf16x8*)(sX + row * 256 + (((s * 4 + fq) ^ (row & 15)) << 4)); }
#pragma unroll
      for (int m = 0; m < 4; ++m)
#pragma unroll
        for (int n = 0; n < 4; ++n) acc[m][n] = __builtin_amdgcn_mfma_f32_16x16x32_bf16(bfr[n], af[m], acc[m][n], 0, 0, 0);
    }
    uint2 uo[4][4];
#pragma unroll
    for (int m = 0; m < 4; ++m)
#pragma unroll
      for (int n = 0; n < 4; ++n) uo[m][n] = *(const uint2*)(UB + (size_t)(tok0 + wr * 64 + m * 16 + fr) * 1024 + g * 128 + wc * 64 + n * 16 + fq * 4);
#pragma unroll
    for (int m = 0; m < 4; ++m) {
      const int p = wr * 64 + m * 16 + fr;
      const float bias = gbs[g * 128 + p];
#pragma unroll
      for (int n = 0; n < 4; ++n) {
        const int c = wc * 64 + n * 16 + fq * 4;
        bf16_t* pd = UB + (size_t)(tok0 + p) * 1024 + g * 128 + c;
        const uint2 u = uo[m][n];
        uint2 o; o.x = pack2(lo_f(u.x) * (acc[m][n][0] + bias), hi_f(u.x) * (acc[m][n][1] + bias));
        o.y = pack2(lo_f(u.y) * (acc[m][n][2] + bias), hi_f(u.y) * (acc[m][n][3] + bias));
        *(uint2*)pd = o;
      }
    }
  }
}

__device__ __forceinline__ void na_phase(bf16_t* Q, const bf16_t* Kb, const bf16_t* Vt, const float* rpb, unsigned char* smem) {
  const int tid = tid_fresh(), wq = tid >> 6, lane = tid & 63, fr = lane & 15, fq = lane >> 4;
  for (int it = blockIdx.x; it < 8 * 64 * 16; it += gridDim.x) {
    const int h = it & 15, r = (it >> 4) & 63, b = it >> 10;
    const int rs = min(max(r - 4, 0), 56);
    const int w0 = (wq == 0) ? 0 : (wq == 1) ? 8 : (wq == 2) ? 24 : 32;
    const int qc = wq * 16 + fr;
    const int tokq = b * 4096 + r * 64 + qc;
    const bf16x8 qf0 = *(const bf16x8*)(Q + (size_t)tokq * 1024 + h * 64 + fq * 8);
    const bf16x8 qf1 = *(const bf16x8*)(Q + (size_t)tokq * 1024 + h * 64 + 32 + fq * 8);
    const int cs = min(max(qc - 8, 0), 48);
    const float* rp = rpb + h * (15 * 31);
    const size_t tok0 = (size_t)b * 4096 + rs * 64;
    __syncthreads();
#pragma unroll 1
    for (int i0 = 0; i0 < 16; i0 += 16) {
      uint4 kv[16];
#pragma unroll
      for (int i = 0; i < 16; ++i) {
        const int id = tid + 256 * (i0 + i), key = id >> 3, kc = id & 7;
        kv[i] = *(const uint4*)(Kb + (tok0 + key) * 1024 + h * 64 + kc * 8);
      }
#pragma unroll
      for (int i = 0; i < 16; ++i) {
        const int id = tid + 256 * (i0 + i), key = id >> 3, kc = id & 7;
        *(uint4*)(smem + key * 128 + ((kc ^ ((key >> 1) & 7)) << 4)) = kv[i];
      }
    }
    __syncthreads();
    uint4 vvA[4];
#pragma unroll
    for (int i = 0; i < 4; ++i) {
      const int id = tid + 256 * i, d = id >> 6, c16 = id & 63;
      vvA[i] = *(const uint4*)(Vt + (size_t)(h * 64 + d) * TOK + tok0 + c16 * 8);
    }
    f32x4 sc[8][2];
    float mx = -1e30f;
#pragma unroll
    for (int jr = 0; jr < 8; ++jr) {
#pragma unroll
      for (int hc = 0; hc < 2; ++hc) {
        const int key = jr * 64 + w0 + 8 * (fr >> 2) + 4 * hc + (fr & 3);
        const unsigned char* kp = smem + key * 128;
        const int kx = (key >> 1) & 7;
        const bf16x8 kf0 = *(const bf16x8*)(kp + ((fq ^ kx) << 4));
        const bf16x8 kf1 = *(const bf16x8*)(kp + (((4 + fq) ^ kx) << 4));
        f32x4 a = (f32x4){0.f, 0.f, 0.f, 0.f};
        a = __builtin_amdgcn_mfma_f32_16x16x32_bf16(kf0, qf0, a, 0, 0, 0);
        a = __builtin_amdgcn_mfma_f32_16x16x32_bf16(kf1, qf1, a, 0, 0, 0);
        const int dr = rs + jr - r + 7;
#pragma unroll
        for (int e = 0; e < 4; ++e) {
          const int kcol = w0 + 8 * fq + 4 * hc + e;
          const bool valid = (kcol >= cs) && (kcol < cs + 16);
          const int dc = min(max(kcol - qc + 15, 0), 30);
          const float v = valid ? (a[e] * 0.125f + rp[dr * 31 + dc]) : -1e30f;
          a[e] = v; mx = fmaxf(mx, v);
        }
        sc[jr][hc] = a;
      }
    }
    mx = fmaxf(mx, __shfl_xor(mx, 16)); mx = fmaxf(mx, __shfl_xor(mx, 32));
    float sum = 0.f;
#pragma unroll
    for (int jr = 0; jr < 8; ++jr)
#pragma unroll
      for (int hc = 0; hc < 2; ++hc)
#pragma unroll
        for (int e = 0; e < 4; ++e) { const float pv = (sc[jr][hc][e] > -1e29f) ? __expf(sc[jr][hc][e] - mx) : 0.f; sc[jr][hc][e] = pv; sum += pv; }
    sum += __shfl_xor(sum, 16); sum += __shfl_xor(sum, 32);
    const float inv = 1.f / sum;
    __syncthreads();
    {
#pragma unroll
      for (int i = 0; i < 4; ++i) {
        const int id = tid + 256 * i, d = id >> 6, c16 = id & 63;
        *(uint4*)(smem + d * 1024 + ((c16 ^ (d & 15)) << 4)) = vvA[i];
      }
#pragma unroll 1
      for (int i0 = 4; i0 < 16; i0 += 6) {
        uint4 vvB[6];
#pragma unroll
        for (int i = 0; i < 6; ++i) {
          const int id = tid + 256 * (i0 + i), d = id >> 6, c16 = id & 63;
          vvB[i] = *(const uint4*)(Vt + (size_t)(h * 64 + d) * TOK + tok0 + c16 * 8);
        }
#pragma unroll
        for (int i = 0; i < 6; ++i) {
          const int id = tid + 256 * (i0 + i), d = id >> 6, c16 = id & 63;
          *(uint4*)(smem + d * 1024 + ((c16 ^ (d & 15)) << 4)) = vvB[i];
        }
      }
    }
    __syncthreads();
    f32x4 o[4];
#pragma unroll
    for (int dt = 0; dt < 4; ++dt) o[dt] = (f32x4){0.f, 0.f, 0.f, 0.f};
#pragma unroll
    for (int jr = 0; jr < 8; ++jr) {
      union { bf16x8 v; unsigned u[4]; } pf;
      pf.u[0] = pack2(sc[jr][0][0] * inv, sc[jr][0][1] * inv); pf.u[1] = pack2(sc[jr][0][2] * inv, sc[jr][0][3] * inv);
      pf.u[2] = pack2(sc[jr][1][0] * inv, sc[jr][1][1] * inv); pf.u[3] = pack2(sc[jr][1][2] * inv, sc[jr][1][3] * inv);
      const int c16 = jr * 8 + (w0 >> 3) + fq;
#pragma unroll
      for (int dt = 0; dt < 4; ++dt) {
        const int d = dt * 16 + fr;
        const bf16x8 vf = *(const bf16x8*)(smem + d * 1024 + ((c16 ^ (d & 15)) << 4));
        o[dt] = __builtin_amdgcn_mfma_f32_16x16x32_bf16(vf, pf.v, o[dt], 0, 0, 0);
      }
    }
#pragma unroll
    for (int dt = 0; dt < 4; ++dt) {
      uint2 ob; ob.x = pack2(o[dt][0], o[dt][1]); ob.y = pack2(o[dt][2], o[dt][3]);
      *(uint2*)(Q + (size_t)tokq * 1024 + h * 64 + dt * 16 + fq * 4) = ob;
    }
  }
}

__device__ __forceinline__ float2 cmul(float2 a, float2 b) { return make_float2(a.x * b.x - a.y * b.y, a.x * b.y + a.y * b.x); }
__device__ __forceinline__ float2 cadd(float2 a, float2 b) { return make_float2(a.x + b.x, a.y + b.y); }
__device__ __forceinline__ float2 csub(float2 a, float2 b) { return make_float2(a.x - b.x, a.y - b.y); }

template <bool DIF>
__device__ __forceinline__ void bfly(float2& a, float2& b, float2 w) {
  if (DIF) { const float2 s = cadd(a, b), d = csub(a, b); a = s; b = cmul(d, w); }
  else { const float2 t = cmul(b, w); const float2 s = cadd(a, t), d = csub(a, t); a = s; b = d; }
}
#define PH(i) ((i) ^ (((i) >> 4) & 7))
template <bool DIF, int HALF = 0>
__device__ __forceinline__ void fft_r8(float2* buf, const float2* __restrict__ T, int lq) {
  const int q = 1 << lq, sA = 1024 >> lq;
  for (int g = tid_fresh(); g < 1024; g += NT) {
    const int j0 = g & (q - 1), i0 = ((g >> lq) << (lq + 3)) + j0;
    float2 x[8];
#pragma unroll
    for (int p = 0; p < 8; ++p) x[p] = (HALF == 1 && p >= 4) ? make_float2(0.f, 0.f) : buf[PH(i0 + p * q)];
    const float2 w1 = T[j0 * sA];
    const float2 w2 = cmul(w1, w1), w4 = cmul(w2, w2);
    const float cs8 = 0.70710678118654752f;
    const float2 tA1 = make_float2(cs8 * (w1.x + w1.y), cs8 * (w1.y - w1.x));
    const float2 tA2 = make_float2(w1.y, -w1.x);
    const float2 tA3 = make_float2(cs8 * (w1.y - w1.x), -cs8 * (w1.x + w1.y));
    const float2 tB1 = make_float2(w2.y, -w2.x);
    if (DIF) {
      bfly<true>(x[0], x[4], w1); bfly<true>(x[1], x[5], tA1); bfly<true>(x[2], x[6], tA2); bfly<true>(x[3], x[7], tA3);
      bfly<true>(x[0], x[2], w2); bfly<true>(x[4], x[6], w2); bfly<true>(x[1], x[3], tB1); bfly<true>(x[5], x[7], tB1);
      bfly<true>(x[0], x[1], w4); bfly<true>(x[2], x[3], w4); bfly<true>(x[4], x[5], w4); bfly<true>(x[6], x[7], w4);
    } else {
      bfly<false>(x[0], x[1], w4); bfly<false>(x[2], x[3], w4); bfly<false>(x[4], x[5], w4); bfly<false>(x[6], x[7], w4);
      bfly<false>(x[0], x[2], w2); bfly<false>(x[4], x[6], w2); bfly<false>(x[1], x[3], tB1); bfly<false>(x[5], x[7], tB1);
      bfly<false>(x[0], x[4], w1); bfly<false>(x[1], x[5], tA1); bfly<false>(x[2], x[6], tA2); bfly<false>(x[3], x[7], tA3);
    }
#pragma unroll
    for (int p = 0; p < 8; ++p) if (!(HALF == 2 && p >= 4)) buf[PH(i0 + p * q)] = x[p];
  }
  __syncthreads();
}
__device__ __forceinline__ void fft_r2(float2* buf) {
  for (int g = tid_fresh(); g < 4096; g += NT) {
    const int i0 = PH(2 * g), i1 = PH(2 * g + 1);
    const float2 a = buf[i0], b = buf[i1];
    buf[i0] = make_float2(a.x + b.x, a.y + b.y); buf[i1] = make_float2(a.x - b.x, a.y - b.y);
  }
  __syncthreads();
}
__device__ __forceinline__ void fft_dif(float2* buf, const float2* T) { fft_r8<true>(buf, T, 10); fft_r8<true>(buf, T, 7); fft_r8<true>(buf, T, 4); fft_r8<true>(buf, T, 1); fft_r2(buf); }
__device__ __forceinline__ void fft_dit(float2* buf, const float2* T) { fft_r2(buf); fft_r8<false>(buf, T, 1); fft_r8<false>(buf, T, 4); fft_r8<false>(buf, T, 7); fft_r8<false>(buf, T, 10); }
__device__ __forceinline__ void fft_dif_zp(float2* buf, const float2* T) { fft_r8<true, 1>(buf, T, 10); fft_r8<true>(buf, T, 7); fft_r8<true>(buf, T, 4); fft_r8<true>(buf, T, 1); fft_r2(buf); }
__device__ __forceinline__ void fft_dit_lo(float2* buf, const float2* T) { fft_r2(buf); fft_r8<false>(buf, T, 1); fft_r8<false>(buf, T, 4); fft_r8<false>(buf, T, 7); fft_r8<false, 2>(buf, T, 10); }
__device__ __forceinline__ int brev13(int k) { return (int)(__brev((unsigned)k) >> 19); }

__device__ __forceinline__ void hyena_feats(float* h3, unsigned char* smem) {
  KP PP = params_fresh();
  float* hin = (float*)smem;
  const int tid = tid_fresh(), r = tid >> 6, u = tid & 63;
  for (int it = blockIdx.x; it < 2048; it += gridDim.x) {
    const int j = it >> 10, l = (it & 1023) * 4 + r;
    const float* w0 = PP->in[I_HW0] + j * 33 * 64; const float* b0 = PP->in[I_HB0] + j * 64;
    const float* w1 = PP->in[I_HW1] + j * 4096; const float* b1 = PP->in[I_HB1] + j * 64;
    const float* w2 = PP->in[I_HW2] + j * 4096; const float* b2 = PP->in[I_HB2] + j * 64;
    const float fr = PP->in[I_HFREQ][j * 64 + u];
    __syncthreads();
    {
      const float tt = (float)l / 4095.f;
      const float ang = 6.283185307179586f * (float)l / 4096.f;
      float f = 0.f;
      if (u == 0) f = tt;
      else if (u <= 16) { const float band = 1e-4f + (float)(u - 1) * ((15.f - 1e-4f) / 15.f); f = cosf(band * ang); }
      else if (u <= 32) { const float band = 1e-4f + (float)(u - 17) * ((15.f - 1e-4f) / 15.f); f = -sinf(band * ang); }
      hin[r * 64 + u] = f;
    }
    __syncthreads();
    float a = b0[u];
    for (int k = 0; k < 33; ++k) a += hin[r * 64 + k] * w0[k * 64 + u];
    float v = sinf(fr * a);
    __syncthreads(); hin[r * 64 + u] = v; __syncthreads();
    a = b1[u];
    for (int k = 0; k < 64; ++k) a += hin[r * 64 + k] * w1[k * 64 + u];
    v = sinf(fr * a);
    __syncthreads(); hin[r * 64 + u] = v; __syncthreads();
    a = b2[u];
    for (int k = 0; k < 64; ++k) a += hin[r * 64 + k] * w2[k * 64 + u];
    v = sinf(fr * a);
    h3[((size_t)j * 4096 + l) * 64 + u] = v;
  }
}

__device__ __forceinline__ void filtgen_phase(const float* hwout, int j, const float* h3, float* kT, unsigned char* smem) {
  float* hs = (float*)smem;
  float* wsm = (float*)(smem + 32768);
  const int tid = tid_fresh(), tl = tid & 15, tc = tid >> 4;
  const float* wout = hwout + (size_t)j * 64 * 2048;
  const float mind = logf(0.01f) / 1.5f, maxd = logf(0.01f) / 0.3f;
  for (int it = blockIdx.x; it < 2048; it += gridDim.x) {
    const int l0 = (it & 63) * 64, c0 = (it >> 6) * 64;
    __syncthreads();
#pragma unroll
    for (int i = 0; i < 4; ++i) {
      const int id = tid + 256 * i, r = id >> 4, c4 = id & 15;
      const float4 hv = *(const float4*)(h3 + ((size_t)j * 4096 + l0 + r) * 64 + c4 * 4);
      float* d = hs + r * 65 + c4 * 4; d[0] = hv.x; d[1] = hv.y; d[2] = hv.z; d[3] = hv.w;
      *(float4*)(wsm + r * 64 + c4 * 4) = *(const float4*)(wout + (size_t)r * 2048 + c0 + c4 * 4);
    }
    __syncthreads();
    float acc[4][4];
#pragma unroll
    for (int i = 0; i < 4; ++i)
#pragma unroll
      for (int k = 0; k < 4; ++k) acc[i][k] = 0.f;
#pragma unroll 4
    for (int u = 0; u < 64; ++u) {
      const float4 w = *(const float4*)(wsm + u * 64 + tc * 4);
#pragma unroll
      for (int i = 0; i < 4; ++i) {
        const float hv = hs[(tl * 4 + i) * 65 + u];
        acc[i][0] += hv * w.x; acc[i][1] += hv * w.y; acc[i][2] += hv * w.z; acc[i][3] += hv * w.w;
      }
    }
#pragma unroll
    for (int k = 0; k < 4; ++k) {
      const int col = c0 + tc * 4 + k, c = col & 1023;
      const float dl = fabsf(mind + (float)c * ((maxd - mind) / 1023.f));
      float4 o;
      o.x = acc[0][k] * expf(-((float)(l0 + tl * 4 + 0) / 4095.f) * dl);
      o.y = acc[1][k] * expf(-((float)(l0 + tl * 4 + 1) / 4095.f) * dl);
      o.z = acc[2][k] * expf(-((float)(l0 + tl * 4 + 2) / 4095.f) * dl);
      o.w = acc[3][k] * expf(-((float)(l0 + tl * 4 + 3) / 4095.f) * dl);
      *(float4*)(kT + (size_t)col * 4096 + l0 + tl * 4) = o;
    }
  }
}

__device__ __forceinline__ void spectrum_phase(const float* kT, const float2* T, float4* spec, unsigned char* smem) {
  float2* buf = (float2*)smem;
  float* red = (float*)smem;
  const int tid = tid_fresh(), lane = tid & 63, wid = tid >> 6;
  for (int pi = blockIdx.x; pi < 512; pi += gridDim.x) {
    const int c1 = 2 * pi;
    const float* f0 = kT + (size_t)c1 * 4096;
    const float* b0 = kT + (size_t)(1024 + c1) * 4096;
    __syncthreads();
    float s1 = 0.f, s2 = 0.f;
#pragma unroll 4
    for (int i = 0; i < 16; ++i) {
      const int l = tid + 256 * i;
      const float a00 = f0[l], a01 = f0[4096 + l], a10 = b0[l], a11 = b0[4096 + l];
      s1 += a00 * a00; s2 += a01 * a01;
      if (l != 0) { s1 += a10 * a10; s2 += a11 * a11; }
    }
#pragma unroll
    for (int o = 32; o > 0; o >>= 1) { s1 += __shfl_xor(s1, o); s2 += __shfl_xor(s2, o); }
    if (lane == 0) { red[wid * 2] = s1; red[wid * 2 + 1] = s2; }
    __syncthreads();
    s1 = red[0] + red[2] + red[4] + red[6]; s2 = red[1] + red[3] + red[5] + red[7];
    __syncthreads();
#pragma unroll 4
    for (int i = 0; i < 16; ++i) {
      const int l = tid + 256 * i;
      const float a00 = f0[l], a01 = f0[4096 + l], a10 = b0[l], a11 = b0[4096 + l];
      buf[PH(l)] = make_float2(a00, a01);
      if (l == 0) buf[PH(4096)] = make_float2(0.f, 0.f);
      else buf[PH(8192 - l)] = make_float2(a10, a11);
    }
    __syncthreads();
    const float sc1 = rsqrtf(s1 + 1e-6f) * (1.f / 8192.f);
    const float sc2 = rsqrtf(s2 + 1e-6f) * (1.f / 8192.f);
    fft_dif(buf, T);
    for (int k = tid; k <= 4096; k += NT) {
      const int pk_ = brev13(k), pn_ = brev13((8192 - k) & 8191);
      const float2 Pk = buf[PH(pk_)], Fn = buf[PH(pn_)];
      const float2 Qc = make_float2(Fn.x, -Fn.y);
      const float2 H1 = make_float2(0.5f * (Pk.x + Qc.x) * sc1, 0.5f * (Pk.y + Qc.y) * sc1);
      const float2 H2 = make_float2(0.5f * (Pk.y - Qc.y) * sc2, -0.5f * (Pk.x - Qc.x) * sc2);
      spec[(size_t)pi * SPEC_STRIDE + k] = make_float4(0.5f * (H1.x + H2.x), 0.5f * (H1.y + H2.y), 0.5f * (H1.x - H2.x), 0.5f * (H1.y - H2.y));
    }
  }
}

__device__ __forceinline__ void z_phase(const bf16_t* X1, const bf16_t* V, const float* cw  , const float* cb  , bf16_t* zT, unsigned char* smem) {
  float* zs = (float*)smem;
  const int tid = tid_fresh(), c8 = tid & 7, tr = tid >> 3;
  for (int it = blockIdx.x; it < 8192; it += gridDim.x) {
    const int ct = it & 15, tt = it >> 4, c0 = ct * 64, t0 = tt * 64;
    __syncthreads();
    const int c = c0 + c8 * 8;
    float w1[3][8], w2[3][8], bb1[8], bb2[8];
#pragma unroll
    for (int e = 0; e < 8; ++e) {
#pragma unroll
      for (int k = 0; k < 3; ++k) { w1[k][e] = cw[k * 3072 + 1024 + c + e]; w2[k][e] = cw[k * 3072 + 2048 + c + e]; }
      bb1[e] = cb[1024 + c + e]; bb2[e] = cb[2048 + c + e];
    }
#pragma unroll
    for (int i = 0; i < 2; ++i) {
      const int tl = tr + 32 * i, t = t0 + tl, tb = t & (SEQ - 1);
      float a1[8], a2[8];
#pragma unroll
      for (int e = 0; e < 8; ++e) { a1[e] = bb1[e]; a2[e] = bb2[e]; }
#pragma unroll
      for (int k = 0; k < 3; ++k) {
        const int tbk = tb + k - 1;
        if (tbk >= 0 && tbk < SEQ) {
          float f[8], g[8];
          unpack8(*(const uint4*)(X1 + (size_t)(t + k - 1) * 1024 + c), f);
          unpack8(*(const uint4*)(V + (size_t)(t + k - 1) * 1024 + c), g);
#pragma unroll
          for (int e = 0; e < 8; ++e) { a1[e] += w1[k][e] * f[e]; a2[e] += w2[k][e] * g[e]; }
        }
      }
#pragma unroll
      for (int e = 0; e < 8; ++e) zs[(c8 * 8 + e) * 65 + tl] = a1[e] * a2[e];
    }
    __syncthreads();
    {
      const int cl = tid >> 2, tq = tid & 3;
      const int bidx = t0 >> 12, tbase = t0 & (SEQ - 1);
      bf16_t* dst = zT + ((size_t)(bidx * 1024 + c0 + cl)) * SEQ + tbase + tq * 16;
      const float* sr = zs + cl * 65 + tq * 16;
      *(uint4*)dst = make_uint4(pack2(sr[0], sr[1]), pack2(sr[2], sr[3]), pack2(sr[4], sr[5]), pack2(sr[6], sr[7]));
      *(uint4*)(dst + 8) = make_uint4(pack2(sr[8], sr[9]), pack2(sr[10], sr[11]), pack2(sr[12], sr[13]), pack2(sr[14], sr[15]));
    }
  }
}

__device__ __forceinline__ void fftconv_phase(bf16_t* zT, const float4* spec, const float2* T, const float* hd, unsigned char* smem) {
  float2* buf = (float2*)smem;
  const int tid = tid_fresh();
  for (int it = blockIdx.x; it < 4096; it += gridDim.x) {
    const int b = (it >> 3) & 7, pi = (it & 7) + 8 * (it >> 6), c1 = 2 * pi;
    bf16_t* z1 = zT + ((size_t)(b * 1024 + c1)) * SEQ;
    bf16_t* z2 = z1 + SEQ;
    __syncthreads();
    for (int t = tid; t < 4096; t += NT) buf[PH(t)] = make_float2(bf2f(z1[t]), bf2f(z2[t]));
    __syncthreads();
    fft_r8<true, 1>(buf, T, 10); fft_r8<true>(buf, T, 7); fft_r8<true>(buf, T, 4); fft_r8<true>(buf, T, 1);
    const float4* sp = spec + (size_t)pi * SPEC_STRIDE;
    for (int f = tid; f <= 2048; f += NT) {
      const int p0 = brev13(f);
      const float2 a0 = buf[PH(p0)], b0 = buf[PH(p0 + 1)];
      const float2 Xf = cadd(a0, b0), Xf4 = csub(a0, b0);
      const float4 s1 = sp[f];
      const float2 S1 = make_float2(s1.x, s1.y), D1 = make_float2(s1.z, s1.w);
      if (f == 0 || f == 2048) {
        float2 W0, W1;
        if (f == 0) {
          const float4 s2 = sp[4096];
          W0 = cadd(cmul(Xf, S1), cmul(make_float2(Xf.x, -Xf.y), D1));
          W1 = cadd(cmul(Xf4, make_float2(s2.x, s2.y)), cmul(make_float2(Xf4.x, -Xf4.y), make_float2(s2.z, s2.w)));
        } else {
          W0 = cadd(cmul(Xf, S1), cmul(make_float2(Xf4.x, -Xf4.y), D1));
          W1 = cadd(cmul(Xf4, make_float2(S1.x, -S1.y)), cmul(make_float2(Xf.x, -Xf.y), make_float2(D1.x, -D1.y)));
        }
        const float2 c0 = make_float2(W0.x, -W0.y), c1 = make_float2(W1.x, -W1.y);
        buf[PH(p0)] = cadd(c0, c1); buf[PH(p0 + 1)] = csub(c0, c1);
      } else {
        const int fp = 4096 - f, p1 = brev13(fp);
        const float2 a1 = buf[PH(p1)], b1 = buf[PH(p1 + 1)];
        const float2 Xg = cadd(a1, b1), Xg4 = csub(a1, b1);
        const float4 s2 = sp[fp];
        const float2 S2 = make_float2(s2.x, s2.y), D2 = make_float2(s2.z, s2.w);
        const float2 Wf  = cadd(cmul(Xf, S1), cmul(make_float2(Xg4.x, -Xg4.y), D1));
        const float2 Wg4 = cadd(cmul(Xg4, make_float2(S1.x, -S1.y)), cmul(make_float2(Xf.x, -Xf.y), make_float2(D1.x, -D1.y)));
        const float2 Wg  = cadd(cmul(Xg, S2), cmul(make_float2(Xf4.x, -Xf4.y), D2));
        const float2 Wf4 = cadd(cmul(Xf4, make_float2(S2.x, -S2.y)), cmul(make_float2(Xg.x, -Xg.y), make_float2(D2.x, -D2.y)));
        float2 c0 = make_float2(Wf.x, -Wf.y), c1 = make_float2(Wf4.x, -Wf4.y);
        buf[PH(p0)] = cadd(c0, c1); buf[PH(p0 + 1)] = csub(c0, c1);
        c0 = make_float2(Wg.x, -Wg.y); c1 = make_float2(Wg4.x, -Wg4.y);
        buf[PH(p1)] = cadd(c0, c1); buf[PH(p1 + 1)] = csub(c0, c1);
      }
    }
    __syncthreads();
    fft_r8<false>(buf, T, 1); fft_r8<false>(buf, T, 4); fft_r8<false>(buf, T, 7); fft_r8<false, 2>(buf, T, 10);
    const float d1 = hd[c1], d2 = hd[c1 + 1];
    for (int t = tid; t < 4096; t += NT) {
      const float2 y = buf[PH(t)];
      z1[t] = f2bf(y.x + d1 * bf2f(z1[t]));
      z2[t] = f2bf(-y.y + d2 * bf2f(z2[t]));
    }
  }
}

__device__ __forceinline__ void ya_phase(const bf16_t* X0, const bf16_t* yT, const float* cw, const float* cb, bf16_t* MA, unsigned char* smem) {
  float* ys = (float*)smem;
  const int tid = tid_fresh(), c8 = tid & 7, tr = tid >> 3;
  for (int it = blockIdx.x; it < 8192; it += gridDim.x) {
    const int ct = it & 15, tt = it >> 4, c0 = ct * 64, t0 = tt * 64;
    __syncthreads();
    {
      const int cl = tid >> 2, tq = tid & 3;
      const int bidx = t0 >> 12, tbase = t0 & (SEQ - 1);
      const bf16_t* src = yT + ((size_t)(bidx * 1024 + c0 + cl)) * SEQ + tbase + tq * 16;
      float f[8];
      float* sw = ys + cl * 65 + tq * 16;
      unpack8(*(const uint4*)src, f);
#pragma unroll
      for (int e = 0; e < 8; ++e) sw[e] = f[e];
      unpack8(*(const uint4*)(src + 8), f);
#pragma unroll
      for (int e = 0; e < 8; ++e) sw[8 + e] = f[e];
    }
    __syncthreads();
    const int c = c0 + c8 * 8;
    float w0[3][8], bb[8];
#pragma unroll
    for (int e = 0; e < 8; ++e) {
#pragma unroll
      for (int k = 0; k < 3; ++k) w0[k][e] = cw[k * 3072 + c + e];
      bb[e] = cb[c + e];
    }
#pragma unroll
    for (int i = 0; i < 2; ++i) {
      const int tl = tr + 32 * i, t = t0 + tl, tb = t & (SEQ - 1);
      float a[8];
#pragma unroll
      for (int e = 0; e < 8; ++e) a[e] = bb[e];
#pragma unroll
      for (int k = 0; k < 3; ++k) {
        const int tbk = tb + k - 1;
        if (tbk >= 0 && tbk < SEQ) {
          float f[8];
          unpack8(*(const uint4*)(X0 + (size_t)(t + k - 1) * 1024 + c), f);
#pragma unroll
          for (int e = 0; e < 8; ++e) a[e] += w0[k][e] * f[e];
        }
      }
#pragma unroll
      for (int e = 0; e < 8; ++e) a[e] *= ys[(c8 * 8 + e) * 65 + tl];
      *(uint4*)(MA + (size_t)t * 1024 + c) = make_uint4(pack2(a[0], a[1]), pack2(a[2], a[3]), pack2(a[4], a[5]), pack2(a[6], a[7]));
    }
  }
}

__device__ __forceinline__ void convT_job(const float* src, int K, int N, bf16_t* dst, const float* scale, unsigned char* smem) {
  float* ts = (float*)smem;
  const int tid = tid_fresh();
  const int tn = N >> 6, ntile = (K >> 6) * tn;
  for (int it = blockIdx.x; it < ntile; it += gridDim.x) {
    const int k0 = (it / tn) * 64, n0 = (it % tn) * 64;
    __syncthreads();
#pragma unroll
    for (int i = 0; i < 4; ++i) {
      const int r = (tid >> 4) + 16 * i, c4 = tid & 15;
      float4 v = *(const float4*)(src + (size_t)(k0 + r) * N + n0 + c4 * 4);
      const float s = scale ? scale[k0 + r] : 1.f;
      float* d = ts + r * 65 + c4 * 4;
      d[0] = v.x * s; d[1] = v.y * s; d[2] = v.z * s; d[3] = v.w * s;
    }
    __syncthreads();
#pragma unroll
    for (int i = 0; i < 2; ++i) {
      const int id = tid + 256 * i, nn = id >> 3, kc = id & 7;
      float f[8];
#pragma unroll
      for (int e = 0; e < 8; ++e) f[e] = ts[(kc * 8 + e) * 65 + nn];
      *(uint4*)(dst + (size_t)(n0 + nn) * K + k0 + kc * 8) = make_uint4(pack2(f[0], f[1]), pack2(f[2], f[3]), pack2(f[4], f[5]), pack2(f[6], f[7]));
    }
  }
}
__device__ __forceinline__ void conv_plain(const float* src, bf16_t* dst, size_t n) {
  const size_t stride = (size_t)gridDim.x * NT * 8;
  for (size_t i = ((size_t)blockIdx.x * NT + tid_fresh()) * 8; i < n; i += stride) {
    const float4 a = *(const float4*)(src + i), b = *(const float4*)(src + i + 4);
    *(uint4*)(dst + i) = make_uint4(pack2(a.x, a.y), pack2(a.z, a.w), pack2(b.x, b.y), pack2(b.z, b.w));
  }
}

__device__ __forceinline__ void convx_rows(const float* x, bf16_t* hb, float* pa) {
  const int tid = tid_fresh(), wave = tid >> 6, lane = tid & 63;
  for (int row = blockIdx.x * 4 + wave; row < TOK; row += gridDim.x * 4) {
    const float* p = x + (size_t)row * 1024;
    float s = 0.f;
#pragma unroll
    for (int i = 0; i < 2; ++i) {
      const float4 a = *(const float4*)(p + i * 512 + lane * 8), b = *(const float4*)(p + i * 512 + lane * 8 + 4);
      *(uint4*)(hb + (size_t)row * 1024 + i * 512 + lane * 8) = make_uint4(pack2(a.x, a.y), pack2(a.z, a.w), pack2(b.x, b.y), pack2(b.z, b.w));
      s += a.x * a.x + a.y * a.y + a.z * a.z + a.w * a.w + b.x * b.x + b.y * b.y + b.z * b.z + b.w * b.w;
    }
#pragma unroll
    for (int o = 32; o > 0; o >>= 1) s += __shfl_xor(s, o);
    if (lane < 16) pa[(size_t)row * 16 + lane] = (lane == 0) ? s : 0.f;
  }
}

__device__ __forceinline__ void final_norm(float* h, const float* g) {
  const int tid = tid_fresh(), wave = tid >> 6, lane = tid & 63;
  for (int row = blockIdx.x * 4 + wave; row < TOK; row += gridDim.x * 4) {
    float* p = h + (size_t)row * 1024;
    float4 v[4]; float s = 0.f;
#pragma unroll
    for (int i = 0; i < 4; ++i) { v[i] = *(const float4*)(p + i * 256 + lane * 4); s += v[i].x * v[i].x + v[i].y * v[i].y + v[i].z * v[i].z + v[i].w * v[i].w; }
#pragma unroll
    for (int o = 32; o > 0; o >>= 1) s += __shfl_xor(s, o);
    const float r = rsqrtf(s * (1.f / 1024.f) + 1e-6f);
#pragma unroll
    for (int i = 0; i < 4; ++i) {
      const float4 gg = *(const float4*)(g + i * 256 + lane * 4);
      *(float4*)(p + i * 256 + lane * 4) = make_float4(v[i].x * r * gg.x, v[i].y * r * gg.y, v[i].z * r * gg.z, v[i].w * r * gg.w);
    }
  }
}


#define XB_TMO      128
#define XB_XCNT(j)  (256  + 64 * (j))
#define XB_XSUB(j)  (1280 + 64 * (j))
#define XB_XGEN(j)  (2304 + 64 * (j))
#define XB_TOP      3328
#define XB_TOPGEN   3392
#define XCD_BAR_WORDS 3456
#define XB_SPIN_CAP (1u << 18)
__device__ __forceinline__ unsigned xb_ld(unsigned* p)              { return __hip_atomic_load(p, __ATOMIC_RELAXED, __HIP_MEMORY_SCOPE_AGENT); }
__device__ __forceinline__ unsigned xb_add(unsigned* p, unsigned v) { return __hip_atomic_fetch_add(p, v, __ATOMIC_RELAXED, __HIP_MEMORY_SCOPE_AGENT); }
__device__ __forceinline__ unsigned xb_xcc_id() { unsigned v; asm volatile("s_getreg_b32 %0, hwreg(HW_REG_XCC_ID, 0, 4)" : "=s"(v)); return v & 0xFu; }
#define XB_SPIN(cond, bar) do { unsigned _sp = 0; while (cond) { __builtin_amdgcn_s_sleep(1); \
    if ((++_sp & 255u) == 0u) { if (xb_ld(&(bar)[XB_TMO])) break; if (_sp > XB_SPIN_CAP) { atomicAdd(&(bar)[XB_TMO], 1u); break; } } } } while (0)
__device__ __forceinline__ void xcd_barrier(unsigned* bar) {
  asm volatile("s_waitcnt vmcnt(0) lgkmcnt(0)" ::: "memory");
  __syncthreads();
  if (tid_fresh() == 0) {
    __builtin_amdgcn_s_waitcnt(0);
    const unsigned x = xb_xcc_id();
    int bi = blockIdx.x; asm volatile("" : "+s"(bi));
    const uint2 census = *(const uint2*)(bar + XCD_BAR_WORDS + 2 * bi);
    const unsigned nloc = census.x, nx = census.y;
    const unsigned old = xb_add(&bar[XB_XSUB(x)], 1u);
    const unsigned gen = old / nloc;
    if (old + 1u == (gen + 1u) * nloc) {
      __builtin_amdgcn_fence(__ATOMIC_RELEASE, "agent");
      asm volatile("s_waitcnt vmcnt(0)" ::: "memory");
      const unsigned og = xb_add(&bar[XB_TOP], 1u);
      const unsigned tg = og / nx;
      if (og + 1u == (tg + 1u) * nx) xb_add(&bar[XB_TOPGEN], 1u);
      else XB_SPIN(xb_ld(&bar[XB_TOPGEN]) == tg, bar);
      __builtin_amdgcn_fence(__ATOMIC_ACQUIRE, "agent");
      xb_add(&bar[XB_XGEN(x)], 1u);
      asm volatile("s_waitcnt vmcnt(0)" ::: "memory");
    } else {
      XB_SPIN(xb_ld(&bar[XB_XGEN(x)]) == gen, bar);
      __builtin_amdgcn_fence(__ATOMIC_ACQUIRE, "agent");
      asm volatile("s_waitcnt vmcnt(0)" ::: "memory");
    }
  }
  __syncthreads();
}

#define GSYNC() do { asm volatile("s_waitcnt vmcnt(0) lgkmcnt(0)" ::: "memory"); grid.sync(); \
    if (tid_fresh() < 64) { __builtin_amdgcn_fence(__ATOMIC_ACQUIRE, "agent"); asm volatile("s_waitcnt vmcnt(0)" ::: "memory"); } \
    __syncthreads(); } while (0)
#define XSYNC() xcd_barrier((unsigned*)WSP(BAR_OFF))
#define INP(i) (params_fresh()->in[i])
#define WBP ((bf16_t*)WSP(WB_OFF))
#define HBA ((bf16_t*)WSP(HBA_OFF))
#define SPECP ((float4*)WSP(SPEC_OFF))
#define H3P ((float*)WSP(H3_OFF))
#define TWP ((float2*)WSP(TW_OFF))
#define SLOT(i) ((bf16_t*)WSP(R_OFF + (size_t)(i) * 64 * MiB))
#define HRES (params_fresh()->out)

__global__ void __launch_bounds__(NT, 2) mega(Params Pdummy) {
  __shared__ __attribute__((aligned(16))) unsigned char smem[65536];
  cg::grid_group grid = cg::this_grid();
  if (tid_fresh() == 0) (void)xb_add(&((unsigned*)WSP(BAR_OFF))[XB_XCNT(xb_xcc_id())], 1u);

  for (int j = 0; j < 2; ++j) {
    convT_job(INP(I_EWIN) + (size_t)j * 1024 * 7168, 1024, 7168, WBP + W_EIN + (size_t)j * 7340032, INP(I_NORMG) + (2 * j) * 1024, smem);
    convT_job(INP(I_OWIN) + (size_t)j * 1024 * 6144, 1024, 6144, WBP + W_OIN + (size_t)j * 6291456, INP(I_NORMG) + (2 * j + 1) * 1024, smem);
    convT_job(INP(I_EWOUT) + (size_t)j * 2048 * 1024, 2048, 1024, WBP + W_EOUT + (size_t)j * 2097152, nullptr, smem);
    convT_job(INP(I_OWOUT) + (size_t)j * 2048 * 1024, 2048, 1024, WBP + W_OOUT + (size_t)j * 2097152, nullptr, smem);
    for (int g = 0; g < 4; ++g)
      convT_job(INP(I_POOLW) + (size_t)(j * 4 + g) * 65536, 256, 256, WBP + W_POOL + (size_t)(j * 4 + g) * 65536, nullptr, smem);
  }
  for (int i = 0; i < 4; ++i) {
    convT_job(INP(I_PGATE) + (size_t)i * 1048576, 1024, 1024, WBP + W_PGATE + (size_t)i * 1048576, INP(I_PLEG) + i * 1024, smem);
    convT_job(INP(I_PUP) + (size_t)i * 262144, 256, 1024, WBP + W_PUP + (size_t)i * 262144, nullptr, smem);
  }
  conv_plain(INP(I_GMWS), WBP + W_GMWS, 262144);
  convx_rows(INP(I_X), HBA, (float*)WSP(PA_OFF));
  hyena_feats(H3P, smem);
  {
    float2* T = TWP;
    for (int k = blockIdx.x * NT + tid_fresh(); k < 4096; k += gridDim.x * NT) {
      float s, c; sincospif((float)k / 4096.f, &s, &c);
      T[k] = make_float2(c, -s);
    }
  }
  if (gridDim.y == 0x7fffu) grid.sync();
  if (tid_fresh() == 0) {
    unsigned* bar = (unsigned*)WSP(BAR_OFF);
    const unsigned x = xb_xcc_id();
    unsigned nloc = 0u, nx = 0u, sum = 0u, sp = 0u;
    for (;;) {
      sum = 0u; nx = 0u; nloc = 0u;
#pragma unroll
      for (unsigned jx = 0; jx < 16; ++jx) { const unsigned c = xb_ld(&bar[XB_XCNT(jx)]); sum += c; nx += (c > 0u) ? 1u : 0u; nloc = (jx == x) ? c : nloc; }
      if (sum == gridDim.x) break;
      __builtin_amdgcn_s_sleep(1);
      if ((++sp & 255u) == 0u) { if (xb_ld(&bar[XB_TMO])) break; if (sp > XB_SPIN_CAP) { atomicAdd(&bar[XB_TMO], 1u); break; } }
    }
    *(uint2*)(bar + XCD_BAR_WORDS + 2 * blockIdx.x) = make_uint2(nloc > 0u ? nloc : 1u, nx > 0u ? nx : 1u);
  }
  XSYNC();
  filtgen_phase(INP(I_HWOUT), 0, H3P, (float*)SLOT(3), smem);
  XSYNC();

#pragma unroll 1
  for (int layer = 0; layer < 4; ++layer) {
    const int j = layer >> 1;
    if ((layer & 1) == 0) {
      spectrum_phase((const float*)SLOT(3), TWP, SPECP, smem);
      inproj_phase(HBA, WBP + W_EIN + (size_t)j * 7340032, 3, 0, 1024, 2048, 0, SLOT(0), SLOT(1), SLOT(2), nullptr, 0, 0, 0, 0, smem);
      XSYNC();
      z_phase(SLOT(1), SLOT(2), INP(I_CONVW) + (size_t)j * 9216, INP(I_CONVB) + (size_t)j * 3072, SLOT(3), smem);
      XSYNC();
      fftconv_phase(SLOT(3), SPECP, TWP, INP(I_HD) + j * 1024, smem);
      XSYNC();
      ya_phase(SLOT(0), SLOT(3), INP(I_CONVW) + (size_t)j * 9216, INP(I_CONVB) + (size_t)j * 3072, SLOT(1), smem);
      inproj_phase(HBA, WBP + W_EIN + (size_t)j * 7340032, 2, 4096, 5120, 0, 0, SLOT(4), SLOT(2), nullptr, nullptr, 0, 3, 0, 0, smem);
      XSYNC();
      gmlp_phase(SLOT(4), SLOT(2), WBP + W_GMWS + (size_t)j * 131072, INP(I_GMG) + j * 1024, INP(I_GMBS) + j * 1024, smem);
      XSYNC();
      inproj_phase(HBA, WBP + W_EIN + (size_t)j * 7340032, 2, 3072, 6144, 0, 0, SLOT(1), SLOT(4), nullptr, nullptr, 2, 2, 0, 0, smem);
      XSYNC();
      outproj_phase(SLOT(1), SLOT(4), WBP + W_EOUT + (size_t)j * 2097152, (layer == 0) ? INP(I_X) : (const float*)HRES, HRES, SLOT(3), smem);
      XSYNC();
      ple_phase(SLOT(3), INP(I_P) + (size_t)layer * TOK * 256, WBP + W_PGATE + (size_t)layer * 1048576, WBP + W_PUP + (size_t)layer * 262144, HRES, HBA, smem);
      XSYNC();
    } else {
      inproj_phase(HBA, WBP + W_OIN + (size_t)j * 6291456, 4, 0, 2048, 3072, 4096, SLOT(0), SLOT(1), SLOT(2), SLOT(3), 0, 0, 0, 1, smem);
      XSYNC();
      pool_phase(SLOT(0), WBP + W_POOL + (size_t)j * 262144, INP(I_POOLB) + j * 1024, INP(I_POOLS) + j * 1024, SLOT(4), smem);
      na_phase(SLOT(1), SLOT(2), SLOT(3), INP(I_RPB) + (size_t)j * 16 * 15 * 31, smem);
      XSYNC();
      inproj_phase(HBA, WBP + W_OIN + (size_t)j * 6291456, 2, 1024, 5120, 0, 0, SLOT(4), SLOT(1), nullptr, nullptr, 2, 2, 0, 0, smem);
      XSYNC();
      outproj_phase(SLOT(4), SLOT(1), WBP + W_OOUT + (size_t)j * 2097152, HRES, HRES, SLOT(2), smem);
      XSYNC();
      ple_phase(SLOT(2), INP(I_P) + (size_t)layer * TOK * 256, WBP + W_PGATE + (size_t)layer * 1048576, WBP + W_PUP + (size_t)layer * 262144, HRES, HBA, smem);
      if (layer == 1) filtgen_phase(INP(I_HWOUT), 1, H3P, (float*)SLOT(3), smem);
      XSYNC();
    }
  }
  final_norm(HRES, INP(I_FINALG));
}

extern "C" void kernel_launch(void* const* d_in, const int* in_sizes, int n_in, void* d_out, int out_size, void* d_ws, size_t ws_size, hipStream_t stream) {
  static int grid_blocks = 0;
  if (grid_blocks == 0) {
    if (n_in != 29 || out_size != TOK * 1024 || ws_size < WS_END) { fprintf(stderr, "kernel_launch: unexpected shapes (n_in %d out %d ws %zu)\n", n_in, out_size, ws_size); grid_blocks = -1; return; }
    int dev = 0, cus = 0, per_cu = 0;
    if (hipGetDevice(&dev) != hipSuccess || hipDeviceGetAttribute(&cus, hipDeviceAttributeMultiprocessorCount, dev) != hipSuccess) { grid_blocks = -1; return; }
    if (hipOccupancyMaxActiveBlocksPerMultiprocessor(&per_cu, (const void*)mega, NT, LDS_BYTES) != hipSuccess || per_cu < 1) { fprintf(stderr, "occupancy query failed\n"); per_cu = 1; }
    if (per_cu > 2) per_cu = 2;
    grid_blocks = cus * per_cu;
  }
  if (grid_blocks < 0) return;
  Params p{};
  for (int i = 0; i < 29; ++i) p.in[i] = (const float*)d_in[i];
  p.out = (float*)d_out; p.ws = (unsigned char*)d_ws;
  if (hipMemsetAsync((unsigned char*)d_ws + BAR_OFF, 0, XCD_BAR_WORDS * sizeof(unsigned), stream) != hipSuccess) { fprintf(stderr, "memset of barrier words failed\n"); return; }
  void* args[] = {&p};
  hipError_t e = hipLaunchCooperativeKernel((const void*)mega, dim3(grid_blocks), dim3(NT), args, LDS_BYTES, stream);
  if (e != hipSuccess) fprintf(stderr, "cooperative launch failed: %s (grid %d)\n", hipGetErrorString(e), grid_blocks);
}
```

```cpp
#include <hip/hip_runtime.h>
#include <hip/hip_cooperative_groups.h>
#include <cstdio>
namespace cg = cooperative_groups;

typedef unsigned short bf16_t;
typedef short bf16x8 __attribute__((ext_vector_type(8)));
typedef short bf16x4 __attribute__((ext_vector_type(4)));
typedef float f32x4 __attribute__((ext_vector_type(4)));

#define NT 256
constexpr int LDS_BYTES = 0;
constexpr size_t MiB = 1u << 20;
constexpr size_t WB_OFF = 0, HBA_OFF = 80 * MiB, SPEC_OFF = 144 * MiB, H3_OFF = 177 * MiB, TW_OFF = 179 * MiB, R_OFF = 180 * MiB, PART_OFF = 500 * MiB, BAR_OFF = 502 * MiB, RSTD_OFF = 503 * MiB, PA_OFF = 504 * MiB, PB_OFF = 506 * MiB, WS_END = 508 * MiB;
constexpr int TOK = 32768, SEQ = 4096, DM = 1024;
constexpr size_t W_EIN = 0, W_OIN = 14680064, W_EOUT = 27262976, W_OOUT = 31457280, W_PGATE = 35651584, W_PUP = 39845888, W_POOL = 40894464, W_GMWS = 41418752;
constexpr int SPEC_STRIDE = 4104;

struct Params { const float* in[29]; float* out; unsigned char* ws; };
enum { I_X = 0, I_P, I_NORMG, I_FINALG, I_EWIN, I_CONVW, I_CONVB, I_HW0, I_HB0, I_HW1, I_HB1, I_HW2, I_HB2, I_HWOUT, I_HFREQ, I_HD, I_GMG, I_GMWS, I_GMBS, I_EWOUT, I_OWIN, I_POOLW, I_POOLB, I_POOLS, I_RPB, I_OWOUT, I_PUP, I_PGATE, I_PLEG };

__device__ __forceinline__ unsigned pack2(float lo, float hi);
__device__ __forceinline__ unsigned short f2bf(float f) { return (unsigned short)(pack2(f, 0.f) & 0xffffu); }
__device__ __forceinline__ float bf2f(unsigned short h) { return __uint_as_float(((unsigned)h) << 16); }
typedef __bf16 bf16v2_t __attribute__((ext_vector_type(2)));
typedef float f32v2_t __attribute__((ext_vector_type(2)));
__device__ __forceinline__ unsigned pack2(float lo, float hi) { const f32v2_t v = {lo, hi}; const bf16v2_t b = __builtin_convertvector(v, bf16v2_t); return __builtin_bit_cast(unsigned, b); }
__device__ __forceinline__ float lo_f(unsigned u) { return __uint_as_float(u << 16); }
__device__ __forceinline__ float hi_f(unsigned u) { return __uint_as_float(u & 0xffff0000u); }
__device__ __forceinline__ float silu_f(float v) { return v * __builtin_amdgcn_rcpf(1.f + __expf(-v)); }
__device__ __forceinline__ float sigmoid_f(float v) { return __builtin_amdgcn_rcpf(1.f + __expf(-v)); }
__device__ __forceinline__ void unpack8(const uint4& u, float* f) { f[0] = lo_f(u.x); f[1] = hi_f(u.x); f[2] = lo_f(u.y); f[3] = hi_f(u.y); f[4] = lo_f(u.z); f[5] = hi_f(u.z); f[6] = lo_f(u.w); f[7] = hi_f(u.w); }

typedef const Params __attribute__((address_space(4)))* KP;
__device__ __forceinline__ KP params_fresh() { KP p = (KP)__builtin_amdgcn_kernarg_segment_ptr(); asm volatile("" : "+s"(p)); return p; }
#define WSP(off) (params_fresh()->ws + (off))
__device__ __forceinline__ int tid_fresh() { int t = threadIdx.x; asm volatile("" : "+v"(t)); return t; }

__device__ __forceinline__ int swz(int row, int kc) { return row * 128 + ((kc ^ ((row >> 1) & 7)) << 4); }

template <int AM, bool SS>
__device__ __forceinline__ void load_a1(int tid, uint4& out, float& ssq, const void* A0, const void* A1, int lda, int row, int k0, int aux) {
  const int kc = tid & 7;
  if (AM == 0) {
    out = *(const uint4*)((const bf16_t*)A0 + (size_t)row * lda + k0 + kc * 8);
  } else if (AM == 2) {
    const bf16_t* src = (k0 < 1024) ? (const bf16_t*)A0 : (const bf16_t*)A1;
    out = *(const uint4*)(src + (size_t)row * lda + (k0 & 1023) + kc * 8);
  } else if (AM == 1) {
    const float* src = (const float*)A0 + (size_t)row * lda + k0 + kc * 8;
    const float4 a = *(const float4*)src, b = *(const float4*)(src + 4);
    out = make_uint4(pack2(a.x, a.y), pack2(a.z, a.w), pack2(b.x, b.y), pack2(b.z, b.w));
  } else {
    const bf16_t* src = (const bf16_t*)A0 + k0 + kc * 8;
    const int half = 1 << aux;
    const int tb = row & (SEQ - 1), base = row - tb;
    const int lo = max(tb - half, 0), hi = min(tb + half, SEQ);
    float s0 = 0.f, s1 = 0.f, s2 = 0.f, s3 = 0.f, s4 = 0.f, s5 = 0.f, s6 = 0.f, s7 = 0.f;
    const int cnt = hi - lo;
    const bf16_t* wp = src + (size_t)(base + lo) * lda;
#pragma unroll 1
    for (int d0 = 0; d0 < cnt; d0 += 8) {
      uint4 wv[8];
#pragma unroll
      for (int d = 0; d < 8; ++d) wv[d] = (d0 + d < cnt) ? *(const uint4*)(wp + (size_t)(d0 + d) * lda) : make_uint4(0u, 0u, 0u, 0u);
#pragma unroll
      for (int d = 0; d < 8; ++d) {
        s0 += lo_f(wv[d].x); s1 += hi_f(wv[d].x); s2 += lo_f(wv[d].y); s3 += hi_f(wv[d].y); s4 += lo_f(wv[d].z); s5 += hi_f(wv[d].z); s6 += lo_f(wv[d].w); s7 += hi_f(wv[d].w);
      }
    }
    const uint4 u = *(const uint4*)(src + (size_t)row * lda);
    const float inv = 1.f / (float)(hi - lo);
    out = make_uint4(pack2(s0 * inv - lo_f(u.x), s1 * inv - hi_f(u.x)), pack2(s2 * inv - lo_f(u.y), s3 * inv - hi_f(u.y)),
                     pack2(s4 * inv - lo_f(u.z), s5 * inv - hi_f(u.z)), pack2(s6 * inv - lo_f(u.w), s7 * inv - hi_f(u.w)));
  }
}
template <int AM, bool SS>
__device__ __forceinline__ void load_a(int tid, uint4& a0, uint4& a1, uint4& a2, uint4& a3, const void* A0, const void* A1, int lda, int m0, int k0, int aux, float (&ss)[4]) {
  const int row = m0 + (tid >> 3);
  load_a1<AM, SS>(tid, a0, ss[0], A0, A1, lda, row, k0, aux);
  load_a1<AM, SS>(tid, a1, ss[1], A0, A1, lda, row + 32, k0, aux);
  load_a1<AM, SS>(tid, a2, ss[2], A0, A1, lda, row + 64, k0, aux);
  load_a1<AM, SS>(tid, a3, ss[3], A0, A1, lda, row + 96, k0, aux);
}
__device__ __forceinline__ void load_b(int tid, uint4& b0, uint4& b1, uint4& b2, uint4& b3, const bf16_t* Bt, int ldb, int n0, int k0) {
  const bf16_t* p = Bt + (size_t)(n0 + (tid >> 3)) * ldb + k0 + (tid & 7) * 8;
  b0 = *(const uint4*)p; b1 = *(const uint4*)(p + (size_t)32 * ldb); b2 = *(const uint4*)(p + (size_t)64 * ldb); b3 = *(const uint4*)(p + (size_t)96 * ldb);
}
__device__ __forceinline__ void store_tile(int tid, unsigned char* dst, const uint4& r0v, const uint4& r1v, const uint4& r2v, const uint4& r3v) {
  const int r0 = tid >> 3, kc = tid & 7;
  *(uint4*)(dst + swz(r0, kc)) = r0v; *(uint4*)(dst + swz(r0 + 32, kc)) = r1v; *(uint4*)(dst + swz(r0 + 64, kc)) = r2v; *(uint4*)(dst + swz(r0 + 96, kc)) = r3v;
}

__device__ __forceinline__ float ssq8(const uint4& v) {
  const float f0 = lo_f(v.x), f1 = hi_f(v.x), f2 = lo_f(v.y), f3 = hi_f(v.y), f4 = lo_f(v.z), f5 = hi_f(v.z), f6 = lo_f(v.w), f7 = hi_f(v.w);
  return f0 * f0 + f1 * f1 + f2 * f2 + f3 * f3 + f4 * f4 + f5 * f5 + f6 * f6 + f7 * f7;
}
template <bool SS>
__device__ __forceinline__ void store_a(int tid, unsigned char* dst, const uint4& a0, const uint4& a1, const uint4& a2, const uint4& a3, float (&ss)[4]) {
  if (SS) { ss[0] += ssq8(a0); ss[1] += ssq8(a1); ss[2] += ssq8(a2); ss[3] += ssq8(a3); }
  store_tile(tid, dst, a0, a1, a2, a3);
}
template <bool SWAP>
__device__ __forceinline__ void mma_tile(f32x4 (&acc)[4][4], const unsigned char* cur, int wr, int wc, int fr, int fq) {
#pragma unroll
  for (int s = 0; s < 2; ++s) {
    bf16x8 af[4], bfr[4];
#pragma unroll
    for (int m = 0; m < 4; ++m) af[m] = *(const bf16x8*)(cur + swz(wr * 64 + m * 16 + fr, s * 4 + fq));
#pragma unroll
    for (int n = 0; n < 4; ++n) bfr[n] = *(const bf16x8*)(cur + 16384 + swz(wc * 64 + n * 16 + fr, s * 4 + fq));
#pragma unroll
    for (int m = 0; m < 4; ++m)
#pragma unroll
      for (int n = 0; n < 4; ++n)
        acc[m][n] = SWAP ? __builtin_amdgcn_mfma_f32_16x16x32_bf16(bfr[n], af[m], acc[m][n], 0, 0, 0)
                         : __builtin_amdgcn_mfma_f32_16x16x32_bf16(af[m], bfr[n], acc[m][n], 0, 0, 0);
  }
}
template <int AM, bool SS, bool SWAP>
__device__ __forceinline__ void gemm_mainloop(f32x4 (&acc)[4][4], const void* A0, const void* A1, int lda, const bf16_t* Bt, int ldb,
                                              int m0, int n0, int K, int aux, unsigned char* smem, float (&ss)[4], int rot,
                                              size_t tail_off = 0, float* rout = nullptr) {
  const int tid = tid_fresh(), wid = tid >> 6, lane = tid & 63, wr = wid >> 1, wc = wid & 1, fr = lane & 15, fq = lane >> 4;
  const int nk = K >> 6, km = nk - 1;
  unsigned char* L0 = smem;
  unsigned char* L1 = smem + 32768;
  uint4 a0, a1, a2, a3, b0, b1, b2, b3;
  __syncthreads();
  if (AM == 0 || AM == 2) {
    uint4 c0, c1, c2, c3, d0, d1, d2, d3;
    load_a<AM, SS>(tid, a0, a1, a2, a3, A0, A1, lda, m0, (rot & km) << 6, aux, ss);
    load_b(tid, b0, b1, b2, b3, Bt, ldb, n0, (rot & km) << 6);
    load_a<AM, SS>(tid, c0, c1, c2, c3, A0, A1, lda, m0, ((1 + rot) & km) << 6, aux, ss);
    load_b(tid, d0, d1, d2, d3, Bt, ldb, n0, ((1 + rot) & km) << 6);
    store_a<SS>(tid, L0, a0, a1, a2, a3, ss); store_tile(tid, L0 + 16384, b0, b1, b2, b3);
    __syncthreads();
#define SGB_PIPE() do { __builtin_amdgcn_sched_group_barrier(0x100, 8, 0); \
      _Pragma("unroll") for (int q_ = 0; q_ < 8; ++q_) { __builtin_amdgcn_sched_group_barrier(0x008, 1, 0); __builtin_amdgcn_sched_group_barrier(0x020, 1, 0); __builtin_amdgcn_sched_group_barrier(0x008, 1, 0); __builtin_amdgcn_sched_group_barrier(0x100, 1, 0); } \
      _Pragma("unroll") for (int q_ = 0; q_ < 8; ++q_) { __builtin_amdgcn_sched_group_barrier(0x008, 1, 0); __builtin_amdgcn_sched_group_barrier(0x200, 1, 0); __builtin_amdgcn_sched_group_barrier(0x008, 1, 0); } } while (0)
    for (int kt = 0; kt < nk; kt += 2) {
      const int k2 = ((min(kt + 2, km) + rot) & km) << 6, k3 = ((min(kt + 3, km) + rot) & km) << 6;
      if (AM == 0 && tail_off != 0) {
        const bool lastp = (kt + 2 >= nk);
        const char* tb = (const char*)((const bf16_t*)A0 + (size_t)(m0 + (tid >> 3)) * lda + k2 + (tid & 7) * 8);
        const size_t rstep = (size_t)64 * lda;
        const char* tp = (const char*)WSP(tail_off) + (size_t)(m0 + (tid & 127)) * 64;
        a0 = *(const uint4*)(lastp ? tp : tb);
        a1 = *(const uint4*)(lastp ? tp + 16 : tb + rstep);
        a2 = *(const uint4*)(lastp ? tp + 32 : tb + 2 * rstep);
        a3 = *(const uint4*)(lastp ? tp + 48 : tb + 3 * rstep);
      } else {
        load_a<AM, SS>(tid, a0, a1, a2, a3, A0, A1, lda, m0, k2, aux, ss);
      }
      load_b(tid, b0, b1, b2, b3, Bt, ldb, n0, k2);
      mma_tile<SWAP>(acc, L0, wr, wc, fr, fq);
      store_a<SS>(tid, L1, c0, c1, c2, c3, ss); store_tile(tid, L1 + 16384, d0, d1, d2, d3);
      SGB_PIPE();
      __syncthreads();
      load_a<AM, SS>(tid, c0, c1, c2, c3, A0, A1, lda, m0, k3, aux, ss); load_b(tid, d0, d1, d2, d3, Bt, ldb, n0, k3);
      mma_tile<SWAP>(acc, L1, wr, wc, fr, fq);
      if (SS) { if (kt + 2 < nk) { ss[0] += ssq8(a0); ss[1] += ssq8(a1); ss[2] += ssq8(a2); ss[3] += ssq8(a3); } }
      store_tile(tid, L0, a0, a1, a2, a3); store_tile(tid, L0 + 16384, b0, b1, b2, b3);
      SGB_PIPE();
      __syncthreads();
    }
#undef SGB_PIPE
    asm volatile("s_waitcnt vmcnt(0)" ::: "memory");
    if (AM == 0 && tail_off != 0) {
      const float sq = (__uint_as_float(a0.x) + __uint_as_float(a0.y) + __uint_as_float(a0.z) + __uint_as_float(a0.w)) + (__uint_as_float(a1.x) + __uint_as_float(a1.y) + __uint_as_float(a1.z) + __uint_as_float(a1.w))
                     + (__uint_as_float(a2.x) + __uint_as_float(a2.y) + __uint_as_float(a2.z) + __uint_as_float(a2.w)) + (__uint_as_float(a3.x) + __uint_as_float(a3.y) + __uint_as_float(a3.z) + __uint_as_float(a3.w));
      *rout = rsqrtf(sq * (1.f / 1024.f) + 1e-6f);
    }
  } else {
    load_a<AM, SS>(tid, a0, a1, a2, a3, A0, A1, lda, m0, (rot & km) << 6, aux, ss);
    load_b(tid, b0, b1, b2, b3, Bt, ldb, n0, (rot & km) << 6);
    store_a<SS>(tid, L0, a0, a1, a2, a3, ss); store_tile(tid, L0 + 16384, b0, b1, b2, b3);
    __syncthreads();
    for (int kt = 0; kt < nk; ++kt) {
      unsigned char* cur = smem + (kt & 1) * 32768;
      unsigned char* nxt = smem + ((kt + 1) & 1) * 32768;
      const bool more = (kt + 1 < nk);
      if (more) { load_a<AM, SS>(tid, a0, a1, a2, a3, A0, A1, lda, m0, ((kt + 1 + rot) & km) << 6, aux, ss); load_b(tid, b0, b1, b2, b3, Bt, ldb, n0, ((kt + 1 + rot) & km) << 6); }
      mma_tile<SWAP>(acc, cur, wr, wc, fr, fq);
      if (more) { store_a<SS>(tid, nxt, a0, a1, a2, a3, ss); store_tile(tid, nxt + 16384, b0, b1, b2, b3); }
      __syncthreads();
    }
  }
}
__device__ __forceinline__ void finish_rstd(float (&ss)[4], unsigned char* smem) {
  const int tid = tid_fresh(), r0 = tid >> 3, kc = tid & 7;
  float* rs = (float*)smem;
#pragma unroll
  for (int i = 0; i < 4; ++i) {
    float v = ss[i];
    v += __shfl_xor(v, 1); v += __shfl_xor(v, 2); v += __shfl_xor(v, 4);
    if (kc == 0) rs[r0 + 32 * i] = rsqrtf(v * (1.f / 1024.f) + 1e-6f);
  }
  __syncthreads();
}
__device__ __forceinline__ void rstd_from_partials(size_t ws_off, int m0, unsigned char* smem) {
  const int tid = tid_fresh();
  if (tid < 128) {
    const float4* q = (const float4*)((const float*)WSP(ws_off) + (size_t)(m0 + tid) * 16);
    const float4 p0 = q[0], p1 = q[1], p2 = q[2], p3 = q[3];
    const float sq = (p0.x + p0.y + p0.z + p0.w) + (p1.x + p1.y + p1.z + p1.w) + (p2.x + p2.y + p2.z + p2.w) + (p3.x + p3.y + p3.z + p3.w);
    ((float*)smem)[tid] = rsqrtf(sq * (1.f / 1024.f) + 1e-6f);
  }
  __syncthreads();
}
__device__ __forceinline__ void zero_acc(f32x4 (&acc)[4][4]) {
#pragma unroll
  for (int m = 0; m < 4; ++m)
#pragma unroll
    for (int n = 0; n < 4; ++n) acc[m][n] = (f32x4){0.f, 0.f, 0.f, 0.f};
}

__device__ __forceinline__ bool tile_pick(int i, int nNt, int& mt, int& nt, int& L) {
  const int b = blockIdx.x;
  L = i * (int)gridDim.x + (b & 7) * ((int)gridDim.x >> 3) + (b >> 3);
  if (L >= 256 * nNt) return false;
  const int band = L / (8 * nNt), r = L - band * (8 * nNt), c = r >> 6, w = r & 63;
  mt = band * 8 + (w & 7); nt = c * 8 + (w >> 3);
  return true;
}

__device__ __forceinline__ void inproj_phase(const bf16_t* hb, const bf16_t* W, int ng, int wr0, int wr1, int wr2, int wr3,
                             bf16_t* d0, bf16_t* d1, bf16_t* d2, bf16_t* d3, int md0, int md1, int md2, int md3, unsigned char* smem) {
  const int tid = tid_fresh(), wid = tid >> 6, lane = tid & 63, wr = wid >> 1, wc = wid & 1, fr = lane & 15, fq = lane >> 4;
  for (int i = 0;; ++i) {
    int mt, ntg, t;
    if (!tile_pick(i, ng * 8, mt, ntg, t)) break;
    const int grp = ntg >> 3, nt = ntg & 7;
    const int wrow = grp == 0 ? wr0 : grp == 1 ? wr1 : grp == 2 ? wr2 : wr3;
    bf16_t* dst = grp == 0 ? d0 : grp == 1 ? d1 : grp == 2 ? d2 : d3;
    const int mode = grp == 0 ? md0 : grp == 1 ? md1 : grp == 2 ? md2 : md3;
    const int m0 = mt * 128, n0 = nt * 128;
    f32x4 acc[4][4]; zero_acc(acc);
    float ss[4] = {0.f, 0.f, 0.f, 0.f};
    if (mode == 1) {
      float myr;
      gemm_mainloop<0, false, false>(acc, hb, nullptr, 1024, W + (size_t)wrow * 1024, 1024, m0, n0, 1024, 0, smem, ss, 0, PA_OFF, &myr);
      if (tid < 128) ((float*)smem)[tid] = myr;
      __syncthreads();
      const float* rs = (const float*)smem;
#pragma unroll
      for (int m = 0; m < 4; ++m) {
        const int rl = wr * 64 + m * 16 + fq * 4;
        const float r0 = rs[rl], r1 = rs[rl + 1], r2 = rs[rl + 2], r3 = rs[rl + 3];
#pragma unroll
        for (int n = 0; n < 4; ++n) {
          const int col = n0 + wc * 64 + n * 16 + fr;
          uint2 o; o.x = pack2(acc[m][n][0] * r0, acc[m][n][1] * r1); o.y = pack2(acc[m][n][2] * r2, acc[m][n][3] * r3);
          *(uint2*)(dst + (size_t)col * TOK + m0 + rl) = o;
        }
      }
    } else {
      float myr;
      gemm_mainloop<0, false, true>(acc, hb, nullptr, 1024, W + (size_t)wrow * 1024, 1024, m0, n0, 1024, 0, smem, ss, 0, PA_OFF, &myr);
      if (tid < 128) ((float*)smem)[tid] = myr;
      __syncthreads();
      const float* rs = (const float*)smem;
      uint2 old[4][4];
      if (mode == 2) {
#pragma unroll
        for (int m = 0; m < 4; ++m)
#pragma unroll
          for (int n = 0; n < 4; ++n) old[m][n] = *(const uint2*)(dst + (size_t)(m0 + wr * 64 + m * 16 + fr) * 1024 + n0 + wc * 64 + n * 16 + fq * 4);
      }
#pragma unroll
      for (int m = 0; m < 4; ++m) {
        const int rl = wr * 64 + m * 16 + fr;
        const float r = rs[rl];
        float psq = 0.f;
#pragma unroll
        for (int n = 0; n < 4; ++n) {
          const int col = n0 + wc * 64 + n * 16 + fq * 4;
          bf16_t* pd = dst + (size_t)(m0 + rl) * 1024 + col;
          float v0 = acc[m][n][0] * r, v1 = acc[m][n][1] * r, v2 = acc[m][n][2] * r, v3 = acc[m][n][3] * r;
          if (mode == 2) {
            v0 = lo_f(old[m][n].x) * silu_f(v0); v1 = hi_f(old[m][n].x) * silu_f(v1); v2 = lo_f(old[m][n].y) * silu_f(v2); v3 = hi_f(old[m][n].y) * silu_f(v3);
          }
          uint2 o; o.x = pack2(v0, v1); o.y = pack2(v2, v3);
          *(uint2*)pd = o;
          if (mode == 3) psq += v0 * v0 + v1 * v1 + v2 * v2 + v3 * v3;
        }
        if (mode == 3) {
          psq += __shfl_xor(psq, 16); psq += __shfl_xor(psq, 32);
          if (fq == 0) ((float*)WSP(PART_OFF))[(size_t)(m0 + rl) * 16 + nt * 2 + wc] = psq;
        }
      }
    }
  }
}

__device__ __forceinline__ void outproj_phase(const bf16_t* MA, const bf16_t* MB, const bf16_t* Wt  , const float* hsrc, float* hres, bf16_t* hbB, unsigned char* smem) {
  const int tid = tid_fresh(), wid = tid >> 6, lane = tid & 63, wr = wid >> 1, wc = wid & 1, fr = lane & 15, fq = lane >> 4;
  for (int i = 0;; ++i) {
    int mt, nt, t;
    if (!tile_pick(i, 8, mt, nt, t)) break;
    const int m0 = mt * 128, n0 = nt * 128;
    f32x4 acc[4][4]; zero_acc(acc);
    float ss[4] = {0.f, 0.f, 0.f, 0.f};
    gemm_mainloop<2, false, true>(acc, MA, MB, 1024, Wt, 2048, m0, n0, 2048, 0, smem, ss, 0);
#pragma unroll
    for (int m = 0; m < 4; ++m) {
      const int row = m0 + wr * 64 + m * 16 + fr;
      const size_t idx = (size_t)row * 1024 + n0 + wc * 64 + fq * 4;
      float4 h[4];
#pragma unroll
      for (int n = 0; n < 4; ++n) h[n] = *(const float4*)(hsrc + idx + n * 16);
      float psq = 0.f;
#pragma unroll
      for (int n = 0; n < 4; ++n) {
        const float4 o = make_float4(h[n].x + acc[m][n][0], h[n].y + acc[m][n][1], h[n].z + acc[m][n][2], h[n].w + acc[m][n][3]);
        *(float4*)(hres + idx + n * 16) = o;
        uint2 ob; ob.x = pack2(o.x, o.y); ob.y = pack2(o.z, o.w);
        *(uint2*)(hbB + idx + n * 16) = ob;
        psq += o.x * o.x + o.y * o.y + o.z * o.z + o.w * o.w;
      }
      psq += __shfl_xor(psq, 16); psq += __shfl_xor(psq, 32);
      if (fq == 0) ((float*)WSP(PB_OFF))[(size_t)row * 16 + nt * 2 + wc] = psq;
    }
  }
}

__device__ __forceinline__ void ple_phase(const bf16_t* hbB, const float* pin  , const bf16_t* Wg  , const bf16_t* Wup  ,
                          float* hres, bf16_t* hbA, unsigned char* smem) {
  const int tid = tid_fresh(), wid = tid >> 6, lane = tid & 63, wr = wid >> 1, wc = wid & 1, fr = lane & 15, fq = lane >> 4;
  for (int i = 0;; ++i) {
    int mt, nt, t;
    if (!tile_pick(i, 8, mt, nt, t)) break;
    const int m0 = mt * 128, n0 = nt * 128;
    f32x4 ag[4][4]; zero_acc(ag);
    float ss[4] = {0.f, 0.f, 0.f, 0.f};
    float myr;
    gemm_mainloop<0, false, true>(ag, hbB, nullptr, 1024, Wg, 1024, m0, n0, 1024, 0, smem, ss, 0, PB_OFF, &myr);
    if (tid < 128) ((float*)smem)[tid] = myr;
    __syncthreads();
    unsigned gp[4][4][2];
    {
      const float* rs = (const float*)smem;
#pragma unroll
      for (int m = 0; m < 4; ++m) {
        const float r = rs[wr * 64 + m * 16 + fr];
#pragma unroll
        for (int n = 0; n < 4; ++n) {
          gp[m][n][0] = pack2(sigmoid_f(r * ag[m][n][0]), sigmoid_f(r * ag[m][n][1]));
          gp[m][n][1] = pack2(sigmoid_f(r * ag[m][n][2]), sigmoid_f(r * ag[m][n][3]));
        }
      }
    }
    zero_acc(ag);
    float ss2[4] = {0.f, 0.f, 0.f, 0.f};
    gemm_mainloop<1, false, true>(ag, pin, nullptr, 256, Wup, 256, m0, n0, 256, 0, smem, ss2, 0);
#pragma unroll
    for (int m = 0; m < 4; ++m) {
      const int rl = wr * 64 + m * 16 + fr;
      const size_t idx = (size_t)(m0 + rl) * 1024 + n0 + wc * 64 + fq * 4;
      float4 h[4];
#pragma unroll
      for (int n = 0; n < 4; ++n) h[n] = *(const float4*)(hres + idx + n * 16);
      float psq = 0.f;
#pragma unroll
      for (int n = 0; n < 4; ++n) {
        float4 o;
        o.x = h[n].x + ag[m][n][0] * lo_f(gp[m][n][0]);
        o.y = h[n].y + ag[m][n][1] * hi_f(gp[m][n][0]);
        o.z = h[n].z + ag[m][n][2] * lo_f(gp[m][n][1]);
        o.w = h[n].w + ag[m][n][3] * hi_f(gp[m][n][1]);
        *(float4*)(hres + idx + n * 16) = o;
        uint2 ob; ob.x = pack2(o.x, o.y); ob.y = pack2(o.z, o.w);
        *(uint2*)(hbA + idx + n * 16) = ob;
        psq += o.x * o.x + o.y * o.y + o.z * o.z + o.w * o.w;
      }
      psq += __shfl_xor(psq, 16); psq += __shfl_xor(psq, 32);
      if (fq == 0) ((float*)WSP(PA_OFF))[(size_t)(m0 + rl) * 16 + nt * 2 + wc] = psq;
    }
  }
}

__device__ __forceinline__ void pool_phase(const bf16_t* XC, const bf16_t* Wp  , const float* pb, const float* ps, bf16_t* MC, unsigned char* smem) {
  const int tid = tid_fresh(), wid = tid >> 6, lane = tid & 63, wr = wid >> 1, wc = wid & 1, fr = lane & 15, fq = lane >> 4;
  unsigned char* sA = smem;
  unsigned char* sB = smem + 16384;
  unsigned char* sXs = smem + 32768;
  for (int t = blockIdx.x; t < 2048; t += gridDim.x) {
    const int mt = t >> 3, g = (t >> 1) & 3, nt = t & 1, m0 = mt * 128, n0 = nt * 128;
    const int half = 1 << g;
    const int tb0 = m0 & (SEQ - 1);
    const bf16_t* Bt = Wp + (size_t)g * 65536;
    f32x4 acc[4][4]; zero_acc(acc);
    uint4 xr[5], b0, b1, b2, b3;
#pragma unroll
    for (int i = 0; i < 5; ++i) {
      const int id = tid + 256 * i, row = id >> 3, kc = id & 7, tb = tb0 - 8 + row;
      xr[i] = (id < 1152 && tb >= 0 && tb < SEQ) ? *(const uint4*)(XC + (size_t)(m0 - 8 + row) * 1024 + g * 256 + kc * 8) : make_uint4(0u, 0u, 0u, 0u);
    }
    load_b(tid, b0, b1, b2, b3, Bt, 256, n0, 0);
    __syncthreads();
#pragma unroll 1
    for (int ks = 0; ks < 4; ++ks) {
#pragma unroll
      for (int i = 0; i < 5; ++i) { const int id = tid + 256 * i; if (id < 1152) *(uint4*)(sXs + id * 16) = xr[i]; }
      store_tile(tid, sB, b0, b1, b2, b3);
      __syncthreads();
      if (ks < 3) {
        const int k1 = (ks + 1) * 64;
#pragma unroll
        for (int i = 0; i < 5; ++i) {
          const int id = tid + 256 * i, row = id >> 3, kc = id & 7, tb = tb0 - 8 + row;
          xr[i] = (id < 1152 && tb >= 0 && tb < SEQ) ? *(const uint4*)(XC + (size_t)(m0 - 8 + row) * 1024 + g * 256 + k1 + kc * 8) : make_uint4(0u, 0u, 0u, 0u);
        }
        load_b(tid, b0, b1, b2, b3, Bt, 256, n0, k1);
      }
#pragma unroll
      for (int i = 0; i < 4; ++i) {
        const int row = (tid >> 3) + 32 * i, kc = tid & 7, tb = tb0 + row;
        const int lo = max(tb - half, 0), hi = min(tb + half, SEQ);
        float s0 = 0.f, s1 = 0.f, s2 = 0.f, s3 = 0.f, s4 = 0.f, s5 = 0.f, s6 = 0.f, s7 = 0.f;
        for (int tt = lo; tt < hi; ++tt) {
          const uint4 u = *(const uint4*)(sXs + (tt - tb0 + 8) * 128 + kc * 16);
          s0 += lo_f(u.x); s1 += hi_f(u.x); s2 += lo_f(u.y); s3 += hi_f(u.y); s4 += lo_f(u.z); s5 += hi_f(u.z); s6 += lo_f(u.w); s7 += hi_f(u.w);
        }
        const uint4 u = *(const uint4*)(sXs + (row + 8) * 128 + kc * 16);
        const float inv = 1.f / (float)(hi - lo);
        *(uint4*)(sA + swz(row, kc)) = make_uint4(pack2(s0 * inv - lo_f(u.x), s1 * inv - hi_f(u.x)), pack2(s2 * inv - lo_f(u.y), s3 * inv - hi_f(u.y)),
                                                  pack2(s4 * inv - lo_f(u.z), s5 * inv - hi_f(u.z)), pack2(s6 * inv - lo_f(u.w), s7 * inv - hi_f(u.w)));
      }
      __syncthreads();
      mma_tile<true>(acc, smem, wr, wc, fr, fq);
      __syncthreads();
    }
#pragma unroll
    for (int m = 0; m < 4; ++m) {
      const int row = m0 + wr * 64 + m * 16 + fr;
#pragma unroll
      for (int n = 0; n < 4; ++n) {
        const int col = g * 256 + n0 + wc * 64 + n * 16 + fq * 4;
        const float4 b = *(const float4*)(pb + col), sc = *(const float4*)(ps + col);
        uint2 o; o.x = pack2((acc[m][n][0] + b.x) * sc.x, (acc[m][n][1] + b.y) * sc.y); o.y = pack2((acc[m][n][2] + b.z) * sc.z, (acc[m][n][3] + b.w) * sc.w);
        *(uint2*)(MC + (size_t)row * 1024 + col) = o;
      }
    }
  }
}

__device__ __forceinline__ void gmlp_phase(bf16_t* UB, const bf16_t* VB, const bf16_t* Ws  , const float* gmg, const float* gbs  , unsigned char* smem) {
  const int tid = tid_fresh(), wid = tid >> 6, lane = tid & 63, wr = wid >> 1, wc = wid & 1, fr = lane & 15, fq = lane >> 4;
  unsigned char* sW = smem;
  unsigned char* sX = smem + 32768;
  for (int it = blockIdx.x; it < 2048; it += gridDim.x) {
    const int g = it & 7, tok0 = (it >> 3) * 128;
    __syncthreads();
#pragma unroll 2
    for (int i = 0; i < 8; ++i) {
      const int id = tid + 256 * i, row = id >> 4, kc = id & 15;
      *(uint4*)(sW + row * 256 + ((kc ^ (row & 15)) << 4)) = *(const uint4*)(Ws + (size_t)g * 16384 + row * 128 + kc * 8);
    }
    float rq;
    {
      const float4* pp = (const float4*)((const float*)WSP(PART_OFF) + (size_t)(tok0 + (tid & 127)) * 16);
      const float4 p0 = pp[0], p1 = pp[1], p2 = pp[2], p3 = pp[3];
      const float sq = (p0.x + p0.y + p0.z + p0.w) + (p1.x + p1.y + p1.z + p1.w) + (p2.x + p2.y + p2.z + p2.w) + (p3.x + p3.y + p3.z + p3.w);
      rq = rsqrtf(sq * (1.f / 1024.f) + 1e-6f);
    }
    __syncthreads();
#pragma unroll 2
    for (int i = 0; i < 8; ++i) {
      const int id = tid + 256 * i, q = id & 127, cc = id >> 7;
      float f[8]; unpack8(*(const uint4*)(VB + (size_t)(tok0 + q) * 1024 + g * 128 + cc * 8), f);
#pragma unroll
      for (int e = 0; e < 8; ++e) {
        const int c = cc * 8 + e;
        const float v = f[e] * rq * gmg[g * 128 + c];
        *(bf16_t*)(sX + c * 256 + (((q >> 3) ^ (c & 15)) << 4) + (q & 7) * 2) = f2bf(v);
      }
    }
    __syncthreads();
    f32x4 acc[4][4]; zero_acc(acc);
#pragma unroll
    for (int s = 0; s < 4; ++s) {
      bf16x8 af[4], bfr[4];
#pragma unroll
      for (int m = 0; m < 4; ++m) { const int row = wr * 64 + m * 16 + fr; af[m] = *(const bf16x8*)(sW + row * 256 + (((s * 4 + fq) ^ (row & 15)) << 4)); }
#pragma unroll
      for (int n = 0; n < 4; ++n) { const int row = wc * 64 + n * 16 + fr; bfr[n] = *(const bf16x8*)(sX + row * 256 + (((s * 4 + fq) ^ (row & 15)) << 4)); }
#pragma unroll
      for (int m = 0; m < 4; ++m)
#pragma unroll
        for (int n = 0; n < 4; ++n) acc[m][n] = __builtin_amdgcn_mfma_f32_16x16x32_bf16(bfr[n], af[m], acc[m][n], 0, 0, 0);
    }
    uint2 uo[4][4];
#pragma unroll
    for (int m = 0; m < 4; ++m)
#pragma unroll
      for (int n = 0; n < 4; ++n) uo[m][n] = *(const uint2*)(UB + (size_t)(tok0 + wr * 64 + m * 16 + fr) * 1024 + g * 128 + wc * 64 + n * 16 + fq * 4);
#pragma unroll
    for (int m = 0; m < 4; ++m) {
      const int p = wr * 64 + m * 16 + fr;
      const float bias = gbs[g * 128 + p];
#pragma unroll
      for (int n = 0; n < 4; ++n) {
        const int c = wc * 64 + n * 16 + fq * 4;
        bf16_t* pd = UB + (size_t)(tok0 + p) * 1024 + g * 128 + c;
        const uint2 u = uo[m][n];
        uint2 o; o.x = pack2(lo_f(u.x) * (acc[m][n][0] + bias), hi_f(u.x) * (acc[m][n][1] + bias));
        o.y = pack2(lo_f(u.y) * (acc[m][n][2] + bias), hi_f(u.y) * (acc[m][n][3] + bias));
        *(uint2*)pd = o;
      }
    }
  }
}

__device__ __forceinline__ void na_phase(bf16_t* Q, const bf16_t* Kb, const bf16_t* Vt, const float* rpb, unsigned char* smem) {
  const int tid = tid_fresh(), wq = tid >> 6, lane = tid & 63, fr = lane & 15, fq = lane >> 4;
  for (int it = blockIdx.x; it < 8 * 64 * 16; it += gridDim.x) {
    const int h = it & 15, r = (it >> 4) & 63, b = it >> 10;
    const int rs = min(max(r - 4, 0), 56);
    const int w0 = (wq == 0) ? 0 : (wq == 1) ? 8 : (wq == 2) ? 24 : 32;
    const int qc = wq * 16 + fr;
    const int tokq = b * 4096 + r * 64 + qc;
    const bf16x8 qf0 = *(const bf16x8*)(Q + (size_t)tokq * 1024 + h * 64 + fq * 8);
    const bf16x8 qf1 = *(const bf16x8*)(Q + (size_t)tokq * 1024 + h * 64 + 32 + fq * 8);
    const int cs = min(max(qc - 8, 0), 48);
    const float* rp = rpb + h * (15 * 31);
    const size_t tok0 = (size_t)b * 4096 + rs * 64;
    __syncthreads();
#pragma unroll 1
    for (int i0 = 0; i0 < 16; i0 += 16) {
      uint4 kv[16];
#pragma unroll
      for (int i = 0; i < 16; ++i) {
        const int id = tid + 256 * (i0 + i), key = id >> 3, kc = id & 7;
        kv[i] = *(const uint4*)(Kb + (tok0 + key) * 1024 + h * 64 + kc * 8);
      }
#pragma unroll
      for (int i = 0; i < 16; ++i) {
        const int id = tid + 256 * (i0 + i), key = id >> 3, kc = id & 7;
        *(uint4*)(smem + key * 128 + ((kc ^ ((key >> 1) & 7)) << 4)) = kv[i];
      }
    }
    __syncthreads();
    uint4 vvA[4];
#pragma unroll
    for (int i = 0; i < 4; ++i) {
      const int id = tid + 256 * i, d = id >> 6, c16 = id & 63;
      vvA[i] = *(const uint4*)(Vt + (size_t)(h * 64 + d) * TOK + tok0 + c16 * 8);
    }
    f32x4 sc[8][2];
    float mx = -1e30f;
#pragma unroll
    for (int jr = 0; jr < 8; ++jr) {
#pragma unroll
      for (int hc = 0; hc < 2; ++hc) {
        const int key = jr * 64 + w0 + 8 * (fr >> 2) + 4 * hc + (fr & 3);
        const unsigned char* kp = smem + key * 128;
        const int kx = (key >> 1) & 7;
        const bf16x8 kf0 = *(const bf16x8*)(kp + ((fq ^ kx) << 4));
        const bf16x8 kf1 = *(const bf16x8*)(kp + (((4 + fq) ^ kx) << 4));
        f32x4 a = (f32x4){0.f, 0.f, 0.f, 0.f};
        a = __builtin_amdgcn_mfma_f32_16x16x32_bf16(kf0, qf0, a, 0, 0, 0);
        a = __builtin_amdgcn_mfma_f32_16x16x32_bf16(kf1, qf1, a, 0, 0, 0);
        const int dr = rs + jr - r + 7;
#pragma unroll
        for (int e = 0; e < 4; ++e) {
          const int kcol = w0 + 8 * fq + 4 * hc + e;
          const bool valid = (kcol >= cs) && (kcol < cs + 16);
          const int dc = min(max(kcol - qc + 15, 0), 30);
          const float v = valid ? (a[e] * 0.125f + rp[dr * 31 + dc]) : -1e30f;
          a[e] = v; mx = fmaxf(mx, v);
        }
        sc[jr][hc] = a;
      }
    }
    mx = fmaxf(mx, __shfl_xor(mx, 16)); mx = fmaxf(mx, __shfl_xor(mx, 32));
    float sum = 0.f;
#pragma unroll
    for (int jr = 0; jr < 8; ++jr)
#pragma unroll
      for (int hc = 0; hc < 2; ++hc)
#pragma unroll
        for (int e = 0; e < 4; ++e) { const float pv = (sc[jr][hc][e] > -1e29f) ? __expf(sc[jr][hc][e] - mx) : 0.f; sc[jr][hc][e] = pv; sum += pv; }
    sum += __shfl_xor(sum, 16); sum += __shfl_xor(sum, 32);
    const float inv = 1.f / sum;
    __syncthreads();
    {
#pragma unroll
      for (int i = 0; i < 4; ++i) {
        const int id = tid + 256 * i, d = id >> 6, c16 = id & 63;
        *(uint4*)(smem + d * 1024 + ((c16 ^ (d & 15)) << 4)) = vvA[i];
      }
#pragma unroll 1
      for (int i0 = 4; i0 < 16; i0 += 6) {
        uint4 vvB[6];
#pragma unroll
        for (int i = 0; i < 6; ++i) {
          const int id = tid + 256 * (i0 + i), d = id >> 6, c16 = id & 63;
          vvB[i] = *(const uint4*)(Vt + (size_t)(h * 64 + d) * TOK + tok0 + c16 * 8);
        }
#pragma unroll
        for (int i = 0; i < 6; ++i) {
          const int id = tid + 256 * (i0 + i), d = id >> 6, c16 = id & 63;
          *(uint4*)(smem + d * 1024 + ((c16 ^ (d & 15)) << 4)) = vvB[i];
        }
      }
    }
    __syncthreads();
    f32x4 o[4];
#pragma unroll
    for (int dt = 0; dt < 4; ++dt) o[dt] = (f32x4){0.f, 0.f, 0.f, 0.f};
#pragma unroll
    for (int jr = 0; jr < 8; ++jr) {
      union { bf16x8 v; unsigned u[4]; } pf;
      pf.u[0] = pack2(sc[jr][0][0] * inv, sc[jr][0][1] * inv); pf.u[1] = pack2(sc[jr][0][2] * inv, sc[jr][0][3] * inv);
      pf.u[2] = pack2(sc[jr][1][0] * inv, sc[jr][1][1] * inv); pf.u[3] = pack2(sc[jr][1][2] * inv, sc[jr][1][3] * inv);
      const int c16 = jr * 8 + (w0 >> 3) + fq;
#pragma unroll
      for (int dt = 0; dt < 4; ++dt) {
        const int d = dt * 16 + fr;
        const bf16x8 vf = *(const bf16x8*)(smem + d * 1024 + ((c16 ^ (d & 15)) << 4));
        o[dt] = __builtin_amdgcn_mfma_f32_16x16x32_bf16(vf, pf.v, o[dt], 0, 0, 0);
      }
    }
#pragma unroll
    for (int dt = 0; dt < 4; ++dt) {
      uint2 ob; ob.x = pack2(o[dt][0], o[dt][1]); ob.y = pack2(o[dt][2], o[dt][3]);
      *(uint2*)(Q + (size_t)tokq * 1024 + h * 64 + dt * 16 + fq * 4) = ob;
    }
  }
}

__device__ __forceinline__ float2 cmul(float2 a, float2 b) { return make_float2(a.x * b.x - a.y * b.y, a.x * b.y + a.y * b.x); }
__device__ __forceinline__ float2 cadd(float2 a, float2 b) { return make_float2(a.x + b.x, a.y + b.y); }
__device__ __forceinline__ float2 csub(float2 a, float2 b) { return make_float2(a.x - b.x, a.y - b.y); }

template <bool DIF>
__device__ __forceinline__ void bfly(float2& a, float2& b, float2 w) {
  if (DIF) { const float2 s = cadd(a, b), d = csub(a, b); a = s; b = cmul(d, w); }
  else { const float2 t = cmul(b, w); const float2 s = cadd(a, t), d = csub(a, t); a = s; b = d; }
}
#define PH(i) ((i) ^ (((i) >> 4) & 7))
template <bool DIF, int HALF = 0>
__device__ __forceinline__ void fft_r8(float2* buf, const float2* __restrict__ T, int lq) {
  const int q = 1 << lq, sA = 1024 >> lq;
  for (int g = tid_fresh(); g < 1024; g += NT) {
    const int j0 = g & (q - 1), i0 = ((g >> lq) << (lq + 3)) + j0;
    float2 x[8];
#pragma unroll
    for (int p = 0; p < 8; ++p) x[p] = (HALF == 1 && p >= 4) ? make_float2(0.f, 0.f) : buf[PH(i0 + p * q)];
    const float2 w1 = T[j0 * sA];
    const float2 w2 = cmul(w1, w1), w4 = cmul(w2, w2);
    const float cs8 = 0.70710678118654752f;
    const float2 tA1 = make_float2(cs8 * (w1.x + w1.y), cs8 * (w1.y - w1.x));
    const float2 tA2 = make_float2(w1.y, -w1.x);
    const float2 tA3 = make_float2(cs8 * (w1.y - w1.x), -cs8 * (w1.x + w1.y));
    const float2 tB1 = make_float2(w2.y, -w2.x);
    if (DIF) {
      bfly<true>(x[0], x[4], w1); bfly<true>(x[1], x[5], tA1); bfly<true>(x[2], x[6], tA2); bfly<true>(x[3], x[7], tA3);
      bfly<true>(x[0], x[2], w2); bfly<true>(x[4], x[6], w2); bfly<true>(x[1], x[3], tB1); bfly<true>(x[5], x[7], tB1);
      bfly<true>(x[0], x[1], w4); bfly<true>(x[2], x[3], w4); bfly<true>(x[4], x[5], w4); bfly<true>(x[6], x[7], w4);
    } else {
      bfly<false>(x[0], x[1], w4); bfly<false>(x[2], x[3], w4); bfly<false>(x[4], x[5], w4); bfly<false>(x[6], x[7], w4);
      bfly<false>(x[0], x[2], w2); bfly<false>(x[4], x[6], w2); bfly<false>(x[1], x[3], tB1); bfly<false>(x[5], x[7], tB1);
      bfly<false>(x[0], x[4], w1); bfly<false>(x[1], x[5], tA1); bfly<false>(x[2], x[6], tA2); bfly<false>(x[3], x[7], tA3);
    }
#pragma unroll
    for (int p = 0; p < 8; ++p) if (!(HALF == 2 && p >= 4)) buf[PH(i0 + p * q)] = x[p];
  }
  __syncthreads();
}
__device__ __forceinline__ void fft_r2(float2* buf) {
  for (int g = tid_fresh(); g < 4096; g += NT) {
    const int i0 = PH(2 * g), i1 = PH(2 * g + 1);
    const float2 a = buf[i0], b = buf[i1];
    buf[i0] = make_float2(a.x + b.x, a.y + b.y); buf[i1] = make_float2(a.x - b.x, a.y - b.y);
  }
  __syncthreads();
}
__device__ __forceinline__ void fft_dif(float2* buf, const float2* T) { fft_r8<true>(buf, T, 10); fft_r8<true>(buf, T, 7); fft_r8<true>(buf, T, 4); fft_r8<true>(buf, T, 1); fft_r2(buf); }
__device__ __forceinline__ void fft_dit(float2* buf, const float2* T) { fft_r2(buf); fft_r8<false>(buf, T, 1); fft_r8<false>(buf, T, 4); fft_r8<false>(buf, T, 7); fft_r8<false>(buf, T, 10); }
__device__ __forceinline__ void fft_dif_zp(float2* buf, const float2* T) { fft_r8<true, 1>(buf, T, 10); fft_r8<true>(buf, T, 7); fft_r8<true>(buf, T, 4); fft_r8<true>(buf, T, 1); fft_r2(buf); }
__device__ __forceinline__ void fft_dit_lo(float2* buf, const float2* T) { fft_r2(buf); fft_r8<false>(buf, T, 1); fft_r8<false>(buf, T, 4); fft_r8<false>(buf, T, 7); fft_r8<false, 2>(buf, T, 10); }
__device__ __forceinline__ int brev13(int k) { return (int)(__brev((unsigned)k) >> 19); }

__device__ __forceinline__ void hyena_feats(float* h3, unsigned char* smem) {
  KP PP = params_fresh();
  float* hin = (float*)smem;
  const int tid = tid_fresh(), r = tid >> 6, u = tid & 63;
  for (int it = blockIdx.x; it < 2048; it += gridDim.x) {
    const int j = it >> 10, l = (it & 1023) * 4 + r;
    const float* w0 = PP->in[I_HW0] + j * 33 * 64; const float* b0 = PP->in[I_HB0] + j * 64;
    const float* w1 = PP->in[I_HW1] + j * 4096; const float* b1 = PP->in[I_HB1] + j * 64;
    const float* w2 = PP->in[I_HW2] + j * 4096; const float* b2 = PP->in[I_HB2] + j * 64;
    const float fr = PP->in[I_HFREQ][j * 64 + u];
    __syncthreads();
    {
      const float tt = (float)l / 4095.f;
      const float ang = 6.283185307179586f * (float)l / 4096.f;
      float f = 0.f;
      if (u == 0) f = tt;
      else if (u <= 16) { const float band = 1e-4f + (float)(u - 1) * ((15.f - 1e-4f) / 15.f); f = cosf(band * ang); }
      else if (u <= 32) { const float band = 1e-4f + (float)(u - 17) * ((15.f - 1e-4f) / 15.f); f = -sinf(band * ang); }
      hin[r * 64 + u] = f;
    }
    __syncthreads();
    float a = b0[u];
    for (int k = 0; k < 33; ++k) a += hin[r * 64 + k] * w0[k * 64 + u];
    float v = sinf(fr * a);
    __syncthreads(); hin[r * 64 + u] = v; __syncthreads();
    a = b1[u];
    for (int k = 0; k < 64; ++k) a += hin[r * 64 + k] * w1[k * 64 + u];
    v = sinf(fr * a);
    __syncthreads(); hin[r * 64 + u] = v; __syncthreads();
    a = b2[u];
    for (int k = 0; k < 64; ++k) a += hin[r * 64 + k] * w2[k * 64 + u];
    v = sinf(fr * a);
    h3[((size_t)j * 4096 + l) * 64 + u] = v;
  }
}

__device__ __forceinline__ void filtgen_phase(const float* hwout, int j, const float* h3, float* kT, unsigned char* smem) {
  float* hs = (float*)smem;
  float* wsm = (float*)(smem + 32768);
  const int tid = tid_fresh(), tl = tid & 15, tc = tid >> 4;
  const float* wout = hwout + (size_t)j * 64 * 2048;
  const float mind = logf(0.01f) / 1.5f, maxd = logf(0.01f) / 0.3f;
  for (int it = blockIdx.x; it < 2048; it += gridDim.x) {
    const int l0 = (it & 63) * 64, c0 = (it >> 6) * 64;
    __syncthreads();
#pragma unroll
    for (int i = 0; i < 4; ++i) {
      const int id = tid + 256 * i, r = id >> 4, c4 = id & 15;
      const float4 hv = *(const float4*)(h3 + ((size_t)j * 4096 + l0 + r) * 64 + c4 * 4);
      float* d = hs + r * 65 + c4 * 4; d[0] = hv.x; d[1] = hv.y; d[2] = hv.z; d[3] = hv.w;
      *(float4*)(wsm + r * 64 + c4 * 4) = *(const float4*)(wout + (size_t)r * 2048 + c0 + c4 * 4);
    }
    __syncthreads();
    float acc[4][4];
#pragma unroll
    for (int i = 0; i < 4; ++i)
#pragma unroll
      for (int k = 0; k < 4; ++k) acc[i][k] = 0.f;
#pragma unroll 4
    for (int u = 0; u < 64; ++u) {
      const float4 w = *(const float4*)(wsm + u * 64 + tc * 4);
#pragma unroll
      for (int i = 0; i < 4; ++i) {
        const float hv = hs[(tl * 4 + i) * 65 + u];
        acc[i][0] += hv * w.x; acc[i][1] += hv * w.y; acc[i][2] += hv * w.z; acc[i][3] += hv * w.w;
      }
    }
#pragma unroll
    for (int k = 0; k < 4; ++k) {
      const int col = c0 + tc * 4 + k, c = col & 1023;
      const float dl = fabsf(mind + (float)c * ((maxd - mind) / 1023.f));
      float4 o;
      o.x = acc[0][k] * expf(-((float)(l0 + tl * 4 + 0) / 4095.f) * dl);
      o.y = acc[1][k] * expf(-((float)(l0 + tl * 4 + 1) / 4095.f) * dl);
      o.z = acc[2][k] * expf(-((float)(l0 + tl * 4 + 2) / 4095.f) * dl);
      o.w = acc[3][k] * expf(-((float)(l0 + tl * 4 + 3) / 4095.f) * dl);
      *(float4*)(kT + (size_t)col * 4096 + l0 + tl * 4) = o;
    }
  }
}

__device__ __forceinline__ void spectrum_phase(const float* kT, const float2* T, float4* spec, unsigned char* smem) {
  float2* buf = (float2*)smem;
  float* red = (float*)smem;
  const int tid = tid_fresh(), lane = tid & 63, wid = tid >> 6;
  for (int pi = blockIdx.x; pi < 512; pi += gridDim.x) {
    const int c1 = 2 * pi;
    const float* f0 = kT + (size_t)c1 * 4096;
    const float* b0 = kT + (size_t)(1024 + c1) * 4096;
    __syncthreads();
    float s1 = 0.f, s2 = 0.f;
#pragma unroll 4
    for (int i = 0; i < 16; ++i) {
      const int l = tid + 256 * i;
      const float a00 = f0[l], a01 = f0[4096 + l], a10 = b0[l], a11 = b0[4096 + l];
      s1 += a00 * a00; s2 += a01 * a01;
      if (l != 0) { s1 += a10 * a10; s2 += a11 * a11; }
    }
#pragma unroll
    for (int o = 32; o > 0; o >>= 1) { s1 += __shfl_xor(s1, o); s2 += __shfl_xor(s2, o); }
    if (lane == 0) { red[wid * 2] = s1; red[wid * 2 + 1] = s2; }
    __syncthreads();
    s1 = red[0] + red[2] + red[4] + red[6]; s2 = red[1] + red[3] + red[5] + red[7];
    __syncthreads();
#pragma unroll 4
    for (int i = 0; i < 16; ++i) {
      const int l = tid + 256 * i;
      const float a00 = f0[l], a01 = f0[4096 + l], a10 = b0[l], a11 = b0[4096 + l];
      buf[PH(l)] = make_float2(a00, a01);
      if (l == 0) buf[PH(4096)] = make_float2(0.f, 0.f);
      else buf[PH(8192 - l)] = make_float2(a10, a11);
    }
    __syncthreads();
    const float sc1 = rsqrtf(s1 + 1e-6f) * (1.f / 8192.f);
    const float sc2 = rsqrtf(s2 + 1e-6f) * (1.f / 8192.f);
    fft_dif(buf, T);
    for (int k = tid; k <= 4096; k += NT) {
      const int pk_ = brev13(k), pn_ = brev13((8192 - k) & 8191);
      const float2 Pk = buf[PH(pk_)], Fn = buf[PH(pn_)];
      const float2 Qc = make_float2(Fn.x, -Fn.y);
      const float2 H1 = make_float2(0.5f * (Pk.x + Qc.x) * sc1, 0.5f * (Pk.y + Qc.y) * sc1);
      const float2 H2 = make_float2(0.5f * (Pk.y - Qc.y) * sc2, -0.5f * (Pk.x - Qc.x) * sc2);
      spec[(size_t)pi * SPEC_STRIDE + k] = make_float4(0.5f * (H1.x + H2.x), 0.5f * (H1.y + H2.y), 0.5f * (H1.x - H2.x), 0.5f * (H1.y - H2.y));
    }
  }
}

__device__ __forceinline__ void z_phase(const bf16_t* X1, const bf16_t* V, const float* cw  , const float* cb  , bf16_t* zT, unsigned char* smem) {
  float* zs = (float*)smem;
  const int tid = tid_fresh(), c8 = tid & 7, tr = tid >> 3;
  for (int it = blockIdx.x; it < 8192; it += gridDim.x) {
    const int ct = it & 15, tt = it >> 4, c0 = ct * 64, t0 = tt * 64;
    __syncthreads();
    const int c = c0 + c8 * 8;
    float w1[3][8], w2[3][8], bb1[8], bb2[8];
#pragma unroll
    for (int e = 0; e < 8; ++e) {
#pragma unroll
      for (int k = 0; k < 3; ++k) { w1[k][e] = cw[k * 3072 + 1024 + c + e]; w2[k][e] = cw[k * 3072 + 2048 + c + e]; }
      bb1[e] = cb[1024 + c + e]; bb2[e] = cb[2048 + c + e];
    }
#pragma unroll
    for (int i = 0; i < 2; ++i) {
      const int tl = tr + 32 * i, t = t0 + tl, tb = t & (SEQ - 1);
      float a1[8], a2[8];
#pragma unroll
      for (int e = 0; e < 8; ++e) { a1[e] = bb1[e]; a2[e] = bb2[e]; }
#pragma unroll
      for (int k = 0; k < 3; ++k) {
        const int tbk = tb + k - 1;
        if (tbk >= 0 && tbk < SEQ) {
          float f[8], g[8];
          unpack8(*(const uint4*)(X1 + (size_t)(t + k - 1) * 1024 + c), f);
          unpack8(*(const uint4*)(V + (size_t)(t + k - 1) * 1024 + c), g);
#pragma unroll
          for (int e = 0; e < 8; ++e) { a1[e] += w1[k][e] * f[e]; a2[e] += w2[k][e] * g[e]; }
        }
      }
#pragma unroll
      for (int e = 0; e < 8; ++e) zs[(c8 * 8 + e) * 65 + tl] = a1[e] * a2[e];
    }
    __syncthreads();
    {
      const int cl = tid >> 2, tq = tid & 3;
      const int bidx = t0 >> 12, tbase = t0 & (SEQ - 1);
      bf16_t* dst = zT + ((size_t)(bidx * 1024 + c0 + cl)) * SEQ + tbase + tq * 16;
      const float* sr = zs + cl * 65 + tq * 16;
      *(uint4*)dst = make_uint4(pack2(sr[0], sr[1]), pack2(sr[2], sr[3]), pack2(sr[4], sr[5]), pack2(sr[6], sr[7]));
      *(uint4*)(dst + 8) = make_uint4(pack2(sr[8], sr[9]), pack2(sr[10], sr[11]), pack2(sr[12], sr[13]), pack2(sr[14], sr[15]));
    }
  }
}

__device__ __forceinline__ void fftconv_phase(bf16_t* zT, const float4* spec, const float2* T, const float* hd, unsigned char* smem) {
  float2* buf = (float2*)smem;
  const int tid = tid_fresh();
  for (int it = blockIdx.x; it < 4096; it += gridDim.x) {
    const int b = (it >> 3) & 7, pi = (it & 7) + 8 * (it >> 6), c1 = 2 * pi;
    bf16_t* z1 = zT + ((size_t)(b * 1024 + c1)) * SEQ;
    bf16_t* z2 = z1 + SEQ;
    __syncthreads();
    for (int t = tid; t < 4096; t += NT) buf[PH(t)] = make_float2(bf2f(z1[t]), bf2f(z2[t]));
    __syncthreads();
    fft_r8<true, 1>(buf, T, 10); fft_r8<true>(buf, T, 7); fft_r8<true>(buf, T, 4); fft_r8<true>(buf, T, 1);
    const float4* sp = spec + (size_t)pi * SPEC_STRIDE;
    for (int f = tid; f <= 2048; f += NT) {
      const int p0 = brev13(f);
      const float2 a0 = buf[PH(p0)], b0 = buf[PH(p0 + 1)];
      const float2 Xf = cadd(a0, b0), Xf4 = csub(a0, b0);
      const float4 s1 = sp[f];
      const float2 S1 = make_float2(s1.x, s1.y), D1 = make_float2(s1.z, s1.w);
      if (f == 0 || f == 2048) {
        float2 W0, W1;
        if (f == 0) {
          const float4 s2 = sp[4096];
          W0 = cadd(cmul(Xf, S1), cmul(make_float2(Xf.x, -Xf.y), D1));
          W1 = cadd(cmul(Xf4, make_float2(s2.x, s2.y)), cmul(make_float2(Xf4.x, -Xf4.y), make_float2(s2.z, s2.w)));
        } else {
          W0 = cadd(cmul(Xf, S1), cmul(make_float2(Xf4.x, -Xf4.y), D1));
          W1 = cadd(cmul(Xf4, make_float2(S1.x, -S1.y)), cmul(make_float2(Xf.x, -Xf.y), make_float2(D1.x, -D1.y)));
        }
        const float2 c0 = make_float2(W0.x, -W0.y), c1 = make_float2(W1.x, -W1.y);
        buf[PH(p0)] = cadd(c0, c1); buf[PH(p0 + 1)] = csub(c0, c1);
      } else {
        const int fp = 4096 - f, p1 = brev13(fp);
        const float2 a1 = buf[PH(p1)], b1 = buf[PH(p1 + 1)];
        const float2 Xg = cadd(a1, b1), Xg4 = csub(a1, b1);
        const float4 s2 = sp[fp];
        const float2 S2 = make_float2(s2.x, s2.y), D2 = make_float2(s2.z, s2.w);
        const float2 Wf  = cadd(cmul(Xf, S1), cmul(make_float2(Xg4.x, -Xg4.y), D1));
        const float2 Wg4 = cadd(cmul(Xg4, make_float2(S1.x, -S1.y)), cmul(make_float2(Xf.x, -Xf.y), make_float2(D1.x, -D1.y)));
        const float2 Wg  = cadd(cmul(Xg, S2), cmul(make_float2(Xf4.x, -Xf4.y), D2));
        const float2 Wf4 = cadd(cmul(Xf4, make_float2(S2.x, -S2.y)), cmul(make_float2(Xg.x, -Xg.y), make_float2(D2.x, -D2.y)));
        float2 c0 = make_float2(Wf.x, -Wf.y), c1 = make_float2(Wf4.x, -Wf4.y);
        buf[PH(p0)] = cadd(c0, c1); buf[PH(p0 + 1)] = csub(c0, c1);
        c0 = make_float2(Wg.x, -Wg.y); c1 = make_float2(Wg4.x, -Wg4.y);
        buf[PH(p1)] = cadd(c0, c1); buf[PH(p1 + 1)] = csub(c0, c1);
      }
    }
    __syncthreads();
    fft_r8<false>(buf, T, 1); fft_r8<false>(buf, T, 4); fft_r8<false>(buf, T, 7); fft_r8<false, 2>(buf, T, 10);
    const float d1 = hd[c1], d2 = hd[c1 + 1];
    for (int t = tid; t < 4096; t += NT) {
      const float2 y = buf[PH(t)];
      z1[t] = f2bf(y.x + d1 * bf2f(z1[t]));
      z2[t] = f2bf(-y.y + d2 * bf2f(z2[t]));
    }
  }
}

__device__ __forceinline__ void ya_phase(const bf16_t* X0, const bf16_t* yT, const float* cw, const float* cb, bf16_t* MA, unsigned char* smem) {
  float* ys = (float*)smem;
  const int tid = tid_fresh(), c8 = tid & 7, tr = tid >> 3;
  for (int it = blockIdx.x; it < 8192; it += gridDim.x) {
    const int ct = it & 15, tt = it >> 4, c0 = ct * 64, t0 = tt * 64;
    __syncthreads();
    {
      const int cl = tid >> 2, tq = tid & 3;
      const int bidx = t0 >> 12, tbase = t0 & (SEQ - 1);
      const bf16_t* src = yT + ((size_t)(bidx * 1024 + c0 + cl)) * SEQ + tbase + tq * 16;
      float f[8];
      float* sw = ys + cl * 65 + tq * 16;
      unpack8(*(const uint4*)src, f);
#pragma unroll
      for (int e = 0; e < 8; ++e) sw[e] = f[e];
      unpack8(*(const uint4*)(src + 8), f);
#pragma unroll
      for (int e = 0; e < 8; ++e) sw[8 + e] = f[e];
    }
    __syncthreads();
    const int c = c0 + c8 * 8;
    float w0[3][8], bb[8];
#pragma unroll
    for (int e = 0; e < 8; ++e) {
#pragma unroll
      for (int k = 0; k < 3; ++k) w0[k][e] = cw[k * 3072 + c + e];
      bb[e] = cb[c + e];
    }
#pragma unroll
    for (int i = 0; i < 2; ++i) {
      const int tl = tr + 32 * i, t = t0 + tl, tb = t & (SEQ - 1);
      float a[8];
#pragma unroll
      for (int e = 0; e < 8; ++e) a[e] = bb[e];
#pragma unroll
      for (int k = 0; k < 3; ++k) {
        const int tbk = tb + k - 1;
        if (tbk >= 0 && tbk < SEQ) {
          float f[8];
          unpack8(*(const uint4*)(X0 + (size_t)(t + k - 1) * 1024 + c), f);
#pragma unroll
          for (int e = 0; e < 8; ++e) a[e] += w0[k][e] * f[e];
        }
      }
#pragma unroll
      for (int e = 0; e < 8; ++e) a[e] *= ys[(c8 * 8 + e) * 65 + tl];
      *(uint4*)(MA + (size_t)t * 1024 + c) = make_uint4(pack2(a[0], a[1]), pack2(a[2], a[3]), pack2(a[4], a[5]), pack2(a[6], a[7]));
    }
  }
}

__device__ __forceinline__ void convT_job(const float* src, int K, int N, bf16_t* dst, const float* scale, unsigned char* smem) {
  float* ts = (float*)smem;
  const int tid = tid_fresh();
  const int tn = N >> 6, ntile = (K >> 6) * tn;
  for (int it = blockIdx.x; it < ntile; it += gridDim.x) {
    const int k0 = (it / tn) * 64, n0 = (it % tn) * 64;
    __syncthreads();
#pragma unroll
    for (int i = 0; i < 4; ++i) {
      const int r = (tid >> 4) + 16 * i, c4 = tid & 15;
      float4 v = *(const float4*)(src + (size_t)(k0 + r) * N + n0 + c4 * 4);
      const float s = scale ? scale[k0 + r] : 1.f;
      float* d = ts + r * 65 + c4 * 4;
      d[0] = v.x * s; d[1] = v.y * s; d[2] = v.z * s; d[3] = v.w * s;
    }
    __syncthreads();
#pragma unroll
    for (int i = 0; i < 2; ++i) {
      const int id = tid + 256 * i, nn = id >> 3, kc = id & 7;
      float f[8];
#pragma unroll
      for (int e = 0; e < 8; ++e) f[e] = ts[(kc * 8 + e) * 65 + nn];
      *(uint4*)(dst + (size_t)(n0 + nn) * K + k0 + kc * 8) = make_uint4(pack2(f[0], f[1]), pack2(f[2], f[3]), pack2(f[4], f[5]), pack2(f[6], f[7]));
    }
  }
}
__device__ __forceinline__ void conv_plain(const float* src, bf16_t* dst, size_t n) {
  const size_t stride = (size_t)gridDim.x * NT * 8;
  for (size_t i = ((size_t)blockIdx.x * NT + tid_fresh()) * 8; i < n; i += stride) {
    const float4 a = *(const float4*)(src + i), b = *(const float4*)(src + i + 4);
    *(uint4*)(dst + i) = make_uint4(pack2(a.x, a.y), pack2(a.z, a.w), pack2(b.x, b.y), pack2(b.z, b.w));
  }
}

__device__ __forceinline__ void convx_rows(const float* x, bf16_t* hb, float* pa) {
  const int tid = tid_fresh(), wave = tid >> 6, lane = tid & 63;
  for (int row = blockIdx.x * 4 + wave; row < TOK; row += gridDim.x * 4) {
    const float* p = x + (size_t)row * 1024;
    float s = 0.f;
#pragma unroll
    for (int i = 0; i < 2; ++i) {
      const float4 a = *(const float4*)(p + i * 512 + lane * 8), b = *(const float4*)(p + i * 512 + lane * 8 + 4);
      *(uint4*)(hb + (size_t)row * 1024 + i * 512 + lane * 8) = make_uint4(pack2(a.x, a.y), pack2(a.z, a.w), pack2(b.x, b.y), pack2(b.z, b.w));
      s += a.x * a.x + a.y * a.y + a.z * a.z + a.w * a.w + b.x * b.x + b.y * b.y + b.z * b.z + b.w * b.w;
    }
#pragma unroll
    for (int o = 32; o > 0; o >>= 1) s += __shfl_xor(s, o);
    if (lane < 16) pa[(size_t)row * 16 + lane] = (lane == 0) ? s : 0.f;
  }
}

__device__ __forceinline__ void final_norm(float* h, const float* g) {
  const int tid = tid_fresh(), wave = tid >> 6, lane = tid & 63;
  for (int row = blockIdx.x * 4 + wave; row < TOK; row += gridDim.x * 4) {
    float* p = h + (size_t)row * 1024;
    float4 v[4]; float s = 0.f;
#pragma unroll
    for (int i = 0; i < 4; ++i) { v[i] = *(const float4*)(p + i * 256 + lane * 4); s += v[i].x * v[i].x + v[i].y * v[i].y + v[i].z * v[i].z + v[i].w * v[i].w; }
#pragma unroll
    for (int o = 32; o > 0; o >>= 1) s += __shfl_xor(s, o);
    const float r = rsqrtf(s * (1.f / 1024.f) + 1e-6f);
#pragma unroll
    for (int i = 0; i < 4; ++i) {
      const float4 gg = *(const float4*)(g + i * 256 + lane * 4);
      *(float4*)(p + i * 256 + lane * 4) = make_float4(v[i].x * r * gg.x, v[i].y * r * gg.y, v[i].z * r * gg.z, v[i].w * r * gg.w);
    }
  }
}


#define XB_TMO      128
#define XB_XCNT(j)  (256  + 64 * (j))
#define XB_XSUB(j)  (1280 + 64 * (j))
#define XB_XGEN(j)  (2304 + 64 * (j))
#define XB_TOP      3328
#define XB_TOPGEN   3392
#define XCD_BAR_WORDS 3456
#define XB_SPIN_CAP (1u << 18)
__device__ __forceinline__ unsigned xb_ld(unsigned* p)              { return __hip_atomic_load(p, __ATOMIC_RELAXED, __HIP_MEMORY_SCOPE_AGENT); }
__device__ __forceinline__ unsigned xb_add(unsigned* p, unsigned v) { return __hip_atomic_fetch_add(p, v, __ATOMIC_RELAXED, __HIP_MEMORY_SCOPE_AGENT); }
__device__ __forceinline__ unsigned xb_xcc_id() { unsigned v; asm volatile("s_getreg_b32 %0, hwreg(HW_REG_XCC_ID, 0, 4)" : "=s"(v)); return v & 0xFu; }
#define XB_SPIN(cond, bar) do { unsigned _sp = 0; while (cond) { __builtin_amdgcn_s_sleep(1); \
    if ((++_sp & 255u) == 0u) { if (xb_ld(&(bar)[XB_TMO])) break; if (_sp > XB_SPIN_CAP) { atomicAdd(&(bar)[XB_TMO], 1u); break; } } } } while (0)
__device__ __forceinline__ void xcd_barrier(unsigned* bar) {
  asm volatile("s_waitcnt vmcnt(0) lgkmcnt(0)" ::: "memory");
  __syncthreads();
  if (tid_fresh() == 0) {
    __builtin_amdgcn_s_waitcnt(0);
    const unsigned x = xb_xcc_id();
    int bi = blockIdx.x; asm volatile("" : "+s"(bi));
    const uint2 census = *(const uint2*)(bar + XCD_BAR_WORDS + 2 * bi);
    const unsigned nloc = census.x, nx = census.y;
    const unsigned old = xb_add(&bar[XB_XSUB(x)], 1u);
    const unsigned gen = old / nloc;
    if (old + 1u == (gen + 1u) * nloc) {
      __builtin_amdgcn_fence(__ATOMIC_RELEASE, "agent");
      asm volatile("s_waitcnt vmcnt(0)" ::: "memory");
      const unsigned og = xb_add(&bar[XB_TOP], 1u);
      const unsigned tg = og / nx;
      if (og + 1u == (tg + 1u) * nx) xb_add(&bar[XB_TOPGEN], 1u);
      else XB_SPIN(xb_ld(&bar[XB_TOPGEN]) == tg, bar);
      __builtin_amdgcn_fence(__ATOMIC_ACQUIRE, "agent");
      xb_add(&bar[XB_XGEN(x)], 1u);
      asm volatile("s_waitcnt vmcnt(0)" ::: "memory");
    } else {
      XB_SPIN(xb_ld(&bar[XB_XGEN(x)]) == gen, bar);
      __builtin_amdgcn_fence(__ATOMIC_ACQUIRE, "agent");
      asm volatile("s_waitcnt vmcnt(0)" ::: "memory");
    }
  }
  __syncthreads();
}

#define GSYNC() do { asm volatile("s_waitcnt vmcnt(0) lgkmcnt(0)" ::: "memory"); grid.sync(); \
    if (tid_fresh() < 64) { __builtin_amdgcn_fence(__ATOMIC_ACQUIRE, "agent"); asm volatile("s_waitcnt vmcnt(0)" ::: "memory"); } \
    __syncthreads(); } while (0)
#define XSYNC() xcd_barrier((unsigned*)WSP(BAR_OFF))
#define INP(i) (params_fresh()->in[i])
#define WBP ((bf16_t*)WSP(WB_OFF))
#define HBA ((bf16_t*)WSP(HBA_OFF))
#define SPECP ((float4*)WSP(SPEC_OFF))
#define H3P ((float*)WSP(H3_OFF))
#define TWP ((float2*)WSP(TW_OFF))
#define SLOT(i) ((bf16_t*)WSP(R_OFF + (size_t)(i) * 64 * MiB))
#define HRES (params_fresh()->out)

__global__ void __launch_bounds__(NT, 2) mega(Params Pdummy) {
  __shared__ __attribute__((aligned(16))) unsigned char smem[65536];
  cg::grid_group grid = cg::this_grid();
  if (tid_fresh() == 0) (void)xb_add(&((unsigned*)WSP(BAR_OFF))[XB_XCNT(xb_xcc_id())], 1u);

  for (int j = 0; j < 2; ++j) {
    convT_job(INP(I_EWIN) + (size_t)j * 1024 * 7168, 1024, 7168, WBP + W_EIN + (size_t)j * 7340032, INP(I_NORMG) + (2 * j) * 1024, smem);
    convT_job(INP(I_OWIN) + (size_t)j * 1024 * 6144, 1024, 6144, WBP + W_OIN + (size_t)j * 6291456, INP(I_NORMG) + (2 * j + 1) * 1024, smem);
    convT_job(INP(I_EWOUT) + (size_t)j * 2048 * 1024, 2048, 1024, WBP + W_EOUT + (size_t)j * 2097152, nullptr, smem);
    convT_job(INP(I_OWOUT) + (size_t)j * 2048 * 1024, 2048, 1024, WBP + W_OOUT + (size_t)j * 2097152, nullptr, smem);
    for (int g = 0; g < 4; ++g)
      convT_job(INP(I_POOLW) + (size_t)(j * 4 + g) * 65536, 256, 256, WBP + W_POOL + (size_t)(j * 4 + g) * 65536, nullptr, smem);
  }
  for (int i = 0; i < 4; ++i) {
    convT_job(INP(I_PGATE) + (size_t)i * 1048576, 1024, 1024, WBP + W_PGATE + (size_t)i * 1048576, INP(I_PLEG) + i * 1024, smem);
    convT_job(INP(I_PUP) + (size_t)i * 262144, 256, 1024, WBP + W_PUP + (size_t)i * 262144, nullptr, smem);
  }
  conv_plain(INP(I_GMWS), WBP + W_GMWS, 262144);
  convx_rows(INP(I_X), HBA, (float*)WSP(PA_OFF));
  hyena_feats(H3P, smem);
  {
    float2* T = TWP;
    for (int k = blockIdx.x * NT + tid_fresh(); k < 4096; k += gridDim.x * NT) {
      float s, c; sincospif((float)k / 4096.f, &s, &c);
      T[k] = make_float2(c, -s);
    }
  }
  if (gridDim.y == 0x7fffu) grid.sync();
  if (tid_fresh() == 0) {
    unsigned* bar = (unsigned*)WSP(BAR_OFF);
    const unsigned x = xb_xcc_id();
    unsigned nloc = 0u, nx = 0u, sum = 0u, sp = 0u;
    for (;;) {
      sum = 0u; nx = 0u; nloc = 0u;
#pragma unroll
      for (unsigned jx = 0; jx < 16; ++jx) { const unsigned c = xb_ld(&bar[XB_XCNT(jx)]); sum += c; nx += (c > 0u) ? 1u : 0u; nloc = (jx == x) ? c : nloc; }
      if (sum == gridDim.x) break;
      __builtin_amdgcn_s_sleep(1);
      if ((++sp & 255u) == 0u) { if (xb_ld(&bar[XB_TMO])) break; if (sp > XB_SPIN_CAP) { atomicAdd(&bar[XB_TMO], 1u); break; } }
    }
    *(uint2*)(bar + XCD_BAR_WORDS + 2 * blockIdx.x) = make_uint2(nloc > 0u ? nloc : 1u, nx > 0u ? nx : 1u);
  }
  XSYNC();
  filtgen_phase(INP(I_HWOUT), 0, H3P, (float*)SLOT(3), smem);
  XSYNC();

#pragma unroll 1
  for (int layer = 0; layer < 4; ++layer) {
    const int j = layer >> 1;
    if ((layer & 1) == 0) {
      spectrum_phase((const float*)SLOT(3), TWP, SPECP, smem);
      inproj_phase(HBA, WBP + W_EIN + (size_t)j * 7340032, 3, 0, 1024, 2048, 0, SLOT(0), SLOT(1), SLOT(2), nullptr, 0, 0, 0, 0, smem);
      XSYNC();
      z_phase(SLOT(1), SLOT(2), INP(I_CONVW) + (size_t)j * 9216, INP(I_CONVB) + (size_t)j * 3072, SLOT(3), smem);
      XSYNC();
      fftconv_phase(SLOT(3), SPECP, TWP, INP(I_HD) + j * 1024, smem);
      XSYNC();
      ya_phase(SLOT(0), SLOT(3), INP(I_CONVW) + (size_t)j * 9216, INP(I_CONVB) + (size_t)j * 3072, SLOT(1), smem);
      inproj_phase(HBA, WBP + W_EIN + (size_t)j * 7340032, 2, 4096, 5120, 0, 0, SLOT(4), SLOT(2), nullptr, nullptr, 0, 3, 0, 0, smem);
      XSYNC();
      gmlp_phase(SLOT(4), SLOT(2), WBP + W_GMWS + (size_t)j * 131072, INP(I_GMG) + j * 1024, INP(I_GMBS) + j * 1024, smem);
      XSYNC();
      inproj_phase(HBA, WBP + W_EIN + (size_t)j * 7340032, 2, 3072, 6144, 0, 0, SLOT(1), SLOT(4), nullptr, nullptr, 2, 2, 0, 0, smem);
      XSYNC();
      outproj_phase(SLOT(1), SLOT(4), WBP + W_EOUT + (size_t)j * 2097152, (layer == 0) ? INP(I_X) : (const float*)HRES, HRES, SLOT(3), smem);
      XSYNC();
      ple_phase(SLOT(3), INP(I_P) + (size_t)layer * TOK * 256, WBP + W_PGATE + (size_t)layer * 1048576, WBP + W_PUP + (size_t)layer * 262144, HRES, HBA, smem);
      XSYNC();
    } else {
      inproj_phase(HBA, WBP + W_OIN + (size_t)j * 6291456, 4, 0, 2048, 3072, 4096, SLOT(0), SLOT(1), SLOT(2), SLOT(3), 0, 0, 0, 1, smem);
      XSYNC();
      pool_phase(SLOT(0), WBP + W_POOL + (size_t)j * 262144, INP(I_POOLB) + j * 1024, INP(I_POOLS) + j * 1024, SLOT(4), smem);
      na_phase(SLOT(1), SLOT(2), SLOT(3), INP(I_RPB) + (size_t)j * 16 * 15 * 31, smem);
      XSYNC();
      inproj_phase(HBA, WBP + W_OIN + (size_t)j * 6291456, 2, 1024, 5120, 0, 0, SLOT(4), SLOT(1), nullptr, nullptr, 2, 2, 0, 0, smem);
      XSYNC();
      outproj_phase(SLOT(4), SLOT(1), WBP + W_OOUT + (size_t)j * 2097152, HRES, HRES, SLOT(2), smem);
      XSYNC();
      ple_phase(SLOT(2), INP(I_P) + (size_t)layer * TOK * 256, WBP + W_PGATE + (size_t)layer * 1048576, WBP + W_PUP + (size_t)layer * 262144, HRES, HBA, smem);
      if (layer == 1) filtgen_phase(INP(I_HWOUT), 1, H3P, (float*)SLOT(3), smem);
      XSYNC();
    }
  }
  final_norm(HRES, INP(I_FINALG));
}

extern "C" void kernel_launch(void* const* d_in, const int* in_sizes, int n_in, void* d_out, int out_size, void* d_ws, size_t ws_size, hipStream_t stream) {
  static int grid_blocks = 0;
  if (grid_blocks == 0) {
    if (n_in != 29 || out_size != TOK * 1024 || ws_size < WS_END) { fprintf(stderr, "kernel_launch: unexpected shapes (n_in %d out %d ws %zu)\n", n_in, out_size, ws_size); grid_blocks = -1; return; }
    int dev = 0, cus = 0, per_cu = 0;
    if (hipGetDevice(&dev) != hipSuccess || hipDeviceGetAttribute(&cus, hipDeviceAttributeMultiprocessorCount, dev) != hipSuccess) { grid_blocks = -1; return; }
    if (hipOccupancyMaxActiveBlocksPerMultiprocessor(&per_cu, (const void*)mega, NT, LDS_BYTES) != hipSuccess || per_cu < 1) { fprintf(stderr, "occupancy query failed\n"); per_cu = 1; }
    if (per_cu > 2) per_cu = 2;
    grid_blocks = cus * per_cu;
  }
  if (grid_blocks < 0) return;
  Params p{};
  for (int i = 0; i < 29; ++i) p.in[i] = (const float*)d_in[i];
  p.out = (float*)d_out; p.ws = (unsigned char*)d_ws;
  if (hipMemsetAsync((unsigned char*)d_ws + BAR_OFF, 0, XCD_BAR_WORDS * sizeof(unsigned), stream) != hipSuccess) { fprintf(stderr, "memset of barrier words failed\n"); return; }
  void* args[] = {&p};
  hipError_t e = hipLaunchCooperativeKernel((const void*)mega, dim3(grid_blocks), dim3(NT), args, LDS_BYTES, stream);
  if (e != hipSuccess) fprintf(stderr, "cooperative launch failed: %s (grid %d)\n", hipGetErrorString(e), grid_blocks);
}
```
